# Optimizing an MI355X kernel written in HIP

```python
import math
import jax, jax.numpy as jnp
from jax import lax
import numpy as np

D_MODEL = 1024
BATCH = 4
SEQ = 4096
DEPTH = 4

GRID_W = 64
CTX_LEN = 256
N_EVEN = (DEPTH + 1) // 2
N_ODD = DEPTH // 2
EPS = 1e-6

CHUNK = 128
A_WIDTH = D_MODEL // 2
A_GROUPS = 4
A_GROUP_W = A_WIDTH // A_GROUPS
B_WIDTH = D_MODEL // 2
B_CH = 16
B_GROUPS = B_WIDTH // B_CH
B_STATE = 64
EVEN_IN = 3 * A_WIDTH + 2 * B_WIDTH
EVEN_MIX = A_WIDTH + B_WIDTH
HEAD_DIM = 128
N_Q = D_MODEL // HEAD_DIM
N_KV = 2
Q_PER_KV = N_Q // N_KV
C_WIDTH = N_Q * HEAD_DIM
KV_WIDTH = N_KV * HEAD_DIM
ODD_IN = 2 * C_WIDTH + 2 * KV_WIDTH
Q_BLOCK = 128
ROPE_THETA = 10000.0
ROPE_PAIRS = HEAD_DIM // 4

kernel_name = "hybrid_gmlp_s5_gqa_prefix_trunk"


def _rms_norm(x, g):
    xf = x.astype(jnp.float32)
    y = xf * lax.rsqrt(jnp.mean(xf * xf, axis=-1, keepdims=True) + EPS)
    return (y * g.astype(jnp.float32)).astype(x.dtype)


def _layer_norm(x, g):
    xf = x.astype(jnp.float32)
    mu = jnp.mean(xf, axis=-1, keepdims=True)
    xc = xf - mu
    var = jnp.mean(xc * xc, axis=-1, keepdims=True)
    return (xc * lax.rsqrt(var + EPS) * g.astype(jnp.float32)).astype(x.dtype)


def _ada(cond, w, b):
    m = jax.nn.silu(cond) @ w + b
    return jnp.split(m, 3, axis=-1)


def _prologue(x, ctx, c, c_ctx, g, w_mod, b_mod):
    sh, sc, gt = _ada(c, w_mod, b_mod)
    shc, scc, gtc = _ada(c_ctx, w_mod, b_mod)
    hx = _rms_norm(x, g) * (1 + sc[:, None]) + sh[:, None]
    hc = _rms_norm(ctx, g) * (1 + scc) + shc
    h = jnp.concatenate([hc, hx], axis=1)
    return h, gt[:, None], gtc


def _chunk_gmlp(u, v, v_g, w_s, b_s):
    Bn, L, _ = v.shape
    v = _layer_norm(v, v_g)
    vc = v.reshape(Bn, L // CHUNK, CHUNK, A_GROUPS, A_GROUP_W)
    mixed = jnp.einsum('gpq,bnqgc->bnpgc', w_s, vc) + b_s.T[None, None, :, :, None]
    return u * mixed.reshape(Bn, L, A_WIDTH)


def _s5_discretize(lam_re, lam_im, log_dt, b_re, b_im):
    lam_re = lam_re.astype(jnp.float32)
    lam_im = lam_im.astype(jnp.float32)
    dt = jnp.exp(log_dt.astype(jnp.float32))[:, None]
    mag = jnp.exp(lam_re * dt)
    lb_re = mag * jnp.cos(lam_im * dt)
    lb_im = mag * jnp.sin(lam_im * dt)
    den = lam_re * lam_re + lam_im * lam_im
    n_re, n_im = lb_re - 1.0, lb_im
    f_re = (n_re * lam_re + n_im * lam_im) / den
    f_im = (n_im * lam_re - n_re * lam_im) / den
    b_re = b_re.astype(jnp.float32)
    b_im = b_im.astype(jnp.float32)
    bb_re = f_re[..., None] * b_re - f_im[..., None] * b_im
    bb_im = f_re[..., None] * b_im + f_im[..., None] * b_re
    return lb_re, lb_im, bb_re, bb_im


def _ssm_combine(e1, e2):
    a1r, a1i, b1r, b1i = e1
    a2r, a2i, b2r, b2i = e2
    return (a1r * a2r - a1i * a2i,
            a1r * a2i + a1i * a2r,
            a2r * b1r - a2i * b1i + b2r,
            a2r * b1i + a2i * b1r + b2i)


def _s5_direction(seq, lam_re, lam_im, log_dt, b_re, b_im, c_re, c_im):
    Bn, L, W = seq.shape
    lb_re, lb_im, bb_re, bb_im = _s5_discretize(lam_re, lam_im, log_dt, b_re, b_im)
    u = seq.reshape(Bn, L, B_GROUPS, B_CH)
    bu_re = jnp.einsum('blgh,gph->blgp', u, bb_re)
    bu_im = jnp.einsum('blgh,gph->blgp', u, bb_im)
    a_re = jnp.broadcast_to(lb_re, (1, L, B_GROUPS, B_STATE))
    a_im = jnp.broadcast_to(lb_im, (1, L, B_GROUPS, B_STATE))
    _, _, h_re, h_im = lax.associative_scan(_ssm_combine, (a_re, a_im, bu_re, bu_im), axis=1)
    y = (jnp.einsum('blgp,ghp->blgh', h_re, c_re.astype(jnp.float32))
         - jnp.einsum('blgp,ghp->blgh', h_im, c_im.astype(jnp.float32)))
    return y.reshape(Bn, L, W)


def _s5_bidir(xs, n_ctx, lam_re, lam_im, log_dt, b_re, b_im, c_re, c_im, d_skip, w_glu, b_glu):
    dtype = xs.dtype
    xf = xs.astype(jnp.float32)
    x_ctx, x_lat = xf[:, :n_ctx], xf[:, n_ctx:]
    fwd = _s5_direction(xf, lam_re[0], lam_im[0], log_dt[0], b_re[0], b_im[0], c_re[0], c_im[0])
    bwd_seq = jnp.concatenate([x_ctx[:, ::-1], x_lat[:, ::-1]], axis=1)
    bwd = _s5_direction(bwd_seq, lam_re[1], lam_im[1], log_dt[1], b_re[1], b_im[1], c_re[1], c_im[1])
    bwd = jnp.concatenate([bwd[:, :n_ctx][:, ::-1], bwd[:, n_ctx:][:, ::-1]], axis=1)
    y = fwd + bwd + d_skip.astype(jnp.float32) * xf
    y = jax.nn.gelu(y)
    y = y * jax.nn.sigmoid(y @ w_glu.astype(jnp.float32) + b_glu.astype(jnp.float32))
    return y.astype(dtype)


def _axial_rope(n_lat):
    rows = n_lat // GRID_W
    row = jnp.repeat(jnp.arange(rows), GRID_W)
    col = jnp.tile(jnp.arange(GRID_W), rows)
    freqs = ROPE_THETA ** (-jnp.arange(ROPE_PAIRS, dtype=jnp.float32) / ROPE_PAIRS)
    ang = jnp.stack([row[:, None] * freqs, col[:, None] * freqs], axis=1)
    return jnp.cos(ang), jnp.sin(ang)


def _apply_rope(x, cos, sin):
    lead = x.shape[:-1]
    xs = x.reshape(lead + (2, 2, ROPE_PAIRS)).astype(jnp.float32)
    bshape = (1, x.shape[1]) + (1,) * (x.ndim - 3) + (2, ROPE_PAIRS)
    cos = cos.reshape(bshape)
    sin = sin.reshape(bshape)
    x1, x2 = xs[..., 0, :], xs[..., 1, :]
    out = jnp.stack([x1 * cos - x2 * sin, x1 * sin + x2 * cos], axis=-2)
    return out.reshape(x.shape).astype(x.dtype)


def _attend(q, k, v):
    s = jnp.einsum('btkgd,bskd->bkgts', q, k).astype(jnp.float32) * (HEAD_DIM ** -0.5)
    p = jax.nn.softmax(s, axis=-1).astype(v.dtype)
    return jnp.einsum('bkgts,bskd->btkgd', p, v)


def _even_layer(x, ctx, c, c_ctx, norm_g, w_mod, b_mod, w_in, w_out, gm_v_g, gm_w_s, gm_b_s,
                lam_re, lam_im, log_dt, b_re, b_im, c_re, c_im, d_skip, w_glu, b_glu, update_ctx):
    n_ctx = ctx.shape[1]
    h, gt, gtc = _prologue(x, ctx, c, c_ctx, norm_g, w_mod, b_mod)
    u, v, g_a, xs, g_b = jnp.split(
        h @ w_in, [A_WIDTH, 2 * A_WIDTH, 3 * A_WIDTH, 3 * A_WIDTH + B_WIDTH], axis=-1)
    y_a = jnp.concatenate([
        _chunk_gmlp(u[:, :n_ctx], v[:, :n_ctx], gm_v_g, gm_w_s, gm_b_s),
        _chunk_gmlp(u[:, n_ctx:], v[:, n_ctx:], gm_v_g, gm_w_s, gm_b_s)], axis=1)
    y_a = y_a * jax.nn.silu(g_a)
    y_b = _s5_bidir(xs, n_ctx, lam_re, lam_im, log_dt, b_re, b_im, c_re, c_im, d_skip, w_glu, b_glu)
    y_b = y_b * jax.nn.silu(g_b)
    mix = jnp.concatenate([y_a, y_b], axis=-1)
    x = x + gt * (mix[:, n_ctx:] @ w_out)
    if update_ctx:
        ctx = ctx + gtc * (mix[:, :n_ctx] @ w_out)
    return x, ctx


def _odd_layer(x, ctx, c, c_ctx, norm_g, w_mod, b_mod, w_in, w_out, q_g, k_g, update_ctx):
    n_ctx = ctx.shape[1]
    Bn, L, _ = x.shape
    n_tot = n_ctx + L
    h, gt, gtc = _prologue(x, ctx, c, c_ctx, norm_g, w_mod, b_mod)
    q, k, v, gate = jnp.split(h @ w_in, [C_WIDTH, C_WIDTH + KV_WIDTH, C_WIDTH + 2 * KV_WIDTH], axis=-1)
    q = _rms_norm(q.reshape(Bn, n_tot, N_KV, Q_PER_KV, HEAD_DIM), q_g)
    k = _rms_norm(k.reshape(Bn, n_tot, N_KV, HEAD_DIM), k_g)
    v = v.reshape(Bn, n_tot, N_KV, HEAD_DIM)
    cos, sin = _axial_rope(L)
    q_lat = _apply_rope(q[:, n_ctx:], cos, sin)
    k_all = jnp.concatenate([k[:, :n_ctx], _apply_rope(k[:, n_ctx:], cos, sin)], axis=1)
    nb = L // Q_BLOCK
    qb = jnp.moveaxis(q_lat.reshape(Bn, nb, Q_BLOCK, N_KV, Q_PER_KV, HEAD_DIM), 1, 0)
    o = lax.map(lambda qi: _attend(qi, k_all, v), qb)
    o_lat = jnp.moveaxis(o, 0, 1).reshape(Bn, L, C_WIDTH)
    x = x + gt * ((o_lat * jax.nn.silu(gate[:, n_ctx:])) @ w_out)
    if update_ctx:
        o_ctx = _attend(q[:, :n_ctx], k[:, :n_ctx], v[:, :n_ctx]).reshape(Bn, n_ctx, C_WIDTH)
        ctx = ctx + gtc * ((o_ctx * jax.nn.silu(gate[:, :n_ctx])) @ w_out)
    return x, ctx


def setup_inputs(seed: int = 0) -> dict:
    key = jax.random.key(seed)
    ks = iter(jax.random.split(key, 40))
    f32 = jnp.float32
    nrm = lambda shape, s=1.0: jax.random.normal(next(ks), shape, f32) * s
    lam_re = -0.5 + nrm((N_EVEN, 2, B_GROUPS, B_STATE), 0.01)
    lam_im = (jnp.pi * jnp.arange(B_STATE, dtype=f32)) + nrm((N_EVEN, 2, B_GROUPS, B_STATE), 0.01)
    return {
        "x": nrm((BATCH, SEQ, D_MODEL)),
        "c": nrm((BATCH, D_MODEL)),
        "ctx": nrm((BATCH, CTX_LEN, D_MODEL)),
        "c_ctx": nrm((D_MODEL,)),
        "norm_g": 1.0 + nrm((DEPTH, D_MODEL), 0.02),
        "w_mod": nrm((DEPTH, D_MODEL, 3 * D_MODEL), 0.5 * D_MODEL ** -0.5),
        "b_mod": nrm((DEPTH, 3 * D_MODEL), 0.02),
        "we_in": nrm((N_EVEN, D_MODEL, EVEN_IN), D_MODEL ** -0.5),
        "we_out": nrm((N_EVEN, EVEN_MIX, D_MODEL), EVEN_MIX ** -0.5),
        "gm_v_g": 1.0 + nrm((N_EVEN, A_WIDTH), 0.02),
        "gm_w_s": nrm((N_EVEN, A_GROUPS, CHUNK, CHUNK), CHUNK ** -0.5),
        "gm_b_s": 1.0 + nrm((N_EVEN, A_GROUPS, CHUNK), 0.1),
        "s5_lam_re": lam_re,
        "s5_lam_im": lam_im,
        "s5_log_dt": jax.random.uniform(next(ks), (N_EVEN, 2, B_GROUPS), f32,
                                        minval=math.log(1e-3), maxval=math.log(1e-1)),
        "s5_b_re": nrm((N_EVEN, 2, B_GROUPS, B_STATE, B_CH), (2 * B_CH) ** -0.5),
        "s5_b_im": nrm((N_EVEN, 2, B_GROUPS, B_STATE, B_CH), (2 * B_CH) ** -0.5),
        "s5_c_re": nrm((N_EVEN, 2, B_GROUPS, B_CH, B_STATE), B_STATE ** -0.5),
        "s5_c_im": nrm((N_EVEN, 2, B_GROUPS, B_CH, B_STATE), B_STATE ** -0.5),
        "s5_d": nrm((N_EVEN, B_WIDTH)),
        "s5_w_glu": nrm((N_EVEN, B_WIDTH, B_WIDTH), B_WIDTH ** -0.5),
        "s5_b_glu": nrm((N_EVEN, B_WIDTH), 0.02),
        "wo_in": nrm((N_ODD, D_MODEL, ODD_IN), D_MODEL ** -0.5),
        "wo_out": nrm((N_ODD, C_WIDTH, D_MODEL), C_WIDTH ** -0.5),
        "q_norm_g": 1.0 + nrm((N_ODD, HEAD_DIM), 0.02),
        "k_norm_g": 1.0 + nrm((N_ODD, HEAD_DIM), 0.02),
        "final_g": 1.0 + nrm((D_MODEL,), 0.02),
    }


def reference(x, c, ctx, c_ctx, norm_g, w_mod, b_mod, we_in, we_out, gm_v_g, gm_w_s, gm_b_s,
              s5_lam_re, s5_lam_im, s5_log_dt, s5_b_re, s5_b_im, s5_c_re, s5_c_im, s5_d,
              s5_w_glu, s5_b_glu, wo_in, wo_out, q_norm_g, k_norm_g, final_g):
    for layer in range(DEPTH):
        update_ctx = layer < DEPTH - 1
        i = layer // 2
        if layer % 2 == 0:
            x, ctx = _even_layer(x, ctx, c, c_ctx, norm_g[layer], w_mod[layer], b_mod[layer],
                                 we_in[i], we_out[i], gm_v_g[i], gm_w_s[i], gm_b_s[i],
                                 s5_lam_re[i], s5_lam_im[i], s5_log_dt[i], s5_b_re[i], s5_b_im[i],
                                 s5_c_re[i], s5_c_im[i], s5_d[i], s5_w_glu[i], s5_b_glu[i], update_ctx)
        else:
            x, ctx = _odd_layer(x, ctx, c, c_ctx, norm_g[layer], w_mod[layer], b_mod[layer],
                                wo_in[i], wo_out[i], q_norm_g[i], k_norm_g[i], update_ctx)
    return _rms_norm(x, final_g)
```

```cpp
#include <hip/hip_runtime.h>
#include <hip/hip_cooperative_groups.h>
#include <cstdio>
#include <cstdint>
namespace cg = cooperative_groups;
#define ONE_LAUNCH 1
#define USE_PG8 1
#define USE_ATTN 1
#define USE_S5 1
#define USE_GMLP 1

constexpr int DM = 1024, NB = 4, SEQ = 4096, NCTX = 256, TPB = NCTX + SEQ, MTOK = NB * TPB;
constexpr int NPROJ = 2560, DEPTH = 4;
constexpr float EPS = 1e-6f;
constexpr int NTHREADS = 512, NWAVES = 8;
constexpr int TAB_OFF = 147456, LDS_BYTES = TAB_OFF + 512;

typedef unsigned short bf16_t;
typedef short bf16x8 __attribute__((ext_vector_type(8)));
typedef float f32x4 __attribute__((ext_vector_type(4)));
typedef unsigned u32x2 __attribute__((ext_vector_type(2)));
typedef unsigned u32x4 __attribute__((ext_vector_type(4)));

constexpr size_t MiB = 1u << 20;
constexpr size_t WS_CTL = 0;
constexpr size_t WS_MODS = 1 * MiB;
constexpr size_t WS_BIAS = 1 * MiB + 512 * 1024;
constexpr size_t WS_RSS = 2 * MiB;
constexpr size_t WS_ROPE = 3 * MiB + 512 * 1024;
constexpr size_t WS_CTXRES = 4 * MiB;
constexpr size_t WS_WIN = 8 * MiB;
constexpr size_t WS_WOUT = 28 * MiB;
constexpr size_t WS_WGLU = 36 * MiB;
constexpr size_t WS_XM = 38 * MiB;
constexpr size_t WS_PROJ = 72 * MiB;
constexpr size_t WS_MIX = 157 * MiB;
constexpr size_t WS_YG = 191 * MiB;
constexpr size_t WS_S5 = 208 * MiB;
constexpr size_t WS_END = 256 * MiB;

struct P {
    const float* in[27];
    float* out;
    unsigned char* ws;
    int ph_lo, ph_hi;
};

__device__ __forceinline__ unsigned f2bf(float f) { unsigned u = __builtin_bit_cast(unsigned, f); return (u + 0x7fffu + ((u >> 16) & 1u)) >> 16; }
__device__ __forceinline__ unsigned pk2(float lo, float hi) { return f2bf(lo) | (f2bf(hi) << 16); }
__device__ __forceinline__ float bf2f(unsigned short h) { return __builtin_bit_cast(float, (unsigned)h << 16); }
__device__ __forceinline__ float bflo(unsigned w) { return __builtin_bit_cast(float, w << 16); }
__device__ __forceinline__ float bfhi(unsigned w) { return __builtin_bit_cast(float, w & 0xffff0000u); }
__device__ __forceinline__ float wave_sum(float v) {
#pragma unroll
    for (int o = 1; o < 64; o <<= 1) v += __shfl_xor(v, o);
    return v;
}
__device__ __forceinline__ float silu_f(float x) { return x * __builtin_amdgcn_rcpf(1.f + __expf(-x)); }
__device__ __forceinline__ float sigmoid_f(float x) { return __builtin_amdgcn_rcpf(1.f + __expf(-x)); }
__device__ __forceinline__ float gelu_tanh_f(float x) {
    const float u2 = 1.5957691216057308f * (x + 0.044715f * x * x * x);
    return x * __builtin_amdgcn_rcpf(1.f + __expf(-u2));
}
__host__ __device__ __forceinline__ int hd_logical(int h) { return (h & 0x40) | ((h & 0x04) << 3) | ((h & 0x38) >> 1) | (h & 0x03); }
__device__ __forceinline__ int in_col_logical(int l, int n) { return ((l & 1) && n < 1280) ? ((n & ~127) | hd_logical(n & 127)) : n; }
__device__ __forceinline__ int cond_row(int m) { const int b = m / TPB, t = m - b * TPB; return t < NCTX ? 4 : b; }
__device__ __forceinline__ size_t res_off(int m, bool& is_ctx) { const int b = m / TPB, t = m - b * TPB; is_ctx = t < NCTX; return is_ctx ? (size_t)(b * NCTX + t) * DM : (size_t)(b * SEQ + t - NCTX) * DM; }

struct Ctx {
    const P* p; int tid, wid, lane, gw, ngw;
    unsigned char* lds;
};

namespace pg8 {
#define PG8_LAS __attribute__((address_space(3)))
typedef unsigned short bf16_t;
typedef short bf16x8 __attribute__((ext_vector_type(8)));
typedef float f32x4 __attribute__((ext_vector_type(4)));
typedef unsigned u32x4 __attribute__((ext_vector_type(4)));
constexpr int BM = 256, BK = 64, HALF = 128, HTB = HALF * BK * 2  , STAGE_BYTES = 8 * HTB, NXCD = 8, WGM = 8;

__host__ __device__ __forceinline__ int lds_byte(int r, int c) { const int st = (r >> 4) * 2 + (c >> 5), rr = r & 15, cc = c & 31, ob = rr * 64 + cc * 2; return st * 1024 + (ob ^ (((ob >> 9) & 1) << 5)); }
__host__ __device__ __forceinline__ void stage_rc(int b, int& R, int& C) { const int st = b / 1024, sb = b % 1024, swz = sb ^ (((sb >> 9) & 1) << 5); R = (st >> 1) * 16 + swz / 64; C = (st & 1) * 32 + (swz % 64) / 2; }
__host__ __device__ __forceinline__ int perm32(int rho) { const int n = rho >> 4, i = rho & 15; return 8 * (i >> 2) + 4 * n + (i & 3); }

struct Unit { int pm, pn; };
struct Gemm { const bf16_t* A; const bf16_t* Bt; int M, N, K; };

struct StaticOrder {
    int nM, nN, nwg, G, c;
    __host__ __device__ void init(int M, int N, int G_, int c_) { nM = M / BM; nN = N / BM; nwg = nM * nN; G = G_; c = c_; }
    __host__ __device__ bool next(int i, Unit& u) const {
        const long L = (long)i * G + c; if (L >= nwg) return false;
        int wgid = (int)L; { const int q = nwg / NXCD, r = nwg % NXCD, xcd = wgid % NXCD, off = wgid / NXCD; wgid = (xcd < r ? xcd * (q + 1) : r * (q + 1) + (xcd - r) * q) + off; }
        const int nig = WGM * nN, gid = wgid / nig, fm = gid * WGM, gsz = (nM - fm) < WGM ? (nM - fm) : WGM;
        u.pm = fm + ((wgid % nig) % gsz); u.pn = (wgid % nig) / gsz; return true;
    }
    __device__ __forceinline__ void a_ready(const Unit&) const {}
    __device__ __forceinline__ void done(const Unit&) const {}
};

__device__ __forceinline__ unsigned cvt_pk_bf16(float lo, float hi) { unsigned r; asm volatile("v_cvt_pk_bf16_f32 %0, %1, %2" : "=v"(r) : "v"(lo), "v"(hi)); return r; }
template <class Epi, class Sched, bool ALIGN_EPI = false, bool SP2 = false>
__device__ __forceinline__ void gemm_phase(PG8_LAS unsigned char* lds, const Gemm g, const Sched& S, const Epi& E, const int tid) {
    const int wid = __builtin_amdgcn_readfirstlane(tid >> 6), lane = tid & 63, wr = wid >> 2, wc = wid & 3, fr = lane & 15, fq = lane >> 4;
    const int K = g.K, nt = K / BK;
    unsigned voffA[2], voffB[2];
#pragma unroll
    for (int i = 0; i < 2; ++i) { int R, C; stage_rc(tid * 16 + i * 8192, R, C); const int Rb = Epi::PERM ? ((R & ~31) + perm32(R & 31)) : R;
        voffA[i] = (unsigned)(R * K + C) * 2u; voffB[i] = (unsigned)(Rb * K + C) * 2u; }
    const size_t kstep = (size_t)(BK * 2);
    const size_t hstep = (size_t)HALF * K * 2;
    const size_t tstep = 2 * hstep;
    const unsigned ldsw = (unsigned)wid * 1024u;
    const int aoff = lds_byte(wr * 64 + fr, fq * 8), boff = lds_byte(wc * 32 + fr, fq * 8);
#define PG8_SA(b, h) (((b) * 2 + (h)) * HTB)
#define PG8_SB(b, h) ((4 + (b) * 2 + (h)) * HTB)
#define PG8_STAGE(bufoff, gbase, voff) do { _Pragma("unroll") for (int _i = 0; _i < 2; ++_i) \
        __builtin_amdgcn_global_load_lds((const unsigned*)((const char*)(gbase) + (voff)[_i]), (PG8_LAS unsigned*)(lds + (bufoff) + ldsw + _i * 8192), 16, 0, 0); } while (0)
#define PG8_LDA(dst, b, h) do { _Pragma("unroll") for (int m = 0; m < 4; ++m) _Pragma("unroll") for (int k = 0; k < 2; ++k) dst[m][k] = *(const PG8_LAS bf16x8*)(lds + PG8_SA(b, h) + aoff + m * 2048 + k * 1024); } while (0)
#define PG8_LDB(dst, b, h) do { _Pragma("unroll") for (int n = 0; n < 2; ++n) _Pragma("unroll") for (int k = 0; k < 2; ++k) dst[n][k] = *(const PG8_LAS bf16x8*)(lds + PG8_SB(b, h) + boff + n * 2048 + k * 1024); } while (0)
#define PG8_MMA(ai, bj, At, Bt) do { __builtin_amdgcn_s_setprio(1); _Pragma("unroll") for (int m = 0; m < 4; ++m) _Pragma("unroll") for (int n = 0; n < 2; ++n) _Pragma("unroll") for (int k = 0; k < 2; ++k) \
        acc[ai][bj][m][n] = __builtin_amdgcn_mfma_f32_16x16x32_bf16(Bt[n][k], At[m][k], acc[ai][bj][m][n], 0, 0, 0); __builtin_amdgcn_s_setprio(0); } while (0)
#define PG8_WAIT_V(n) asm volatile("s_waitcnt vmcnt(" #n ")" ::: "memory")
#define PG8_WAIT_L(n) asm volatile("s_waitcnt lgkmcnt(" #n ")" ::: "memory")
#define PG8_BAR __builtin_amdgcn_s_barrier()
#define PG8_SCHED __builtin_amdgcn_sched_barrier(0)
    Unit cur, nxt; int ui = 0;
    if (!S.next(0, cur)) return;
    f32x4 acc[2][2][4][2];
#pragma unroll
    for (int a = 0; a < 2; ++a)
#pragma unroll
        for (int b = 0; b < 2; ++b)
#pragma unroll
            for (int m = 0; m < 4; ++m)
#pragma unroll
                for (int n = 0; n < 2; ++n) acc[a][b][m][n] = (f32x4){0.f, 0.f, 0.f, 0.f};
    bf16x8 At[4][2], B0[2][2], B1[2][2];
    const char* cA = (const char*)g.A + (size_t)cur.pm * tstep; const char* cB = (const char*)g.Bt + (size_t)cur.pn * tstep;
    S.a_ready(cur);
    if constexpr (SP2) {
        PG8_STAGE(PG8_SB(0, 0), cB, voffB); PG8_STAGE(PG8_SB(0, 1), cB + hstep, voffB); PG8_STAGE(PG8_SA(0, 0), cA, voffA); PG8_STAGE(PG8_SA(0, 1), cA + hstep, voffA);
        if (wr == 1) PG8_BAR;
        PG8_WAIT_V(2); PG8_BAR;
        PG8_STAGE(PG8_SB(1, 0), cB + kstep, voffB); PG8_STAGE(PG8_SA(1, 0), cA + kstep, voffA); PG8_STAGE(PG8_SB(1, 1), cB + hstep + kstep, voffB);
        PG8_WAIT_V(6); PG8_BAR;
    } else {
        PG8_STAGE(PG8_SB(0, 0), cB, voffB); PG8_STAGE(PG8_SA(0, 0), cA, voffA); PG8_STAGE(PG8_SB(0, 1), cB + hstep, voffB); PG8_STAGE(PG8_SA(0, 1), cA + hstep, voffA);
        if (wr == 1) PG8_BAR;
        PG8_WAIT_V(4); PG8_BAR;
        PG8_STAGE(PG8_SB(1, 0), cB + kstep, voffB); PG8_STAGE(PG8_SA(1, 0), cA + kstep, voffA); PG8_STAGE(PG8_SB(1, 1), cB + hstep + kstep, voffB);
        PG8_WAIT_V(6); PG8_BAR;
    }
    for (;;) {
        const bool has_next = S.next(ui + 1, nxt);
        const char* nA = has_next ? (const char*)g.A + (size_t)nxt.pm * tstep : cA; const char* nB = has_next ? (const char*)g.Bt + (size_t)nxt.pn * tstep : cB;
        for (int t = 0; t < nt; t += 2) {
            const bool last = (t == nt - 2);
            const char* a1 = cA + (size_t)(t + 1) * kstep;
            const char* a2 = last ? nA : cA + (size_t)(t + 2) * kstep; const char* b2 = last ? nB : cB + (size_t)(t + 2) * kstep;
            const char* a3 = a2 + kstep; const char* b3 = b2 + kstep;
            if (last && has_next) S.a_ready(nxt);
            if constexpr (SP2) {
            PG8_LDB(B0, 0, 0); PG8_LDB(B1, 0, 1); PG8_SCHED; PG8_LDA(At, 0, 0); PG8_STAGE(PG8_SA(1, 1), a1 + hstep, voffA);
            PG8_WAIT_V(8); PG8_WAIT_L(0); PG8_BAR; PG8_MMA(0, 0, At, B0); PG8_MMA(0, 1, At, B1); PG8_BAR; PG8_SCHED;
            PG8_LDA(At, 0, 1); PG8_STAGE(PG8_SB(0, 0), b2, voffB); PG8_STAGE(PG8_SB(0, 1), b2 + hstep, voffB); PG8_STAGE(PG8_SA(0, 0), a2, voffA);
            PG8_WAIT_V(8); PG8_WAIT_L(0); PG8_BAR; PG8_MMA(1, 0, At, B0); PG8_MMA(1, 1, At, B1); PG8_BAR; PG8_SCHED;
            PG8_LDB(B0, 1, 0); PG8_LDB(B1, 1, 1); PG8_SCHED; PG8_LDA(At, 1, 0); PG8_STAGE(PG8_SA(0, 1), a2 + hstep, voffA);
            PG8_WAIT_V(8); PG8_WAIT_L(0); PG8_BAR; PG8_MMA(0, 0, At, B0); PG8_MMA(0, 1, At, B1); PG8_BAR; PG8_SCHED;
            PG8_LDA(At, 1, 1); PG8_STAGE(PG8_SB(1, 0), b3, voffB); PG8_STAGE(PG8_SB(1, 1), b3 + hstep, voffB); PG8_STAGE(PG8_SA(1, 0), a3, voffA);
            PG8_WAIT_V(8); PG8_WAIT_L(0); PG8_BAR; PG8_MMA(1, 0, At, B0); PG8_MMA(1, 1, At, B1); PG8_BAR; PG8_SCHED;
            } else {
            PG8_LDB(B0, 0, 0); PG8_SCHED; PG8_LDA(At, 0, 0); PG8_STAGE(PG8_SA(1, 1), a1 + hstep, voffA);
            PG8_WAIT_L(8); PG8_BAR; PG8_WAIT_L(0); PG8_MMA(0, 0, At, B0); PG8_BAR; PG8_SCHED;
            PG8_LDB(B1, 0, 1); PG8_STAGE(PG8_SB(0, 0), b2, voffB);
            PG8_BAR; PG8_WAIT_L(0); PG8_MMA(0, 1, At, B1); PG8_BAR;
            PG8_LDA(At, 0, 1); PG8_STAGE(PG8_SA(0, 0), a2, voffA);
            PG8_BAR; PG8_WAIT_L(0); PG8_MMA(1, 0, At, B0); PG8_BAR; PG8_SCHED;
            PG8_STAGE(PG8_SB(0, 1), b2 + hstep, voffB);
            PG8_WAIT_V(6); PG8_BAR; PG8_MMA(1, 1, At, B1); PG8_BAR;
            PG8_LDB(B0, 1, 0); PG8_SCHED; PG8_LDA(At, 1, 0); PG8_STAGE(PG8_SA(0, 1), a2 + hstep, voffA);
            PG8_WAIT_L(8); PG8_BAR; PG8_WAIT_L(0); PG8_MMA(0, 0, At, B0); PG8_BAR; PG8_SCHED;
            PG8_LDB(B1, 1, 1); PG8_STAGE(PG8_SB(1, 0), b3, voffB);
            PG8_BAR; PG8_WAIT_L(0); PG8_MMA(0, 1, At, B1); PG8_BAR;
            PG8_LDA(At, 1, 1); PG8_STAGE(PG8_SA(1, 0), a3, voffA);
            PG8_BAR; PG8_WAIT_L(0); PG8_MMA(1, 0, At, B0); PG8_BAR; PG8_SCHED;
            PG8_STAGE(PG8_SB(1, 1), b3 + hstep, voffB);
            PG8_WAIT_V(6); PG8_BAR; PG8_MMA(1, 1, At, B1); PG8_BAR;
            }
        }
        if constexpr (ALIGN_EPI) { if (wr == 0) PG8_BAR; }
        if constexpr (!Epi::AFTER_DRAIN) { E(acc, cur, wr, wc, fr, fq); S.done(cur); }
        if (!has_next) break;
#pragma unroll
        for (int a = 0; a < 2; ++a)
#pragma unroll
            for (int b = 0; b < 2; ++b)
#pragma unroll
                for (int m = 0; m < 4; ++m)
#pragma unroll
                    for (int n = 0; n < 2; ++n) acc[a][b][m][n] = (f32x4){0.f, 0.f, 0.f, 0.f};
        cur = nxt; cA = nA; cB = nB; ++ui;
        if constexpr (ALIGN_EPI) { if (wr == 1) PG8_BAR; }
    }
    PG8_WAIT_V(0);
    if constexpr (!ALIGN_EPI) { if (wr == 0) PG8_BAR; }
    PG8_BAR;
    if constexpr (Epi::AFTER_DRAIN) { E.fused(acc, cur, wr, wc, fr, fq, lds, wid, lane); S.done(cur); }
#undef PG8_SA
#undef PG8_SB
#undef PG8_STAGE
#undef PG8_LDA
#undef PG8_LDB
#undef PG8_MMA
#undef PG8_WAIT_V
#undef PG8_WAIT_L
#undef PG8_BAR
#undef PG8_SCHED
}
}

namespace attn {
constexpr int   D = 128, NW = 8, QBLK = 32, KVBLK = 64;
constexpr float SCALE = 0.088388347648318440f;
#ifndef ATTN_THR
#define ATTN_THR 8.f
#endif
constexpr float THR = ATTN_THR;
constexpr int SDEPTH = 2;
constexpr int LDQ = 2560, LDK = 2560, LDO = 1024, LDG = 2560;
constexpr size_t SHM_V = KVBLK * D * 2, SHM_K = KVBLK * D * 2, SHM_ATTN = 2 * SHM_V + 2 * SHM_K + NW * 64 * 4;
using bf16 = unsigned short;
using bf16x8 = __attribute__((ext_vector_type(8))) short;
using s16x4  = __attribute__((ext_vector_type(4))) short;
using f32x16 = __attribute__((ext_vector_type(16))) float;
using f32x8  = __attribute__((ext_vector_type(8))) float;
using u32x4  = __attribute__((ext_vector_type(4))) unsigned;
#define KSWZ(row, colB) ((row) * 256 + ((colB) ^ (((row) & 7) << 4)))
#define SBAR() __builtin_amdgcn_sched_barrier(0)
__device__ __forceinline__ int crow(int r, int hi) { return (r & 3) + 8 * (r >> 2) + 4 * hi; }
__device__ __forceinline__ unsigned cvtpk(float lo, float hi) {
  unsigned r; asm volatile("v_cvt_pk_bf16_f32 %0, %1, %2" : "=v"(r) : "v"(lo), "v"(hi)); return r;
}
template <typename TIn> struct Stage;
template <> struct Stage<bf16>  { using T = bf16x8;
  __device__ static __forceinline__ T ld8(const bf16* p) { return *reinterpret_cast<const bf16x8*>(p); }
  __device__ static __forceinline__ bf16x8 tobf(T x) { return x; } };
template <> struct Stage<float> { using T = f32x8;
  __device__ static __forceinline__ T ld8(const float* p) { return *reinterpret_cast<const f32x8*>(p); }
  __device__ static __forceinline__ bf16x8 tobf(T x) {
    u32x4 w = {cvtpk(x[0], x[1]), cvtpk(x[2], x[3]), cvtpk(x[4], x[5]), cvtpk(x[6], x[7])}; return *reinterpret_cast<bf16x8*>(&w); } };

__device__ __forceinline__ void partialSM(f32x16& p0, f32x16& p1, float& m_reg, float& mn, float& alpha) {
  constexpr float C = SCALE * 1.4426950408889634f;
  float pmax = p0[0]; for (int r = 1; r < 16; ++r) pmax = fmaxf(pmax, p0[r]); for (int r = 0; r < 16; ++r) pmax = fmaxf(pmax, p1[r]);
  { auto rr = __builtin_amdgcn_permlane32_swap(__float_as_uint(pmax), __float_as_uint(pmax), false, false);
    pmax = fmaxf(__uint_as_float(rr[0]), __uint_as_float(rr[1])); }
  if (__builtin_expect(__all(pmax - m_reg <= THR / SCALE), 1)) { mn = m_reg; alpha = 1.f; }
  else { mn = fmaxf(m_reg, pmax); alpha = __builtin_amdgcn_exp2f((m_reg - mn) * C); m_reg = mn; }
  float mnC = -mn * C;
  for (int r = 0; r < 16; ++r) p0[r] = fmaf(p0[r], C, mnC); for (int r = 0; r < 16; ++r) p1[r] = fmaf(p1[r], C, mnC);
  for (int r = 0; r < 16; ++r) p0[r] = __builtin_amdgcn_exp2f(p0[r]);
}
__device__ __forceinline__ void finishSM(f32x16& p0, f32x16& p1, float alpha, float& l_reg, bf16x8& pa0, bf16x8& pa1, bf16x8& pa2, bf16x8& pa3) {
  for (int r = 0; r < 16; ++r) p1[r] = __builtin_amdgcn_exp2f(p1[r]);
  float ps = 0; for (int r = 0; r < 16; ++r) ps += p0[r]; for (int r = 0; r < 16; ++r) ps += p1[r];
  { auto rr = __builtin_amdgcn_permlane32_swap(__float_as_uint(ps), __float_as_uint(ps), false, false);
    ps = __uint_as_float(rr[0]) + __uint_as_float(rr[1]); }
  l_reg = l_reg * alpha + ps;
#define PK4(P, BASE, OUT) do { unsigned a0 = cvtpk(P[BASE + 0], P[BASE + 1]), a1 = cvtpk(P[BASE + 2], P[BASE + 3]);   \
    unsigned b0 = cvtpk(P[BASE + 4], P[BASE + 5]), b1 = cvtpk(P[BASE + 6], P[BASE + 7]);                              \
    auto r0 = __builtin_amdgcn_permlane32_swap(a0, b0, false, false); auto r1 = __builtin_amdgcn_permlane32_swap(a1, b1, false, false); \
    u32x4 w = {r0[0], r1[0], r0[1], r1[1]}; OUT = *reinterpret_cast<bf16x8*>(&w); } while (0)
  PK4(p0, 0, pa0); PK4(p0, 8, pa1); PK4(p1, 0, pa2); PK4(p1, 8, pa3);
#undef PK4
}
__device__ __forceinline__ void qkt(f32x16& p0, f32x16& p1, const bf16* Ks, const bf16x8* qr, int r32, int hi) {
  p0 = f32x16{}; p1 = f32x16{};
  for (int d0 = 0; d0 < 8; ++d0) { int cb = (d0 * 16 + hi * 8) * 2;
    bf16x8 b0 = *reinterpret_cast<const bf16x8*>((const char*)Ks + KSWZ(r32, cb));
    bf16x8 b1 = *reinterpret_cast<const bf16x8*>((const char*)Ks + KSWZ(32 + r32, cb));
    p0 = __builtin_amdgcn_mfma_f32_32x32x16_bf16(b0, qr[d0], p0, 0, 0, 0);
    p1 = __builtin_amdgcn_mfma_f32_32x32x16_bf16(b1, qr[d0], p1, 0, 0, 0); }
}
__device__ __forceinline__ int v_st(int k, int c) { const int kk = (k & ~0xC) | ((k & 4) << 1) | ((k & 8) >> 1); return ((kk >> 3) * 4 + (c >> 5)) * 512 + ((kk & 7) * 32 + (c & 31)) * 2; }
__device__ __forceinline__ int v_rd_base(int lane) { return ((lane & 3) << 3) | (((lane >> 2) & 3) << 6) | (((lane >> 4) & 1) << 5) | (((lane >> 5) & 1) << 8); }
constexpr int v_rd_off(int d0, int ks, int half) { return d0 * 512 + ks * 4096 + half * 2048; }
template <int OFF> __device__ __forceinline__ s16x4 tr_read(int vb) {
  s16x4 r; asm volatile("ds_read_b64_tr_b16 %0, %1 offset:%2" : "=&v"(r) : "v"(vb), "i"(OFF) : "memory"); return r;
}
template <int D0> __device__ __forceinline__ void pv_one(f32x16& od, int vb, bf16x8 pa0, bf16x8 pa1, bf16x8 pa2, bf16x8 pa3) {
  const s16x4 l0 = tr_read<v_rd_off(D0, 0, 0)>(vb), h0 = tr_read<v_rd_off(D0, 0, 1)>(vb), l1 = tr_read<v_rd_off(D0, 1, 0)>(vb), h1 = tr_read<v_rd_off(D0, 1, 1)>(vb);
  const s16x4 l2 = tr_read<v_rd_off(D0, 2, 0)>(vb), h2 = tr_read<v_rd_off(D0, 2, 1)>(vb), l3 = tr_read<v_rd_off(D0, 3, 0)>(vb), h3 = tr_read<v_rd_off(D0, 3, 1)>(vb);
  asm volatile("s_waitcnt lgkmcnt(0)" ::: "memory"); SBAR();
#define PK(L, H) (bf16x8){L[0], L[1], L[2], L[3], H[0], H[1], H[2], H[3]}
  od = __builtin_amdgcn_mfma_f32_32x32x16_bf16(pa0, PK(l0, h0), od, 0, 0, 0);
  od = __builtin_amdgcn_mfma_f32_32x32x16_bf16(pa1, PK(l1, h1), od, 0, 0, 0);
  od = __builtin_amdgcn_mfma_f32_32x32x16_bf16(pa2, PK(l2, h2), od, 0, 0, 0);
  od = __builtin_amdgcn_mfma_f32_32x32x16_bf16(pa3, PK(l3, h3), od, 0, 0, 0);
#undef PK
}
__device__ __forceinline__ void pv_d0(f32x16* o, int vb, bf16x8 pa0, bf16x8 pa1, bf16x8 pa2, bf16x8 pa3) {
  pv_one<0>(o[0], vb, pa0, pa1, pa2, pa3); pv_one<1>(o[1], vb, pa0, pa1, pa2, pa3); pv_one<2>(o[2], vb, pa0, pa1, pa2, pa3); pv_one<3>(o[3], vb, pa0, pa1, pa2, pa3);
}

template <typename TQ>
__device__ __forceinline__ void attn_dense_body(const TQ* __restrict__ Qb, const bf16* __restrict__ Kh, const bf16* __restrict__ Vh,
                                                bf16* __restrict__ Ob, const bf16* __restrict__ Gb, int seq, char* lds, const int tid) {
  using St = Stage<bf16>; using SQ = Stage<TQ>;
  const int wid = __builtin_amdgcn_readfirstlane(tid >> 6), lane = tid & 63, r32 = lane & 31, hi = lane >> 5;
  bf16* V_lds = (bf16*)lds; bf16* K_lds = (bf16*)(lds + 2 * SHM_V);
  float* ws = (float*)(lds + 2 * SHM_V + 2 * SHM_K) + wid * 64; float* li_l = ws; float* al_l = ws + 32;
  float m_reg = -1e30f, l_reg = 0; f32x16 o[4] = {}; bf16x8 qr[8];
  const TQ* Qw = Qb + (long)(wid * QBLK + r32) * LDQ + hi * 8;
#pragma unroll
  for (int d0 = 0; d0 < 8; ++d0) qr[d0] = SQ::tobf(SQ::ld8(Qw + d0 * 16));
  const int sr = tid >> 4, sc = (tid & 15) * 8, vst0 = v_st(sr, sc), vst1 = v_st(32 + sr, sc);
  const int vb0 = (int)(uintptr_t)V_lds + v_rd_base(lane);
  struct { typename St::T vs0, vs1, ks0, ks1; } sr_[SDEPTH];
  const unsigned lo0 = (unsigned)(sr * LDK + sc), lo1 = (unsigned)((32 + sr) * LDK + sc);
#define SLOAD(i, k0) do { const bf16* vt_ = Vh + (long)(k0) * LDK; const bf16* kt_ = Kh + (long)(k0) * LDK; sr_[i].vs0 = St::ld8(vt_ + lo0); sr_[i].vs1 = St::ld8(vt_ + lo1); \
    sr_[i].ks0 = St::ld8(kt_ + lo0); sr_[i].ks1 = St::ld8(kt_ + lo1); } while (0)
#define SWRITE(b, i) do { *(bf16x8*)((char*)V_lds + (b) * SHM_V + vst0) = St::tobf(sr_[i].vs0);          \
    *(bf16x8*)((char*)V_lds + (b) * SHM_V + vst1) = St::tobf(sr_[i].vs1); int kc = sc * 2;               \
    *(bf16x8*)((char*)K_lds + (b) * SHM_K + KSWZ(sr, kc)) = St::tobf(sr_[i].ks0);                       \
    *(bf16x8*)((char*)K_lds + (b) * SHM_K + KSWZ(32 + sr, kc)) = St::tobf(sr_[i].ks1); } while (0)
#define SWAIT() do { if constexpr (SDEPTH == 2) asm volatile("s_waitcnt vmcnt(4)" ::: "memory"); else asm volatile("s_waitcnt vmcnt(0)" ::: "memory"); } while (0)
#define RESC(a) do { if (__any((a) < 1.f)) { if (hi == 0) al_l[r32] = (a); asm volatile("s_waitcnt lgkmcnt(0)" ::: "memory"); \
    for (int d = 0; d < 4; ++d) for (int r = 0; r < 16; ++r) o[d][r] *= al_l[crow(r, hi)]; } } while (0)
  f32x16 pA0, pA1, pB0, pB1; float mnA, mnB, alA, alB; bf16x8 pa0, pa1, pa2, pa3; const int NT = seq / KVBLK;
  constexpr int SE = 0, SO = SDEPTH - 1;
  SLOAD(SE, 0); asm volatile("s_waitcnt vmcnt(0)" ::: "memory"); SWRITE(0, SE); __syncthreads();
  qkt(pA0, pA1, K_lds, qr, r32, hi); partialSM(pA0, pA1, m_reg, mnA, alA);
  SLOAD(SO, KVBLK); if constexpr (SDEPTH == 2) { if (2 < NT) SLOAD(SE, 2 * KVBLK); }
  SWAIT(); SWRITE(1, SO); __syncthreads();
  for (int j = 1; j + 1 < NT; j += 2) {
    SBAR(); qkt(pB0, pB1, (bf16*)((char*)K_lds + SHM_K), qr, r32, hi);
    finishSM(pA0, pA1, alA, l_reg, pa0, pa1, pa2, pa3); SBAR();
    SLOAD(SO, (j + SDEPTH) * KVBLK); SBAR();
    pv_d0(o, vb0, pa0, pa1, pa2, pa3); partialSM(pB0, pB1, m_reg, mnB, alB);
    __syncthreads(); SWAIT(); SWRITE(0, SE);
    RESC(alB); __syncthreads();
    SBAR(); qkt(pA0, pA1, K_lds, qr, r32, hi);
    finishSM(pB0, pB1, alB, l_reg, pa0, pa1, pa2, pa3); SBAR();
    if (SDEPTH == 1 || j + 3 < NT) SLOAD(SE, (j + 1 + SDEPTH) * KVBLK); SBAR();
    pv_d0(o, vb0 + (int)SHM_V, pa0, pa1, pa2, pa3); partialSM(pA0, pA1, m_reg, mnA, alA);
    __syncthreads(); SWAIT(); SWRITE(1, SO);
    RESC(alA); __syncthreads();
  }
  SBAR(); qkt(pB0, pB1, (bf16*)((char*)K_lds + SHM_K), qr, r32, hi);
  finishSM(pA0, pA1, alA, l_reg, pa0, pa1, pa2, pa3); SBAR();
  pv_d0(o, vb0, pa0, pa1, pa2, pa3); partialSM(pB0, pB1, m_reg, mnB, alB);
  __syncthreads(); RESC(alB);
  finishSM(pB0, pB1, alB, l_reg, pa0, pa1, pa2, pa3); SBAR();
  pv_d0(o, vb0 + (int)SHM_V, pa0, pa1, pa2, pa3);
  if (hi == 0) li_l[r32] = l_reg; asm volatile("s_waitcnt lgkmcnt(0)" ::: "memory");
  float rli[16];
#pragma unroll
  for (int r = 0; r < 16; ++r) rli[r] = __builtin_amdgcn_rcpf(li_l[crow(r, hi)]);
  __syncthreads();
  { char* ost = lds + wid * 8704;
    int ob = hi * (4 * 272) + r32 * 2; asm volatile("" : "+v"(ob));
    char* osl = ost + ob;
#pragma unroll
    for (int r = 0; r < 16; ++r) { const int orow0 = (r & 3) + 8 * (r >> 2);
#pragma unroll
      for (int d0 = 0; d0 < 4; ++d0) *(bf16*)(osl + orow0 * 272 + d0 * 64) = (bf16)(cvtpk(o[d0][r] * rli[r], 0.f) & 0xffffu); }
    asm volatile("s_waitcnt lgkmcnt(0)" ::: "memory");
    bf16* Ow = Ob + (long)(wid * QBLK) * LDO; const bf16* Gw = Gb + (long)(wid * QBLK) * LDG;
    int ln = lane; asm volatile("" : "+v"(ln));
#pragma unroll 2
    for (int i = 0; i < 8; ++i) { const int id = i * 64 + ln, row = id >> 4, ch = id & 15;
      const u32x4 ov = *(const u32x4*)(ost + row * 272 + ch * 16); const u32x4 gv = *(const u32x4*)(Gw + (long)row * LDG + ch * 8);
      u32x4 w;
#define GMUL(O, G) cvtpk(__builtin_bit_cast(float, (O) << 16) * __builtin_bit_cast(float, (G) << 16), __builtin_bit_cast(float, (O) & 0xffff0000u) * __builtin_bit_cast(float, (G) & 0xffff0000u))
      w.x = GMUL(ov.x, gv.x); w.y = GMUL(ov.y, gv.y); w.z = GMUL(ov.z, gv.z); w.w = GMUL(ov.w, gv.w);
#undef GMUL
      *(u32x4*)(Ow + (long)row * LDO + ch * 8) = w; }
    asm volatile("s_waitcnt lgkmcnt(0)" ::: "memory");
  }
#undef SLOAD
#undef SWRITE
#undef SWAIT
#undef RESC
}

#undef KSWZ
#undef SBAR
}

#define LAS __attribute__((address_space(3)))
#define XB_TMO      128
#define XB_XCNT(j)  (256  + 64 * (j))
#define XB_XSUB(j)  (1280 + 64 * (j))
#define XB_XGEN(j)  (2304 + 64 * (j))
#define XB_TOP      3328
#define XB_TOPGEN   3392
#define XCD_BAR_WORDS 3456
#define XB_SPIN_CAP (1u << 18)

__device__ __forceinline__ unsigned xb_ld(unsigned* p)              { return __hip_atomic_load(p, __ATOMIC_RELAXED, __HIP_MEMORY_SCOPE_AGENT); }
__device__ __forceinline__ unsigned xb_add(unsigned* p, unsigned v) { return __hip_atomic_fetch_add(p, v, __ATOMIC_RELAXED, __HIP_MEMORY_SCOPE_AGENT); }
__device__ __forceinline__ unsigned xb_xcc_id() { return (unsigned)__builtin_amdgcn_s_getreg((3 << 11) | 20) & 0xFu; }
#define XB_SPIN(cond, bar) do { unsigned _sp = 0; while (cond) { __builtin_amdgcn_s_sleep(1); \
    if ((++_sp & 255u) == 0u) { if (xb_ld(&(bar)[XB_TMO])) break; if (_sp > XB_SPIN_CAP) { atomicAdd(&(bar)[XB_TMO], 1u); break; } } } } while (0)

struct XcdBarrier {
    unsigned* bar; unsigned x;
    volatile LAS unsigned* st;
};

__device__ __forceinline__ XcdBarrier xcd_barrier_post(unsigned* bar, volatile LAS unsigned* st) {
    XcdBarrier b; b.bar = bar; b.x = xb_xcc_id(); b.st = st;
    if (threadIdx.x == 0) (void)xb_add(&bar[XB_XCNT(b.x)], 1u);
    return b;
}
__device__ __forceinline__ void xcd_barrier_complete(unsigned* bar, unsigned x, unsigned& nloc, unsigned& nx) {
    const unsigned G = gridDim.x * gridDim.y * gridDim.z;
    unsigned sum, cnt, mine, sp = 0u;
    for (;;) {
        sum = 0u; cnt = 0u; mine = 0u;
#pragma unroll
        for (unsigned j = 0; j < 16; ++j) { const unsigned c = xb_ld(&bar[XB_XCNT(j)]); sum += c; cnt += (c > 0u) ? 1u : 0u; mine = (j == x) ? c : mine; }
        if (sum == G) break;
        __builtin_amdgcn_s_sleep(1);
        if ((++sp & 255u) == 0u) { if (xb_ld(&bar[XB_TMO])) break; if (sp > XB_SPIN_CAP) { atomicAdd(&bar[XB_TMO], 1u); break; } }
    }
    nloc = mine > 0u ? mine : 1u; nx = cnt > 0u ? cnt : 1u;
}

__device__ __forceinline__ void xcd_barrier(const XcdBarrier& b) {
    asm volatile("s_waitcnt vmcnt(0)" ::: "memory");
    __syncthreads();
    if (threadIdx.x == 0) {
        unsigned* bar = b.bar;
        __builtin_amdgcn_s_waitcnt(0);
        unsigned nloc = b.st[0], nx = b.st[1];
        if (nloc == 0u) { xcd_barrier_complete(bar, b.x, nloc, nx); b.st[0] = nloc; b.st[1] = nx; }
        const unsigned old = xb_add(&bar[XB_XSUB(b.x)], 1u);
        const unsigned gen = old / nloc;
        if (old + 1u == (gen + 1u) * nloc) {
            __builtin_amdgcn_fence(__ATOMIC_RELEASE, "agent");
            asm volatile("s_waitcnt vmcnt(0)" ::: "memory");
            const unsigned og = xb_add(&bar[XB_TOP], 1u);
            const unsigned tg = og / nx;
            if (og + 1u == (tg + 1u) * nx) xb_add(&bar[XB_TOPGEN], 1u);
            else XB_SPIN(xb_ld(&bar[XB_TOPGEN]) == tg, bar);
            __builtin_amdgcn_fence(__ATOMIC_ACQUIRE, "agent");
            xb_add(&bar[XB_XGEN(b.x)], 1u);
            asm volatile("s_waitcnt vmcnt(0)" ::: "memory");
        } else {
            XB_SPIN(xb_ld(&bar[XB_XGEN(b.x)]) == gen, bar);
            __builtin_amdgcn_fence(__ATOMIC_ACQUIRE, "agent");
            asm volatile("s_waitcnt vmcnt(0)" ::: "memory");
        }
    }
    __syncthreads();
}

__device__ __forceinline__ void transpose_item(const float* W, int K, int N, bf16_t* WT, int item, float* scr, int tid, int permute_below = 0) {
    const int nblk = N / 64, kb = item / nblk, nb = item % nblk, k0 = kb * 64, n0 = nb * 64;
    __syncthreads();
#pragma unroll
    for (int i = 0; i < 8; ++i) { const int kk = (tid >> 6) + 8 * i, nn = tid & 63; scr[kk * 65 + nn] = W[(size_t)(k0 + kk) * N + n0 + nn]; }
    __syncthreads();
    const int n = tid >> 3, c = tid & 7;
    const int ns = (n0 + n < permute_below) ? (hd_logical((n0 + n) & 127) & 63) : n;
    u32x4 o; const float* s = scr + (8 * c) * 65 + ns;
    o.x = pk2(s[0], s[65]); o.y = pk2(s[2 * 65], s[3 * 65]); o.z = pk2(s[4 * 65], s[5 * 65]); o.w = pk2(s[6 * 65], s[7 * 65]);
    *(u32x4*)(WT + (size_t)(n0 + n) * K + k0 + 8 * c) = o;
}
__device__ __forceinline__ void phase_prep_a(const Ctx& c) {
    const P& p = *c.p;
    float* mods = (float*)(p.ws + WS_MODS);
    {
        float* sl = (float*)(c.lds + 32768);
        float* red = (float*)(c.lds + 32768 + 20480);
        for (int e = c.tid; e < 5 * DM; e += NTHREADS) { const int r = e >> 10, k = e & 1023; sl[e] = silu_f(r < 4 ? p.in[1][r * DM + k] : p.in[3][k]); }
        __syncthreads();
        for (int it = blockIdx.x; it < DEPTH * 48; it += gridDim.x) {
            const int l = it / 48, j = (it % 48) * 64 + c.lane;
            const float* w = p.in[5] + (size_t)l * DM * 3072 + (size_t)(c.wid * 128) * 3072 + j;
            float a0 = 0.f, a1 = 0.f, a2 = 0.f, a3 = 0.f, a4 = 0.f;
#pragma unroll 16
            for (int k = 0; k < 128; ++k) { const float wv = w[(size_t)k * 3072]; const int kk = c.wid * 128 + k;
                a0 += sl[kk] * wv; a1 += sl[DM + kk] * wv; a2 += sl[2 * DM + kk] * wv; a3 += sl[3 * DM + kk] * wv; a4 += sl[4 * DM + kk] * wv; }
            float* rw = red + c.wid * 320 + c.lane; rw[0] = a0; rw[64] = a1; rw[128] = a2; rw[192] = a3; rw[256] = a4;
            __syncthreads();
            if (c.tid < 320) { float sum = 0.f;
#pragma unroll
                for (int w8 = 0; w8 < 8; ++w8) sum += red[w8 * 320 + c.tid];
                const int r = c.tid >> 6, jj = (it % 48) * 64 + (c.tid & 63);
                mods[((size_t)l * 5 + r) * 3072 + jj] = sum + p.in[6][l * 3072 + jj]; }
            __syncthreads();
        }
    }
    if (blockIdx.x == gridDim.x - 1) {
        float* rope = (float*)(p.ws + WS_ROPE);
        for (int e = c.tid; e < 64 * 32; e += NTHREADS) { const int pos = e >> 5, pr = e & 31;
            const float freq = powf(10000.f, -(float)pr / 32.f); const float ang = (float)pos * freq; rope[2 * e] = cosf(ang); rope[2 * e + 1] = sinf(ang); }
    }
}

__device__ __forceinline__ void phase_transposes(const Ctx& c) {
    const P& p = *c.p;
    float* scr = (float*)c.lds;
    constexpr int I_IN = 16 * 40, I_OUT = 16 * 16, I_GLU = 8 * 8;
    constexpr int NIT = 4 * I_IN + 4 * I_OUT + 2 * I_GLU;
    for (int it = blockIdx.x; it < NIT; it += gridDim.x) {
        int r = it;
        if (r < 4 * I_IN) { const int l = r / I_IN; const float* W = (l & 1) ? p.in[22] + (size_t)(l >> 1) * DM * NPROJ : p.in[7] + (size_t)(l >> 1) * DM * NPROJ;
            transpose_item(W, DM, NPROJ, (bf16_t*)(p.ws + WS_WIN) + (size_t)l * NPROJ * DM, r % I_IN, scr, c.tid, (l & 1) ? 1280 : 0); continue; }
        r -= 4 * I_IN;
        if (r < 4 * I_OUT) { const int l = r / I_OUT; const float* W = (l & 1) ? p.in[23] + (size_t)(l >> 1) * DM * DM : p.in[8] + (size_t)(l >> 1) * DM * DM;
            transpose_item(W, DM, DM, (bf16_t*)(p.ws + WS_WOUT) + (size_t)l * DM * DM, r % I_OUT, scr, c.tid); continue; }
        r -= 4 * I_OUT;
        { const int i = r / I_GLU; transpose_item(p.in[20] + (size_t)i * 512 * 512, 512, 512, (bf16_t*)(p.ws + WS_WGLU) + (size_t)i * 512 * 512, r % I_GLU, scr, c.tid); }
    }
    __syncthreads();
}
__device__ __forceinline__ void phase_bias(const Ctx& c) {
    const P& p = *c.p;
    const float* mods = (const float*)(p.ws + WS_MODS); float* bias = (float*)(p.ws + WS_BIAS);
    float* sl = (float*)(c.lds + 32768);
    float* red = (float*)(c.lds + 32768 + 20480);
    for (int it = blockIdx.x; it < DEPTH * 40; it += gridDim.x) {
        const int l = it / 40, n = (it % 40) * 64 + c.lane;
        __syncthreads();
        for (int e = c.tid; e < 5 * DM; e += NTHREADS) { const int r = e >> 10, k = e & 1023; sl[e] = mods[((size_t)l * 5 + r) * 3072 + k]; }
        __syncthreads();
        const float* W = ((l & 1) ? p.in[22] + (size_t)(l >> 1) * DM * NPROJ : p.in[7] + (size_t)(l >> 1) * DM * NPROJ) + (size_t)(c.wid * 128) * NPROJ + in_col_logical(l, n);
        float a0 = 0.f, a1 = 0.f, a2 = 0.f, a3 = 0.f, a4 = 0.f;
#pragma unroll 16
        for (int k = 0; k < 128; ++k) { const float wv = W[(size_t)k * NPROJ]; const int kk = c.wid * 128 + k;
            a0 += sl[kk] * wv; a1 += sl[DM + kk] * wv; a2 += sl[2 * DM + kk] * wv; a3 += sl[3 * DM + kk] * wv; a4 += sl[4 * DM + kk] * wv; }
        float* rw = red + c.wid * 320 + c.lane; rw[0] = a0; rw[64] = a1; rw[128] = a2; rw[192] = a3; rw[256] = a4;
        __syncthreads();
        if (c.tid < 320) { float sum = 0.f;
#pragma unroll
            for (int w8 = 0; w8 < 8; ++w8) sum += red[w8 * 320 + c.tid];
            const int r = c.tid >> 6, nn = (it % 40) * 64 + (c.tid & 63);
            bias[((size_t)l * 5 + r) * NPROJ + nn] = sum; }
    }
    __syncthreads();
}
__device__ __forceinline__ void phase_xprep(const Ctx& c, int l, const float* xbuf, const float* ctxbuf) {
    const P& p = *c.p;
    const float* mods = (const float*)(p.ws + WS_MODS) + (size_t)l * 5 * 3072;
    const float* g = p.in[4] + l * DM;
    bf16_t* xm = (bf16_t*)(p.ws + WS_XM); float* rss = (float*)(p.ws + WS_RSS);
    for (int m = c.gw; m < MTOK; m += c.ngw) {
        bool ic; const size_t off = res_off(m, ic); const float* src = (ic ? ctxbuf : xbuf) + off; const int r = cond_row(m);
        const float* sc = mods + r * 3072 + 1024;
        float ss = 0.f;
#pragma unroll
        for (int j = 0; j < 4; ++j) { const int k = 4 * c.lane + 256 * j; const f32x4 v = *(const f32x4*)(src + k); const f32x4 gv = *(const f32x4*)(g + k), sv = *(const f32x4*)(sc + k);
            ss += v.x * v.x + v.y * v.y + v.z * v.z + v.w * v.w;
            u32x2 o; o.x = pk2(v.x * gv.x * (1.f + sv.x), v.y * gv.y * (1.f + sv.y)); o.y = pk2(v.z * gv.z * (1.f + sv.z), v.w * gv.w * (1.f + sv.w));
            *(u32x2*)(xm + (size_t)m * DM + k) = o; }
        ss = wave_sum(ss);
        if (c.lane < 16) rss[(size_t)m * 16 + c.lane] = c.lane == 0 ? ss : 0.f;
    }
}

template <class Epi>
__device__ __forceinline__ void gemm_simple(const Ctx& c, const bf16_t* A, int lda, const bf16_t* Bt, int ldb, int M, int N, int K, const Epi& epi) {
    const int fr = c.lane & 15, fq = c.lane >> 4, wr = c.wid >> 1, wc = c.wid & 1;
    const int tn = N / 128, nt = (M / 128) * tn;
    for (int t = blockIdx.x; t < nt; t += gridDim.x) {
        const int pm = t / tn, pn = t % tn;
        f32x4 acc[2][4];
#pragma unroll
        for (int i = 0; i < 2; ++i)
#pragma unroll
            for (int j = 0; j < 4; ++j) acc[i][j] = (f32x4){0.f, 0.f, 0.f, 0.f};
        const bf16_t* a0 = A + (size_t)(pm * 128 + wr * 32 + fr) * lda + fq * 8;
        const bf16_t* b0 = Bt + (size_t)(pn * 128 + wc * 64 + fr) * ldb + fq * 8;
        for (int k = 0; k < K; k += 32) {
            bf16x8 af[2], bfr[4];
#pragma unroll
            for (int i = 0; i < 2; ++i) af[i] = *(const bf16x8*)(a0 + (size_t)i * 16 * lda + k);
#pragma unroll
            for (int j = 0; j < 4; ++j) bfr[j] = *(const bf16x8*)(b0 + (size_t)j * 16 * ldb + k);
#pragma unroll
            for (int i = 0; i < 2; ++i)
#pragma unroll
                for (int j = 0; j < 4; ++j) acc[i][j] = __builtin_amdgcn_mfma_f32_16x16x32_bf16(bfr[j], af[i], acc[i][j], 0, 0, 0);
        }
#pragma unroll
        for (int i = 0; i < 2; ++i)
#pragma unroll
            for (int j = 0; j < 4; ++j) epi(pm * 128 + wr * 32 + i * 16 + fr, pn * 128 + wc * 64 + j * 16 + 4 * fq, acc[i][j]);
    }
}

struct EpiIn {
    const float* rss; const float* bias; bf16_t* proj; int odd;
    __device__ __forceinline__ void operator()(int row, int col, f32x4 v) const {
        const f32x4* rp = (const f32x4*)(rss + (size_t)row * 16);
        const f32x4 s0 = rp[0], s1 = rp[1], s2 = rp[2], s3 = rp[3];
        const float ss = ((s0.x + s0.y) + (s0.z + s0.w)) + ((s1.x + s1.y) + (s1.z + s1.w)) + ((s2.x + s2.y) + (s2.z + s2.w)) + ((s3.x + s3.y) + (s3.z + s3.w));
        const float rstd = rsqrtf(ss * (1.f / DM) + EPS);
        const f32x4 bv = *(const f32x4*)(bias + (size_t)cond_row(row) * NPROJ + col);
        v = v * rstd + bv;
        const bool act = odd ? (col >= 1536) : ((col >= 1024 && col < 1536) || col >= 2048);
        if (act) { v.x = silu_f(v.x); v.y = silu_f(v.y); v.z = silu_f(v.z); v.w = silu_f(v.w); }
        u32x2 o; o.x = pk2(v.x, v.y); o.y = pk2(v.z, v.w);
        *(u32x2*)(proj + (size_t)row * NPROJ + col) = o;
    }
};
struct EpiOut {
    const float* xold; const float* cold; float* xnew; float* cnew; const float* mods; int skip_ctx;
    __device__ __forceinline__ void operator()(int row, int col, f32x4 v) const {
        bool ic; const size_t off = res_off(row, ic) + col;
        if (ic && skip_ctx) return;
        const f32x4 gt = *(const f32x4*)(mods + (size_t)cond_row(row) * 3072 + 2048 + col);
        const f32x4 o = *(const f32x4*)((ic ? cold : xold) + off);
        *(f32x4*)((ic ? cnew : xnew) + off) = o + gt * v;
    }
};
struct EpiGlu {
    const bf16_t* yg; const bf16_t* proj; const float* bglu; bf16_t* mix;
    __device__ __forceinline__ void operator()(int row, int col, f32x4 v) const {
        const f32x4 b = *(const f32x4*)(bglu + col);
        const u32x2 yw = *(const u32x2*)(yg + (size_t)row * 512 + col), gw = *(const u32x2*)(proj + (size_t)row * NPROJ + 2048 + col);
        const float o0 = bflo(yw.x) * sigmoid_f(v.x + b.x) * bflo(gw.x), o1 = bfhi(yw.x) * sigmoid_f(v.y + b.y) * bfhi(gw.x);
        const float o2 = bflo(yw.y) * sigmoid_f(v.z + b.z) * bflo(gw.y), o3 = bfhi(yw.y) * sigmoid_f(v.w + b.w) * bfhi(gw.y);
        u32x2 o; o.x = pk2(o0, o1); o.y = pk2(o2, o3);
        *(u32x2*)(mix + (size_t)row * DM + 512 + col) = o;
    }
};


template <class E> struct EpiTile {
    static constexpr bool PERM = false, AFTER_DRAIN = false; E e;
    __device__ __forceinline__ void operator()(const pg8::f32x4 (&acc)[2][2][4][2], const pg8::Unit& u, int wr, int wc, int fr, int fq) const {
#pragma unroll
        for (int ai = 0; ai < 2; ++ai)
#pragma unroll
            for (int m = 0; m < 4; ++m) { const int row = u.pm * 256 + ai * 128 + wr * 64 + m * 16 + fr;
#pragma unroll
                for (int bj = 0; bj < 2; ++bj)
#pragma unroll
                    for (int n = 0; n < 2; ++n) e(row, u.pn * 256 + bj * 128 + wc * 32 + n * 16 + 4 * fq, acc[ai][bj][m][n]); }
    }
};
template <class E> __device__ __forceinline__ void gemm_fast(const Ctx& c, const bf16_t* A, const bf16_t* Bt, int M, int N, int K, const E& e) {
    pg8::Gemm g{A, Bt, M, N, K}; pg8::StaticOrder S; S.init(M, N, (int)gridDim.x, (int)blockIdx.x);
    EpiTile<E> E2{e};
    pg8::gemm_phase<EpiTile<E>, pg8::StaticOrder, true, true>((PG8_LAS unsigned char*)c.lds, g, S, E2, c.tid);
    __syncthreads();
}


struct EpiInTile {
    static constexpr bool PERM = true, AFTER_DRAIN = false;
    const float* rss; const float* bias; bf16_t* proj; int odd; const float* qg; const float* kg; const float* rope; float* red;
    __device__ __forceinline__ void operator()(const pg8::f32x4 (&acc)[2][2][4][2], const pg8::Unit& u, int wr, int wc, int fr, int fq) const {
        asm volatile("" : "+v"(fr), "+v"(fq));
        const int pmb = u.pm / 17, jt = u.pm - pmb * 17, r = jt == 0 ? 4 : pmb;
        const int colb = u.pn * 256 + wc * 32 + 8 * fq;
        f32x4 bv[2][2];
#pragma unroll
        for (int bj = 0; bj < 2; ++bj)
#pragma unroll
            for (int n = 0; n < 2; ++n) bv[bj][n] = *(const f32x4*)(bias + (size_t)r * NPROJ + colb + bj * 128 + n * 4);
        float rstd[2][4];
#pragma unroll
        for (int ai = 0; ai < 2; ++ai)
#pragma unroll
            for (int m = 0; m < 4; ++m) { const int row = u.pm * 256 + ai * 128 + wr * 64 + m * 16 + fr;
                const f32x4* rp = (const f32x4*)(rss + (size_t)row * 16);
                const f32x4 s0 = rp[0], s1 = rp[1], s2 = rp[2], s3 = rp[3];
                const float ss = ((s0.x + s0.y) + (s0.z + s0.w)) + ((s1.x + s1.y) + (s1.z + s1.w)) + ((s2.x + s2.y) + (s2.z + s2.w)) + ((s3.x + s3.y) + (s3.z + s3.w));
                float rs_ = rsqrtf(ss * (1.f / DM) + EPS); asm volatile("" : "+v"(rs_) :: "memory"); rstd[ai][m] = rs_; }
        const bool qk = odd && u.pn <= 4;
        if (qk) {
#pragma unroll
            for (int ai = 0; ai < 2; ++ai)
#pragma unroll
                for (int m = 0; m < 4; ++m)
#pragma unroll
                    for (int bj = 0; bj < 2; ++bj) { const f32x4 v0 = acc[ai][bj][m][0] * rstd[ai][m] + bv[bj][0], v1 = acc[ai][bj][m][1] * rstd[ai][m] + bv[bj][1];
                        float s_ = ((v0.x * v0.x + v0.y * v0.y) + (v0.z * v0.z + v0.w * v0.w)) + ((v1.x * v1.x + v1.y * v1.y) + (v1.z * v1.z + v1.w * v1.w));
                        s_ += __shfl_xor(s_, 16); s_ += __shfl_xor(s_, 32);
                        if (fq == 0) red[((ai * 128 + wr * 64 + m * 16 + fr) * 2 + bj) * 4 + wc] = s_; }
            asm volatile("s_waitcnt lgkmcnt(0)" ::: "memory"); __builtin_amdgcn_s_barrier(); asm volatile("" ::: "memory");
        }
        const float* gn = u.pn == 4 ? kg : qg;
        const int a_ = wc >> 1, p0 = (wc & 1) * 16 + fq * 4, d0 = a_ * 64 + p0;
#pragma unroll
        for (int ai = 0; ai < 2; ++ai)
#pragma unroll
            for (int m = 0; m < 4; ++m) { const int rt = ai * 128 + wr * 64 + m * 16 + fr; const int row = u.pm * 256 + rt;
                bf16_t* rowp = proj + (size_t)row * NPROJ + colb;
                f32x4 cs0 = (f32x4){1.f, 0.f, 1.f, 0.f}, cs1 = cs0;
                if (qk && jt != 0) { const int tl = (jt - 1) * 256 + rt; const int pos = a_ == 0 ? (tl >> 6) : (tl & 63); const float* rp = rope + (size_t)(pos * 32 + p0) * 2; cs0 = *(const f32x4*)rp; cs1 = *(const f32x4*)(rp + 4); }
#pragma unroll
                for (int bj = 0; bj < 2; ++bj) { const int c0 = u.pn * 256 + bj * 128;
                    const bool act = odd ? (c0 >= 1536) : ((c0 >= 1024 && c0 < 1536) || c0 >= 2048);
                    f32x4 v0 = acc[ai][bj][m][0] * rstd[ai][m] + bv[bj][0], v1 = acc[ai][bj][m][1] * rstd[ai][m] + bv[bj][1];
                    if (act) { v0.x = silu_f(v0.x); v0.y = silu_f(v0.y); v0.z = silu_f(v0.z); v0.w = silu_f(v0.w); v1.x = silu_f(v1.x); v1.y = silu_f(v1.y); v1.z = silu_f(v1.z); v1.w = silu_f(v1.w); }
                    if (qk) { const f32x4 pr = *(const f32x4*)(red + ((rt) * 2 + bj) * 4);
                        const float hr = rsqrtf(((pr.x + pr.y) + (pr.z + pr.w)) * (1.f / 128.f) + EPS);
                        const f32x4 g1 = *(const f32x4*)(gn + d0), g2 = *(const f32x4*)(gn + d0 + 32);
                        const f32x4 x1 = v0 * hr * g1, x2 = v1 * hr * g2;
                        v0.x = x1.x * cs0.x - x2.x * cs0.y; v1.x = x1.x * cs0.y + x2.x * cs0.x; v0.y = x1.y * cs0.z - x2.y * cs0.w; v1.y = x1.y * cs0.w + x2.y * cs0.z;
                        v0.z = x1.z * cs1.x - x2.z * cs1.y; v1.z = x1.z * cs1.y + x2.z * cs1.x; v0.w = x1.w * cs1.z - x2.w * cs1.w; v1.w = x1.w * cs1.w + x2.w * cs1.z; }
                    u32x4 o; o.x = pk2(v0.x, v0.y); o.y = pk2(v0.z, v0.w); o.z = pk2(v1.x, v1.y); o.w = pk2(v1.z, v1.w); *(u32x4*)(rowp + bj * 128) = o; }
            }
    }
};
struct EpiGluTile {
    static constexpr bool PERM = true, AFTER_DRAIN = false;
    const bf16_t* yg; const bf16_t* proj; const float* bglu; bf16_t* mix;
    __device__ __forceinline__ void operator()(const pg8::f32x4 (&acc)[2][2][4][2], const pg8::Unit& u, int wr, int wc, int fr, int fq) const {
        asm volatile("" : "+v"(fr), "+v"(fq));
        const int colb = u.pn * 256 + wc * 32 + 8 * fq;
        f32x4 bv[2][2];
#pragma unroll
        for (int bj = 0; bj < 2; ++bj)
#pragma unroll
            for (int n = 0; n < 2; ++n) bv[bj][n] = *(const f32x4*)(bglu + colb + bj * 128 + n * 4);
#pragma unroll
        for (int ai = 0; ai < 2; ++ai)
#pragma unroll
            for (int m = 0; m < 4; ++m) { const int row = u.pm * 256 + ai * 128 + wr * 64 + m * 16 + fr;
#pragma unroll
                for (int bj = 0; bj < 2; ++bj) { const int col = colb + bj * 128; const f32x4 v0 = acc[ai][bj][m][0] + bv[bj][0], v1 = acc[ai][bj][m][1] + bv[bj][1];
                    const u32x4 yw = *(const u32x4*)(yg + (size_t)row * 512 + col), gw = *(const u32x4*)(proj + (size_t)row * NPROJ + 2048 + col);
                    u32x4 o; o.x = pk2(bflo(yw.x) * sigmoid_f(v0.x) * bflo(gw.x), bfhi(yw.x) * sigmoid_f(v0.y) * bfhi(gw.x)); o.y = pk2(bflo(yw.y) * sigmoid_f(v0.z) * bflo(gw.y), bfhi(yw.y) * sigmoid_f(v0.w) * bfhi(gw.y));
                    o.z = pk2(bflo(yw.z) * sigmoid_f(v1.x) * bflo(gw.z), bfhi(yw.z) * sigmoid_f(v1.y) * bfhi(gw.z)); o.w = pk2(bflo(yw.w) * sigmoid_f(v1.z) * bflo(gw.w), bfhi(yw.w) * sigmoid_f(v1.w) * bfhi(gw.w));
                    *(u32x4*)(mix + (size_t)row * DM + 512 + col) = o; }
                if (m & 1) asm volatile("" ::: "memory"); }
    }
};
template <class ET> __device__ __forceinline__ void gemm_fast_tile(const Ctx& c, const bf16_t* A, const bf16_t* Bt, int M, int N, int K, const ET& e) {
    pg8::Gemm g{A, Bt, M, N, K}; pg8::StaticOrder S; S.init(M, N, (int)gridDim.x, (int)blockIdx.x);
    pg8::gemm_phase<ET, pg8::StaticOrder, true, true>((PG8_LAS unsigned char*)c.lds, g, S, e, c.tid);
    __syncthreads();
}


struct LatentOrder {
    pg8::StaticOrder s;
    __device__ void init(int N, int G_, int c_) { s.init(NB * SEQ, N, G_, c_); }
    __device__ bool next(int i, pg8::Unit& u) const { if (!s.next(i, u)) return false; u.pm = (u.pm >> 4) * 17 + (u.pm & 15) + 1; return true; }
    __device__ __forceinline__ void a_ready(const pg8::Unit&) const {}
    __device__ __forceinline__ void done(const pg8::Unit&) const {}
};
struct EpiOutTile {
    static constexpr bool PERM = true, AFTER_DRAIN = false;
    const float* xold; float* xnew; const float* mods; const float* mods_next; const float* gnext; bf16_t* xm; float* rss;
    __device__ __forceinline__ void operator()(const pg8::f32x4 (&acc)[2][2][4][2], const pg8::Unit& u, int wr, int wc, int fr, int fq) const {
        asm volatile("" : "+v"(fr), "+v"(fq));
        const int b = u.pm / 17, j = u.pm - b * 17;
        const int colb = u.pn * 256 + wc * 32 + 8 * fq;
        const size_t off0 = ((size_t)b * SEQ + (j - 1) * 256 + wr * 64 + fr) * DM + colb;
        const size_t row0 = (size_t)u.pm * 256 + wr * 64 + fr;
        float ss[2][4];
#pragma unroll
        for (int ai = 0; ai < 2; ++ai)
#pragma unroll
            for (int m = 0; m < 4; ++m) ss[ai][m] = 0.f;
#define EPI_OUT_BATCH(BJ, AI0, NAI) do { \
            f32x4 xo[NAI][4][2]; \
            _Pragma("unroll") for (int a_ = 0; a_ < NAI; ++a_) _Pragma("unroll") for (int m = 0; m < 4; ++m) { const float* xp = xold + off0 + (size_t)((AI0 + a_) * 128 + m * 16) * DM + BJ * 128; xo[a_][m][0] = *(const f32x4*)xp; xo[a_][m][1] = *(const f32x4*)(xp + 4); } \
            const int col = colb + BJ * 128; \
            const f32x4 gt0 = *(const f32x4*)(mods + (size_t)b * 3072 + 2048 + col), gt1 = *(const f32x4*)(mods + (size_t)b * 3072 + 2048 + col + 4); \
            f32x4 an0 = (f32x4){0.f, 0.f, 0.f, 0.f}, an1 = an0; \
            if (mods_next) { an0 = *(const f32x4*)(gnext + col) * (*(const f32x4*)(mods_next + (size_t)b * 3072 + 1024 + col) + 1.f); an1 = *(const f32x4*)(gnext + col + 4) * (*(const f32x4*)(mods_next + (size_t)b * 3072 + 1024 + col + 4) + 1.f); } \
            _Pragma("unroll") for (int a_ = 0; a_ < NAI; ++a_) _Pragma("unroll") for (int m = 0; m < 4; ++m) { const int ai = AI0 + a_; \
                    const f32x4 x0 = xo[a_][m][0] + gt0 * acc[ai][BJ][m][0], x1 = xo[a_][m][1] + gt1 * acc[ai][BJ][m][1]; \
                    float* xp = xnew + off0 + (size_t)(ai * 128 + m * 16) * DM + BJ * 128; *(f32x4*)xp = x0; *(f32x4*)(xp + 4) = x1; \
                    ss[ai][m] += ((x0.x * x0.x + x0.y * x0.y) + (x0.z * x0.z + x0.w * x0.w)) + ((x1.x * x1.x + x1.y * x1.y) + (x1.z * x1.z + x1.w * x1.w)); \
                    if (mods_next) { const f32x4 h0 = x0 * an0, h1 = x1 * an1; u32x4 w; w.x = pk2(h0.x, h0.y); w.y = pk2(h0.z, h0.w); w.z = pk2(h1.x, h1.y); w.w = pk2(h1.z, h1.w); \
                        *(u32x4*)(xm + (row0 + ai * 128 + m * 16) * DM + col) = w; } } \
            asm volatile("" ::: "memory"); } while (0)
        EPI_OUT_BATCH(0, 0, 1); EPI_OUT_BATCH(0, 1, 1); EPI_OUT_BATCH(1, 0, 1); EPI_OUT_BATCH(1, 1, 1);
#undef EPI_OUT_BATCH
        if (mods_next) {
#pragma unroll
            for (int ai = 0; ai < 2; ++ai)
#pragma unroll
                for (int m = 0; m < 4; ++m) { float s_ = ss[ai][m]; s_ += __shfl_xor(s_, 16); s_ += __shfl_xor(s_, 32); if (fq == 0) rss[(row0 + ai * 128 + m * 16) * 16 + u.pn * 4 + wc] = s_; }
        }
    }
};
__device__ __forceinline__ void out_ctx_small(const Ctx& c, int l, const float* cold, float* cnew) {
    const P& p = *c.p;
    const bf16_t* mix = (const bf16_t*)(p.ws + WS_MIX); const bf16_t* wt = (const bf16_t*)(p.ws + WS_WOUT) + (size_t)l * DM * DM;
    const float* mods = (const float*)(p.ws + WS_MODS) + (size_t)l * 5 * 3072 + 4 * 3072; const float* modsn = (const float*)(p.ws + WS_MODS) + (size_t)(l + 1) * 5 * 3072 + 4 * 3072;
    const float* gnext = p.in[4] + (l + 1) * DM; bf16_t* xm = (bf16_t*)(p.ws + WS_XM); float* rss = (float*)(p.ws + WS_RSS);
    const int wid = __builtin_amdgcn_readfirstlane(c.wid), fr = c.lane & 15, fq = c.lane >> 4, rg = wid & 3, kh = wid >> 2;
    float* red = (float*)c.lds;
    for (int t = blockIdx.x; t < 256; t += gridDim.x) {
        const int rm = t >> 4, cn = t & 15;
        const int cr = rm * 64 + rg * 16 + fr, b = cr >> 8, ti = cr & 255;
        const size_t m = (size_t)b * TPB + ti;
        f32x4 acc[4];
#pragma unroll
        for (int q = 0; q < 4; ++q) acc[q] = (f32x4){0.f, 0.f, 0.f, 0.f};
        const bf16_t* a0 = mix + m * DM + kh * 512 + fq * 8; const bf16_t* b0 = wt + (size_t)(cn * 64 + fr) * DM + kh * 512 + fq * 8;
#pragma unroll 4
        for (int k = 0; k < 512; k += 32) { const bf16x8 af = *(const bf16x8*)(a0 + k);
#pragma unroll
            for (int q = 0; q < 4; ++q) { const bf16x8 bf = *(const bf16x8*)(b0 + (size_t)q * 16 * DM + k); acc[q] = __builtin_amdgcn_mfma_f32_16x16x32_bf16(bf, af, acc[q], 0, 0, 0); } }
        __syncthreads();
        if (kh == 1) {
#pragma unroll
            for (int q = 0; q < 4; ++q) *(f32x4*)(red + ((rg * 64 + c.lane) * 4 + q) * 4) = acc[q]; }
        __syncthreads();
        if (kh == 0) {
            float ss = 0.f; const size_t off = ((size_t)b * NCTX + ti) * DM;
#pragma unroll
            for (int q = 0; q < 4; ++q) { const int col = cn * 64 + q * 16 + 4 * fq;
                const f32x4 a2 = acc[q] + *(const f32x4*)(red + ((rg * 64 + c.lane) * 4 + q) * 4);
                const f32x4 gt = *(const f32x4*)(mods + 2048 + col), sc = *(const f32x4*)(modsn + 1024 + col), gv = *(const f32x4*)(gnext + col);
                const f32x4 o = *(const f32x4*)(cold + off + col); const f32x4 xn = o + gt * a2;
                *(f32x4*)(cnew + off + col) = xn; ss += (xn.x * xn.x + xn.y * xn.y) + (xn.z * xn.z + xn.w * xn.w);
                const f32x4 h = xn * gv * (sc + 1.f); u32x2 w; w.x = pk2(h.x, h.y); w.y = pk2(h.z, h.w); *(u32x2*)(xm + m * DM + col) = w; }
            ss += __shfl_xor(ss, 16); ss += __shfl_xor(ss, 32); if (fq == 0) rss[m * 16 + cn] = ss;
        }
    }
    __syncthreads();
}

__device__ __forceinline__ void phase_in(const Ctx& c, int l) {
    const P& p = *c.p;
    EpiIn e{(const float*)(p.ws + WS_RSS), (const float*)(p.ws + WS_BIAS) + (size_t)l * 5 * NPROJ, (bf16_t*)(p.ws + WS_PROJ), l & 1};
    #ifdef USE_PG8
    { const int i_ = l >> 1; EpiInTile et{e.rss, e.bias, e.proj, e.odd, p.in[24] + i_ * 128, p.in[25] + i_ * 128, (const float*)(p.ws + WS_ROPE), (float*)(c.lds + 131072)}; gemm_fast_tile(c, (const bf16_t*)(p.ws + WS_XM), (const bf16_t*)(p.ws + WS_WIN) + (size_t)l * NPROJ * DM, MTOK, NPROJ, DM, et); }
#else
    gemm_simple(c, (const bf16_t*)(p.ws + WS_XM), DM, (const bf16_t*)(p.ws + WS_WIN) + (size_t)l * NPROJ * DM, DM, MTOK, NPROJ, DM, e);
#endif
}
__device__ __forceinline__ void phase_out(const Ctx& c, int l) {
    const P& p = *c.p;
    float* cres = (float*)(p.ws + WS_CTXRES);
    const bool last = l == DEPTH - 1;
    EpiOutTile e{l == 0 ? p.in[0] : p.out, p.out, (const float*)(p.ws + WS_MODS) + (size_t)l * 5 * 3072, last ? nullptr : (const float*)(p.ws + WS_MODS) + (size_t)(l + 1) * 5 * 3072,
                 last ? nullptr : p.in[4] + (l + 1) * DM, (bf16_t*)(p.ws + WS_XM), (float*)(p.ws + WS_RSS)};
    pg8::Gemm g{(const bf16_t*)(p.ws + WS_MIX), (const bf16_t*)(p.ws + WS_WOUT) + (size_t)l * DM * DM, MTOK, DM, DM};
    LatentOrder S; S.init(DM, (int)gridDim.x, (int)blockIdx.x);
    pg8::gemm_phase<EpiOutTile, LatentOrder, true, true>((PG8_LAS unsigned char*)c.lds, g, S, e, c.tid);
    __syncthreads();
    if (!last) out_ctx_small(c, l, l == 0 ? p.in[2] : cres, cres);
}
__device__ __forceinline__ void phase_glu(const Ctx& c, int l) {
    const P& p = *c.p; const int i = l >> 1;
    EpiGlu e{(const bf16_t*)(p.ws + WS_YG), (const bf16_t*)(p.ws + WS_PROJ), p.in[21] + i * 512, (bf16_t*)(p.ws + WS_MIX)};
    #ifdef USE_PG8
    { EpiGluTile et{e.yg, e.proj, e.bglu, e.mix}; gemm_fast_tile(c, (const bf16_t*)(p.ws + WS_YG), (const bf16_t*)(p.ws + WS_WGLU) + (size_t)i * 512 * 512, MTOK, 512, 512, et); }
#else
    gemm_simple(c, (const bf16_t*)(p.ws + WS_YG), 512, (const bf16_t*)(p.ws + WS_WGLU) + (size_t)i * 512 * 512, 512, MTOK, 512, 512, e);
#endif
}

__device__ __forceinline__ void phase_gmlp(const Ctx& c, int l) {
    const P& p = *c.p; const int i = l >> 1;
    const bf16_t* proj = (const bf16_t*)(p.ws + WS_PROJ); bf16_t* mix = (bf16_t*)(p.ws + WS_MIX);
    const float* vg = p.in[9] + i * 512; const float* ws_ = p.in[10] + (size_t)i * 4 * 128 * 128; const float* bs = p.in[11] + i * 4 * 128;
    float* vn = (float*)c.lds;
    for (int it = blockIdx.x; it < 136 * 4; it += gridDim.x) {
        const int ch = it >> 2, g = it & 3;
        __syncthreads();
        for (int q = c.wid; q < 128; q += NWAVES) {
            const size_t row = (size_t)ch * 128 + q;
            const u32x4 w = *(const u32x4*)(proj + row * NPROJ + 512 + c.lane * 8);
            float v[8] = {bflo(w.x), bfhi(w.x), bflo(w.y), bfhi(w.y), bflo(w.z), bfhi(w.z), bflo(w.w), bfhi(w.w)};
            float s = 0.f;
#pragma unroll
            for (int e = 0; e < 8; ++e) s += v[e];
            const float mu = wave_sum(s) * (1.f / 512.f); float s2 = 0.f;
#pragma unroll
            for (int e = 0; e < 8; ++e) { v[e] -= mu; s2 += v[e] * v[e]; }
            const float rstd = rsqrtf(wave_sum(s2) * (1.f / 512.f) + EPS);
            if ((c.lane >> 4) == g) {
#pragma unroll
                for (int e = 0; e < 8; ++e) { const int cc = (c.lane & 15) * 8 + e; vn[q * 129 + cc] = v[e] * rstd * vg[g * 128 + cc]; }
            }
        }
        __syncthreads();
        const int cc = c.tid & 127, pq = c.tid >> 7;
        for (int pp = pq * 32; pp < pq * 32 + 32; ++pp) {
            const float* wrow = ws_ + ((size_t)g * 128 + pp) * 128;
            float acc = 0.f;
#pragma unroll 8
            for (int q = 0; q < 128; ++q) acc += wrow[q] * vn[q * 129 + cc];
            const float mixed = acc + bs[g * 128 + pp];
            const size_t row = (size_t)ch * 128 + pp;
            const float u = bf2f(proj[row * NPROJ + g * 128 + cc]), ga = bf2f(proj[row * NPROJ + 1024 + g * 128 + cc]);
            mix[row * DM + g * 128 + cc] = (bf16_t)f2bf(u * mixed * ga);
        }
    }
}

__device__ __forceinline__ void phase_s5_naive(const Ctx& c, int l) {
    const P& p = *c.p; const int i = l >> 1;
    const bf16_t* proj = (const bf16_t*)(p.ws + WS_PROJ);
    float* red = (float*)(c.lds + 80 * 1024) + c.wid * 1024;
    for (int it = c.gw; it < NB * 32 * 2; it += c.ngw) {
        const int dir = it & 1, g = (it >> 1) & 31, b = it >> 6, pl = c.lane;
        float* Y = (float*)(p.ws + (dir ? WS_XM : WS_S5));
        const size_t dg = ((size_t)(i * 2 + dir) * 32 + g);
        const float dt = expf(p.in[14][dg]);
        const float lr = p.in[12][dg * 64 + pl], li = p.in[13][dg * 64 + pl];
        const float mag = expf(lr * dt), lbr = mag * cosf(li * dt), lbi = mag * sinf(li * dt);
        const float den = lr * lr + li * li, nre = lbr - 1.f, nim = lbi;
        const float fre = (nre * lr + nim * li) / den, fim = (nim * lr - nre * li) / den;
        float bbr[16], bbi[16], cr[16], ci[16];
#pragma unroll
        for (int h = 0; h < 16; ++h) { const float br = p.in[15][(dg * 64 + pl) * 16 + h], bi = p.in[16][(dg * 64 + pl) * 16 + h];
            bbr[h] = fre * br - fim * bi; bbi[h] = fre * bi + fim * br;
            cr[h] = p.in[17][(dg * 16 + h) * 64 + pl]; ci[h] = p.in[18][(dg * 16 + h) * 64 + pl]; }
        float hr = 0.f, hi = 0.f;
        for (int s0 = 0; s0 < TPB; s0 += 4) {
            u32x4 uw[4][2];
#pragma unroll
            for (int j = 0; j < 4; ++j) { const int s = s0 + j; const int t = dir == 0 ? s : (s < NCTX ? NCTX - 1 - s : NCTX + SEQ - 1 - (s - NCTX));
                const bf16_t* up = proj + (size_t)(b * TPB + t) * NPROJ + 1536 + g * 16; uw[j][0] = *(const u32x4*)up; uw[j][1] = *(const u32x4*)(up + 8); }
#pragma unroll
            for (int j = 0; j < 4; ++j) { const int s = s0 + j; const int t = dir == 0 ? s : (s < NCTX ? NCTX - 1 - s : NCTX + SEQ - 1 - (s - NCTX));
                float u[16];
#pragma unroll
                for (int q = 0; q < 2; ++q) { u[8 * q + 0] = bflo(uw[j][q].x); u[8 * q + 1] = bfhi(uw[j][q].x); u[8 * q + 2] = bflo(uw[j][q].y); u[8 * q + 3] = bfhi(uw[j][q].y);
                    u[8 * q + 4] = bflo(uw[j][q].z); u[8 * q + 5] = bfhi(uw[j][q].z); u[8 * q + 6] = bflo(uw[j][q].w); u[8 * q + 7] = bfhi(uw[j][q].w); }
                float bur = 0.f, bui = 0.f;
#pragma unroll
                for (int h = 0; h < 16; ++h) { bur += bbr[h] * u[h]; bui += bbi[h] * u[h]; }
                const float nhr = lbr * hr - lbi * hi + bur, nhi = lbr * hi + lbi * hr + bui; hr = nhr; hi = nhi;
#pragma unroll
                for (int h = 0; h < 16; ++h) red[h * 64 + pl] = cr[h] * hr - ci[h] * hi;
                asm volatile("s_waitcnt lgkmcnt(0)" ::: "memory");
                const int hh = pl & 15, part = pl >> 4; float sum = 0.f;
#pragma unroll
                for (int q = 0; q < 16; ++q) sum += red[hh * 64 + part * 16 + q];
                sum += __shfl_xor(sum, 16); sum += __shfl_xor(sum, 32);
                if (pl < 16) Y[(size_t)(b * TPB + t) * 512 + g * 16 + pl] = sum;
                asm volatile("s_waitcnt lgkmcnt(0)" ::: "memory");
            }
        }
    }
}
__device__ __forceinline__ void phase_s5comb(const Ctx& c, int l) {
    const P& p = *c.p; const int i = l >> 1;
    const float* Yf = (const float*)(p.ws + WS_S5); const float* Yb = (const float*)(p.ws + WS_XM); const bf16_t* proj = (const bf16_t*)(p.ws + WS_PROJ);
    bf16_t* yg = (bf16_t*)(p.ws + WS_YG); const float* d = p.in[19] + i * 512;
    const size_t n4 = (size_t)MTOK * 512 / 4;
    for (size_t e = (size_t)blockIdx.x * NTHREADS + c.tid; e < n4; e += (size_t)gridDim.x * NTHREADS) {
        const size_t row = e / 128; const int col = (int)(e % 128) * 4;
        const f32x4 a = *(const f32x4*)(Yf + row * 512 + col), b = *(const f32x4*)(Yb + row * 512 + col), dv = *(const f32x4*)(d + col);
        const u32x2 xw = *(const u32x2*)(proj + row * NPROJ + 1536 + col);
        const float y0 = a.x + b.x + dv.x * bflo(xw.x), y1 = a.y + b.y + dv.y * bfhi(xw.x), y2 = a.z + b.z + dv.z * bflo(xw.y), y3 = a.w + b.w + dv.w * bfhi(xw.y);
        u32x2 o; o.x = pk2(gelu_tanh_f(y0), gelu_tanh_f(y1)); o.y = pk2(gelu_tanh_f(y2), gelu_tanh_f(y3));
        *(u32x2*)(yg + row * 512 + col) = o;
    }
}


constexpr size_t S5T_LAM = 0, S5T_BBT = 64 * 1024, S5T_CMT = 320 * 1024;
constexpr size_t WS_WST = WS_S5 + 2 * MiB;
constexpr size_t WS_SCB = WS_S5 + 5 * MiB;
constexpr size_t WS_SR = WS_S5 + 10 * MiB;
typedef float f32x16 __attribute__((ext_vector_type(16)));

__device__ __forceinline__ void phase_s5prep(const Ctx& c) {
    const P& p = *c.p;
    for (int it = c.gw; it < 2 * 2 * 32; it += c.ngw) {
        const int i = it >> 6, dir = (it >> 5) & 1, g = it & 31, pl = c.lane;
        unsigned char* tb = p.ws + WS_S5 + (size_t)i * MiB;
        const size_t dg = ((size_t)(i * 2 + dir) * 32 + g);
        const float dt = expf(p.in[14][dg]);
        const float lr = p.in[12][dg * 64 + pl], li = p.in[13][dg * 64 + pl];
        const float mag = expf(lr * dt), lbr = mag * cosf(li * dt), lbi = mag * sinf(li * dt);
        const float den = lr * lr + li * li, nre = lbr - 1.f, nim = lbi;
        const float fre = (nre * lr + nim * li) / den, fim = (nim * lr - nre * li) / den;
        float* lam = (float*)(tb + S5T_LAM) + ((size_t)(dir * 32 + g) * 64 + pl) * 2; lam[0] = lbr; lam[1] = lbi;
        bf16_t* bbt = (bf16_t*)(tb + S5T_BBT) + (size_t)(dir * 32 + g) * 2 * 64 * 16; bf16_t* cmt = (bf16_t*)(tb + S5T_CMT) + (size_t)(dir * 32 + g) * 16 * 128;
#pragma unroll
        for (int h = 0; h < 16; ++h) { const float br = p.in[15][(dg * 64 + pl) * 16 + h], bi = p.in[16][(dg * 64 + pl) * 16 + h];
            bbt[(0 * 64 + pl) * 16 + h] = (bf16_t)f2bf(fre * br - fim * bi); bbt[(1 * 64 + pl) * 16 + h] = (bf16_t)f2bf(fre * bi + fim * br);
            cmt[h * 128 + 2 * pl] = (bf16_t)f2bf(p.in[17][(dg * 16 + h) * 64 + pl]); cmt[h * 128 + 2 * pl + 1] = (bf16_t)f2bf(-p.in[18][(dg * 16 + h) * 64 + pl]); }
    }
    bf16_t* wst = (bf16_t*)(p.ws + WS_WST);
    for (size_t e = (size_t)blockIdx.x * NTHREADS + c.tid; e < (size_t)2 * 4 * 128 * 128 / 4; e += (size_t)gridDim.x * NTHREADS) {
        const f32x4 v = *(const f32x4*)(p.in[10] + e * 4); u32x2 o; o.x = pk2(v.x, v.y); o.y = pk2(v.z, v.w); *(u32x2*)(wst + e * 4) = o; }
}

__device__ __forceinline__ void phase_gmlp_fast(const Ctx& c, int l) {
    const P& p = *c.p; const int i = l >> 1;
    const bf16_t* proj = (const bf16_t*)(p.ws + WS_PROJ); bf16_t* mix = (bf16_t*)(p.ws + WS_MIX);
    const float* vg = p.in[9] + i * 512; const float* bs = p.in[11] + i * 4 * 128;
    const bf16_t* wst = (const bf16_t*)(p.ws + WS_WST) + (size_t)i * 4 * 128 * 128;
    char* lds = (char*)c.lds;
    float* st = (float*)(lds + 32768);
    const int wid = __builtin_amdgcn_readfirstlane(c.wid), lane = c.lane, r32 = lane & 31, hi = lane >> 5;
    char* ost = lds + 36864 + wid * 4608;
    for (int it = blockIdx.x; it < 136 * 4; it += gridDim.x) {
        const int ch = it >> 2, g = it & 3;
        __syncthreads();
        for (int q = wid; q < 128; q += NWAVES) {
            const u32x4 w = *(const u32x4*)(proj + ((size_t)ch * 128 + q) * NPROJ + 512 + lane * 8);
            float v[8] = {bflo(w.x), bfhi(w.x), bflo(w.y), bfhi(w.y), bflo(w.z), bfhi(w.z), bflo(w.w), bfhi(w.w)};
            float s1 = 0.f;
#pragma unroll
            for (int e = 0; e < 8; ++e) s1 += v[e];
            const float mu = wave_sum(s1) * (1.f / 512.f); float s2 = 0.f;
#pragma unroll
            for (int e = 0; e < 8; ++e) { v[e] -= mu; s2 += v[e] * v[e]; }
            const float rstd = rsqrtf(wave_sum(s2) * (1.f / 512.f) + EPS);
            if (lane == 0) { st[2 * q] = mu; st[2 * q + 1] = rstd; }
        }
        __syncthreads();
        { const int sr = c.tid >> 4, sc = (c.tid & 15) * 8;
            float gv[8];
#pragma unroll
            for (int e = 0; e < 8; ++e) gv[e] = vg[g * 128 + sc + e];
#pragma unroll
            for (int t = 0; t < 2; ++t)
#pragma unroll
                for (int hh = 0; hh < 2; ++hh) { const int q = t * 64 + hh * 32 + sr;
                    const u32x4 w = *(const u32x4*)(proj + ((size_t)ch * 128 + q) * NPROJ + 512 + g * 128 + sc);
                    const float mu = st[2 * q], rs = st[2 * q + 1];
                    u32x4 o; o.x = pk2((bflo(w.x) - mu) * rs * gv[0], (bfhi(w.x) - mu) * rs * gv[1]); o.y = pk2((bflo(w.y) - mu) * rs * gv[2], (bfhi(w.y) - mu) * rs * gv[3]);
                    o.z = pk2((bflo(w.z) - mu) * rs * gv[4], (bfhi(w.z) - mu) * rs * gv[5]); o.w = pk2((bflo(w.w) - mu) * rs * gv[6], (bfhi(w.w) - mu) * rs * gv[7]);
                    *(u32x4*)(lds + t * 16384 + attn::v_st(hh * 32 + sr, sc)) = o; }
        }
        __syncthreads();
        const int pw = wid & 3, cw = wid >> 2;
        f32x16 o0 = {}, o1 = {};
        const int vb = (int)(uintptr_t)lds + attn::v_rd_base(lane);
        const bf16_t* wrow = wst + ((size_t)g * 128 + pw * 32 + r32) * 128 + hi * 8;
#pragma unroll
        for (int t = 0; t < 2; ++t) {
            const bf16x8 pa0 = *(const bf16x8*)(wrow + t * 64), pa1 = *(const bf16x8*)(wrow + t * 64 + 16), pa2 = *(const bf16x8*)(wrow + t * 64 + 32), pa3 = *(const bf16x8*)(wrow + t * 64 + 48);
            if (cw == 0) { attn::pv_one<0>(o0, vb + t * 16384, pa0, pa1, pa2, pa3); attn::pv_one<1>(o1, vb + t * 16384, pa0, pa1, pa2, pa3); }
            else         { attn::pv_one<2>(o0, vb + t * 16384, pa0, pa1, pa2, pa3); attn::pv_one<3>(o1, vb + t * 16384, pa0, pa1, pa2, pa3); }
        }
        {
            int ob = hi * (4 * 144) + r32 * 2; asm volatile("" : "+v"(ob));
#pragma unroll
            for (int r = 0; r < 16; ++r) { const int prow0 = (r & 3) + 8 * (r >> 2); const float b = bs[g * 128 + pw * 32 + prow0 + 4 * hi];
                *(bf16_t*)(ost + ob + prow0 * 144) = (bf16_t)f2bf(o0[r] + b); *(bf16_t*)(ost + ob + prow0 * 144 + 64) = (bf16_t)f2bf(o1[r] + b); }
            asm volatile("s_waitcnt lgkmcnt(0)" ::: "memory");
#pragma unroll
            for (int k = 0; k < 4; ++k) { const int id = k * 64 + lane, row = id >> 3, chk = id & 7;
                const u32x4 mv = *(const u32x4*)(ost + row * 144 + chk * 16);
                const size_t grow = (size_t)ch * 128 + pw * 32 + row; const int col = g * 128 + cw * 64 + chk * 8;
                const u32x4 uv = *(const u32x4*)(proj + grow * NPROJ + col), gvv = *(const u32x4*)(proj + grow * NPROJ + 1024 + col);
                u32x4 w; w.x = pk2(bflo(uv.x) * bflo(mv.x) * bflo(gvv.x), bfhi(uv.x) * bfhi(mv.x) * bfhi(gvv.x)); w.y = pk2(bflo(uv.y) * bflo(mv.y) * bflo(gvv.y), bfhi(uv.y) * bfhi(mv.y) * bfhi(gvv.y));
                w.z = pk2(bflo(uv.z) * bflo(mv.z) * bflo(gvv.z), bfhi(uv.z) * bfhi(mv.z) * bfhi(gvv.z)); w.w = pk2(bflo(uv.w) * bflo(mv.w) * bflo(gvv.w), bfhi(uv.w) * bfhi(mv.w) * bfhi(gvv.w));
                *(u32x4*)(mix + grow * DM + col) = w; }
            asm volatile("s_waitcnt lgkmcnt(0)" ::: "memory");
        }
    }
}

struct cplx { float r, i; };
__device__ __forceinline__ cplx cmul(cplx a, cplx b) { return {a.r * b.r - a.i * b.i, a.r * b.i + a.i * b.r}; }
__device__ __forceinline__ cplx cfma(cplx a, cplx x, cplx b) { return {fmaf(a.r, x.r, fmaf(-a.i, x.i, b.r)), fmaf(a.r, x.i, fmaf(a.i, x.r, b.i))}; }
__device__ __forceinline__ cplx csel(bool s, cplx a, cplx b) { return {s ? a.r : b.r, s ? a.i : b.i}; }
template <bool BWD, bool FINAL>
__device__ __forceinline__ void s5_chunk_scan(f32x16 (&br)[2], f32x16 (&bi)[2], const cplx lam, const cplx Hin, const bool half, cplx& Hout) {
    const cplx lam2 = cmul(lam, lam), lam3 = cmul(lam2, lam), lam4 = cmul(lam2, lam2);
    cplx E[2][4];
#pragma unroll
    for (int tb = 0; tb < 2; ++tb)
#pragma unroll
        for (int q = 0; q < 4; ++q) {
            if (!BWD) { cplx w = {br[tb][4 * q], bi[tb][4 * q]};
#pragma unroll
                for (int j = 1; j < 4; ++j) { w = cfma(lam, w, (cplx){br[tb][4 * q + j], bi[tb][4 * q + j]}); br[tb][4 * q + j] = w.r; bi[tb][4 * q + j] = w.i; }
                E[tb][q] = w; }
            else { cplx w = {br[tb][4 * q + 3], bi[tb][4 * q + 3]};
#pragma unroll
                for (int j = 2; j >= 0; --j) { w = cfma(lam, w, (cplx){br[tb][4 * q + j], bi[tb][4 * q + j]}); br[tb][4 * q + j] = w.r; bi[tb][4 * q + j] = w.i; }
                E[tb][q] = w; }
        }
    cplx Eev[2][4], Eod[2][4];
#pragma unroll
    for (int tb = 0; tb < 2; ++tb)
#pragma unroll
        for (int q = 0; q < 4; ++q) { const cplx Ep = {__shfl_xor(E[tb][q].r, 32), __shfl_xor(E[tb][q].i, 32)}; Eev[tb][q] = csel(half, Ep, E[tb][q]); Eod[tb][q] = csel(half, E[tb][q], Ep); }
    cplx H = Hin; cplx Hg[2][4];
    if (!BWD) {
#pragma unroll
        for (int tb = 0; tb < 2; ++tb)
#pragma unroll
            for (int q = 0; q < 4; ++q) { const cplx He = H; H = cfma(lam4, H, Eev[tb][q]); const cplx Ho = H; H = cfma(lam4, H, Eod[tb][q]); Hg[tb][q] = csel(half, Ho, He); }
    } else {
#pragma unroll
        for (int tb = 1; tb >= 0; --tb)
#pragma unroll
            for (int q = 3; q >= 0; --q) { const cplx Ho = H; H = cfma(lam4, H, Eod[tb][q]); const cplx He = H; H = cfma(lam4, H, Eev[tb][q]); Hg[tb][q] = csel(half, Ho, He); }
    }
    Hout = H;
    if (FINAL) {
#pragma unroll
        for (int tb = 0; tb < 2; ++tb)
#pragma unroll
            for (int q = 0; q < 4; ++q)
#pragma unroll
                for (int j = 0; j < 4; ++j) { const int e = BWD ? 3 - j : j; const cplx pw = e == 0 ? lam : (e == 1 ? lam2 : (e == 2 ? lam3 : lam4));
                    const cplx h = cfma(pw, Hg[tb][q], (cplx){br[tb][4 * q + j], bi[tb][4 * q + j]}); br[tb][4 * q + j] = h.r; bi[tb][4 * q + j] = h.i; }
    }
}
__device__ __forceinline__ cplx cpow2n(cplx a, int n) { for (int k = 0; k < n; ++k) a = cmul(a, a); return a; }
__device__ __forceinline__ cplx ldc(const float* p) { const float2 v = *(const float2*)p; return {v.x, v.y}; }

__device__ __forceinline__ int s5_rs(int rk) { return rk == 0 ? 0 : (rk <= 4 ? 4 + 5 * (rk - 1) : 24 + 4 * (rk - 5)); }
__device__ __forceinline__ int s5_rl(int rk) { return (rk >= 1 && rk <= 4) ? 5 : 4; }
constexpr int S5L_LAM = 0, S5L_BB = 1024, S5L_CM = 1024 + 8192, S5L_HS = 1024 + 16384, S5L_HB = S5L_HS + 8 * 4608, S5L_END = S5L_HB + 8 * 2560;
template <bool OUT>
__device__ __forceinline__ void phase_s5_fast(const Ctx& c, int l) {
    const P& p = *c.p; const int i = l >> 1;
    const bf16_t* proj = (const bf16_t*)(p.ws + WS_PROJ);
    const unsigned char* tb_ = p.ws + WS_S5 + (size_t)i * MiB;
    float* SCB = (float*)(p.ws + WS_SCB); float* SR = (float*)(p.ws + WS_SR); bf16_t* yg = (bf16_t*)(p.ws + WS_YG);
    const int wid = __builtin_amdgcn_readfirstlane(c.wid);
    char* lds = (char*)c.lds;
    const int G = gridDim.x, nsub = G >> 5;
    if ((int)blockIdx.x >= nsub * 32) return;
    const int g = blockIdx.x & 31, sub = blockIdx.x >> 5;
    __syncthreads();
    {
        const float* LAM = (const float*)(tb_ + S5T_LAM); const bf16_t* BBT = (const bf16_t*)(tb_ + S5T_BBT); const bf16_t* CMT = (const bf16_t*)(tb_ + S5T_CMT);
        const int ln = c.lane, r32 = ln & 31, hi = ln >> 5;
        if (c.tid < 128) { const int d = c.tid >> 6, ps = c.tid & 63; *(float2*)(lds + S5L_LAM + (d * 64 + ps) * 8) = *(const float2*)(LAM + ((size_t)(d * 32 + g) * 64 + ps) * 2); }
        { const int d = wid >> 2, ri = (wid >> 1) & 1, pb = wid & 1;
            *(u32x4*)(lds + S5L_BB + (wid * 64 + ln) * 16) = *(const u32x4*)(BBT + (((size_t)(d * 32 + g) * 2 + ri) * 64 + pb * 32 + r32) * 16 + hi * 8); }
        { const int d = wid >> 2, pb = (wid >> 1) & 1, ks = wid & 1;
            *(u32x4*)(lds + S5L_CM + (wid * 64 + ln) * 16) = *(const u32x4*)(CMT + ((size_t)(d * 32 + g) * 16 + (ln & 15)) * 128 + pb * 64 + ks * 32 + (ln >> 4) * 8); }
    }
    __syncthreads();
    char* hs = lds + S5L_HS + wid * 4608;
#pragma unroll 1
    for (int j = sub * 8 + wid; j < 64; j += nsub * 8) {
        int lane = c.lane; asm volatile("" : "+v"(lane));
        const int r32 = lane & 31; const bool half = lane >= 32;
        const int b = j >> 4, rk = j & 15, c0 = s5_rs(rk), nc = s5_rl(rk);
        const size_t m0 = (size_t)b * TPB + 64 * c0;
        cplx Hf[2];
        float* hb = (float*)(lds + S5L_HB + wid * 2560);
        cplx SRf[2], SRb[2], pwb[2];
#pragma unroll
        for (int pb = 0; pb < 2; ++pb) { Hf[pb] = {0.f, 0.f}; SRf[pb] = {0.f, 0.f}; SRb[pb] = {0.f, 0.f}; pwb[pb] = {1.f, 0.f};
}
        if (OUT) {
#pragma unroll
            for (int pb = 0; pb < 2; ++pb) { const int ps = pb * 32 + r32;
                const float* srb = SR + (((size_t)(b * 16) * 32 + g) * 2 * 64 + ps) * 2;
                constexpr size_t KS = 32 * 2 * 64 * 2;
                { const cplx L64 = cpow2n(ldc((const float*)(lds + S5L_LAM + (0 * 64 + ps) * 8)), 6), L256 = cpow2n(L64, 2), L320 = cmul(L256, L64);
                    cplx v[15];
#pragma unroll
                    for (int kk = 0; kk < 15; ++kk) v[kk] = ldc(srb + kk * KS);
                    cplx H = {0.f, 0.f};
#pragma unroll
                    for (int kk = 0; kk < 15; ++kk) if (kk < rk) H = cfma((kk >= 1 && kk <= 4) ? L320 : L256, H, v[kk]);
                    Hf[pb] = H; }
                { const cplx L64 = cpow2n(ldc((const float*)(lds + S5L_LAM + (1 * 64 + ps) * 8)), 6), L256 = cpow2n(L64, 2), L320 = cmul(L256, L64);
                    cplx v[16];
#pragma unroll
                    for (int kk = 0; kk < 16; ++kk) v[kk] = ldc(srb + kk * KS + 128);
                    cplx H = {0.f, 0.f};
                    if (rk >= 1) { H = v[0];
#pragma unroll
                        for (int kk = 15; kk >= 2; --kk) if (kk > rk) H = cfma((kk >= 1 && kk <= 4) ? L320 : L256, H, v[kk]); }
                    const float* scb = SCB + ((((size_t)b * 68 + c0) * 32 + g) * 64 + ps) * 2; constexpr size_t CS = 32 * 64 * 2;
                    cplx sv[5];
#pragma unroll
                    for (int q = 1; q < 5; ++q) sv[q] = (q < nc) ? ldc(scb + q * CS) : (cplx){0.f, 0.f};
#define HB_ST(q, Hv) do { if (!half) { float2 o_; o_.x = (Hv).r; o_.y = (Hv).i; *(float2*)(hb + ((pb * 5 + (q)) * 32 + r32) * 2) = o_; } } while (0)
                    if (nc == 5) { HB_ST(4, H); H = cfma(L64, H, sv[4]); }
                    HB_ST(3, H); H = cfma(L64, H, sv[3]); HB_ST(2, H); H = cfma(L64, H, sv[2]); HB_ST(1, H); H = cfma(L64, H, sv[1]); HB_ST(0, H); }
#undef HB_ST
            }
        }
        asm volatile("s_waitcnt lgkmcnt(0)" ::: "memory");
        bf16x8 dfr;
        { const int hh = lane & 15, l4 = lane >> 4; const unsigned dv = f2bf(p.in[19][i * 512 + g * 16 + hh]);
#pragma unroll
            for (int e = 0; e < 8; ++e) dfr[e] = (short)((8 * l4 + e == hh) ? dv : 0u); }
        bf16x8 ua[2];
#pragma unroll
        for (int tb = 0; tb < 2; ++tb) ua[tb] = *(const bf16x8*)(proj + (m0 + tb * 32 + r32) * NPROJ + 1536 + g * 16 + (lane >> 5) * 8);
#pragma unroll 1
        for (int cc = 0; cc < nc; ++cc) {
            int ln = lane; asm volatile("" : "+v"(ln));
            const int r32c = ln & 31, hi = ln >> 5, l15 = ln & 15, l4 = ln >> 4;
            const size_t mc = m0 + 64 * cc; const size_t chunk = (size_t)b * 68 + c0 + cc;
            const bf16x8 u0 = ua[0], u1 = ua[1];
            if (cc + 1 < nc) {
#pragma unroll
                for (int tb = 0; tb < 2; ++tb) ua[tb] = *(const bf16x8*)(proj + (mc + 64 + tb * 32 + r32c) * NPROJ + 1536 + g * 16 + hi * 8); }
            f32x4 yacc[4];
            if (OUT) {
#pragma unroll
                for (int t = 0; t < 4; ++t) { bf16x8 xa = (bf16x8){0, 0, 0, 0, 0, 0, 0, 0};
                    if (l4 < 2) xa = *(const bf16x8*)(proj + (mc + t * 16 + l15) * NPROJ + 1536 + g * 16 + l4 * 8);
                    yacc[t] = __builtin_amdgcn_mfma_f32_16x16x32_bf16(xa, dfr, (f32x4){0.f, 0.f, 0.f, 0.f}, 0, 0, 0); }
            }
#pragma unroll
            for (int pb = 0; pb < 2; ++pb)
#pragma unroll 1
                for (int d = 0; d < 2; ++d) {
                    const cplx lam_ = ldc((const float*)(lds + S5L_LAM + (d * 64 + pb * 32 + r32c) * 8)); const cplx L64_ = cpow2n(lam_, 6);
                    const bf16x8 bre = *(const bf16x8*)(lds + S5L_BB + (((d * 2 + 0) * 2 + pb) * 64 + ln) * 16), bim = *(const bf16x8*)(lds + S5L_BB + (((d * 2 + 1) * 2 + pb) * 64 + ln) * 16);
                    f32x16 br[2], bi[2];
                    br[0] = __builtin_amdgcn_mfma_f32_32x32x16_bf16(u0, bre, (f32x16){}, 0, 0, 0); bi[0] = __builtin_amdgcn_mfma_f32_32x32x16_bf16(u0, bim, (f32x16){}, 0, 0, 0);
                    br[1] = __builtin_amdgcn_mfma_f32_32x32x16_bf16(u1, bre, (f32x16){}, 0, 0, 0); bi[1] = __builtin_amdgcn_mfma_f32_32x32x16_bf16(u1, bim, (f32x16){}, 0, 0, 0);
                    cplx Hin = {0.f, 0.f}, Hout;
                    if (OUT) { if (d == 0) Hin = Hf[pb]; else Hin = ldc(hb + ((pb * 5 + cc) * 32 + r32c) * 2); }
                    if (d == 0) s5_chunk_scan<false, OUT>(br, bi, lam_, Hin, half, Hout); else s5_chunk_scan<true, OUT>(br, bi, lam_, Hin, half, Hout);
                    if (OUT) {
                        if (d == 0) Hf[pb] = Hout;
#pragma unroll
                        for (int tb = 0; tb < 2; ++tb) {
                            int ob = hi * (4 * 144) + r32c * 4; asm volatile("" : "+v"(ob));
#pragma unroll
                            for (int r = 0; r < 16; ++r) *(unsigned*)(hs + ob + ((r & 3) + 8 * (r >> 2)) * 144) = pk2(br[tb][r], bi[tb][r]);
                            asm volatile("s_waitcnt lgkmcnt(0)" ::: "memory");
#pragma unroll
                            for (int ks = 0; ks < 2; ++ks) { const bf16x8 cf = *(const bf16x8*)(lds + S5L_CM + (((d * 2 + pb) * 2 + ks) * 64 + ln) * 16);
#pragma unroll
                                for (int tq = 0; tq < 2; ++tq) { const bf16x8 af = *(const bf16x8*)(hs + (tq * 16 + l15) * 144 + ks * 64 + l4 * 16);
                                    yacc[tb * 2 + tq] = __builtin_amdgcn_mfma_f32_16x16x32_bf16(af, cf, yacc[tb * 2 + tq], 0, 0, 0); } }
                            asm volatile("s_waitcnt lgkmcnt(0)" ::: "memory");
                        }
                    } else {
                        if (d == 0) SRf[pb] = cfma(L64_, SRf[pb], Hout);
                        else { SRb[pb] = cfma(pwb[pb], Hout, SRb[pb]); pwb[pb] = cmul(pwb[pb], L64_);
                            if (!half) { float2 o; o.x = Hout.r; o.y = Hout.i; *(float2*)(SCB + ((chunk * 32 + g) * 64 + pb * 32 + r32c) * 2) = o; } }
                    }
                }
            if (OUT) {
#pragma unroll
                for (int tq = 0; tq < 4; ++tq)
#pragma unroll
                    for (int e = 0; e < 4; ++e) *(bf16_t*)(hs + (tq * 16 + l4 * 4 + e) * 48 + l15 * 2) = (bf16_t)f2bf(gelu_tanh_f(yacc[tq][e]));
                asm volatile("s_waitcnt lgkmcnt(0)" ::: "memory");
#pragma unroll
                for (int q = 0; q < 2; ++q) { const int id = q * 64 + ln, row = id >> 1, hf = id & 1;
                    *(u32x4*)(yg + (mc + row) * 512 + g * 16 + hf * 8) = *(const u32x4*)(hs + row * 48 + hf * 16); }
                asm volatile("s_waitcnt lgkmcnt(0)" ::: "memory");
            }
        }
        if (!OUT) {
            if (!half) {
#pragma unroll
                for (int pb = 0; pb < 2; ++pb) { float2 o; o.x = SRf[pb].r; o.y = SRf[pb].i; *(float2*)(SR + ((((size_t)(b * 16 + rk) * 32 + g) * 2 + 0) * 64 + pb * 32 + r32) * 2) = o;
                    o.x = SRb[pb].r; o.y = SRb[pb].i; *(float2*)(SR + ((((size_t)(b * 16 + rk) * 32 + g) * 2 + 1) * 64 + pb * 32 + r32) * 2) = o; }
            }
        }
    }
    __syncthreads();
}

__device__ __forceinline__ void phase_headnorm(const Ctx& c, int l) {
    const P& p = *c.p; const int i = l >> 1;
    bf16_t* proj = (bf16_t*)(p.ws + WS_PROJ); const float* rope = (const float*)(p.ws + WS_ROPE);
    for (int it = c.gw; it < MTOK * 10; it += c.ngw) {
        const int m = it / 10, hd = it % 10; const int col0 = hd < 8 ? hd * 128 : 1024 + (hd - 8) * 128;
        const float* g = (hd < 8 ? p.in[24] : p.in[25]) + i * 128;
        const int a = c.lane >> 5, pr = c.lane & 31, i1 = a * 64 + pr, i2 = i1 + 32;
        bf16_t* hp = proj + (size_t)m * NPROJ + col0;
        const float x1 = bf2f(hp[i1]), x2 = bf2f(hp[i2]);
        const float hr = rsqrtf(wave_sum(x1 * x1 + x2 * x2) * (1.f / 128.f) + EPS);
        float y1 = x1 * hr * g[i1], y2 = x2 * hr * g[i2];
        const int t = m % TPB;
        if (t >= NCTX) { const int tl = t - NCTX; const int pos = a == 0 ? tl / 64 : tl % 64; const float cs = rope[2 * (pos * 32 + pr)], sn = rope[2 * (pos * 32 + pr) + 1];
            const float o1 = y1 * cs - y2 * sn, o2 = y1 * sn + y2 * cs; y1 = o1; y2 = o2; }
        hp[i1] = (bf16_t)f2bf(y1); hp[i2] = (bf16_t)f2bf(y2);
    }
}
__device__ __forceinline__ void phase_attn_naive(const Ctx& c, int l) {
    const P& p = *c.p;
    const bf16_t* proj = (const bf16_t*)(p.ws + WS_PROJ); bf16_t* mix = (bf16_t*)(p.ws + WS_MIX);
    float* sc = (float*)c.lds + c.wid * TPB;
    const bool with_ctx = l != DEPTH - 1;
    const int nit = with_ctx ? MTOK : NB * SEQ;
    const float scale = 0.08838834764831845f;
    for (int it = blockIdx.x; it < nit; it += gridDim.x) {
        int m; if (with_ctx) m = it; else { const int b = it / SEQ; m = b * TPB + NCTX + (it - b * SEQ); }
        const int b = m / TPB, t = m - b * TPB; const int nk = t < NCTX ? NCTX : TPB;
        const int hq = c.wid, kv = hq >> 2;
        const bf16_t* qp = proj + (size_t)m * NPROJ + hq * 128;
        float* qs = (float*)(c.lds + 140 * 1024) + c.wid * 128;
        { const unsigned w = *(const unsigned*)(qp + 2 * c.lane); qs[2 * c.lane] = bflo(w); qs[2 * c.lane + 1] = bfhi(w); }
        asm volatile("s_waitcnt lgkmcnt(0)" ::: "memory");
        float mx = -1e30f;
        for (int j0 = 0; j0 < nk; j0 += 64) {
            const bf16_t* kp = proj + (size_t)(b * TPB + j0 + c.lane) * NPROJ + 1024 + kv * 128;
            float s = 0.f;
#pragma unroll 4
            for (int d8 = 0; d8 < 16; ++d8) { const u32x4 w = *(const u32x4*)(kp + d8 * 8); const f32x4 qa = *(const f32x4*)(qs + d8 * 8), qb = *(const f32x4*)(qs + d8 * 8 + 4);
                s += qa.x * bflo(w.x) + qa.y * bfhi(w.x) + qa.z * bflo(w.y) + qa.w * bfhi(w.y) + qb.x * bflo(w.z) + qb.y * bfhi(w.z) + qb.z * bflo(w.w) + qb.w * bfhi(w.w); }
            s *= scale; sc[j0 + c.lane] = s; mx = fmaxf(mx, s);
        }
#pragma unroll
        for (int o = 1; o < 64; o <<= 1) mx = fmaxf(mx, __shfl_xor(mx, o));
        float ls = 0.f;
        for (int j0 = 0; j0 < nk; j0 += 64) { const float e = __expf(sc[j0 + c.lane] - mx); sc[j0 + c.lane] = e; ls += e; }
        ls = wave_sum(ls);
        asm volatile("s_waitcnt lgkmcnt(0)" ::: "memory");
        float o0 = 0.f, o1 = 0.f;
        const bf16_t* vp = proj + (size_t)(b * TPB) * NPROJ + 1280 + kv * 128 + 2 * c.lane;
#pragma unroll 4
        for (int j = 0; j < nk; ++j) { const unsigned w = *(const unsigned*)(vp + (size_t)j * NPROJ); const float pj = sc[j]; o0 += pj * bflo(w); o1 += pj * bfhi(w); }
        const float inv = 1.f / ls;
        const unsigned gw_ = *(const unsigned*)(proj + (size_t)m * NPROJ + 1536 + hq * 128 + 2 * c.lane);
        *(unsigned*)(mix + (size_t)m * DM + hq * 128 + 2 * c.lane) = pk2(o0 * inv * bflo(gw_), o1 * inv * bfhi(gw_));
        asm volatile("s_waitcnt lgkmcnt(0)" ::: "memory");
    }
}


__device__ __forceinline__ void phase_attn(const Ctx& c, int l) {
    const P& p = *c.p;
    const bf16_t* proj = (const bf16_t*)(p.ws + WS_PROJ); bf16_t* mix = (bf16_t*)(p.ws + WS_MIX);
    const int G = gridDim.x, bid = blockIdx.x; const int vcu = (G % 8 == 0) ? (bid % 8) * (G / 8) + bid / 8 : bid;
    const int nu = 512 + (l != DEPTH - 1 ? 32 : 0);
    for (int u = vcu; u < nu; u += G) {
        int b, hq, row0, seq;
        if (u < 512) { const int qb = u & 15, hql = (u >> 4) & 3, kvh = (u >> 6) & 1; b = u >> 7; hq = kvh * 4 + hql; row0 = b * TPB + NCTX + qb * 256; seq = TPB; }
        else { const int v = u - 512; b = v >> 3; hq = v & 7; row0 = b * TPB; seq = NCTX; }
        const int kv = hq >> 2;
        const bf16_t* kvb = proj + (size_t)b * TPB * NPROJ;
        attn::attn_dense_body<bf16_t>(proj + (size_t)row0 * NPROJ + hq * 128, kvb + 1024 + kv * 128, kvb + 1280 + kv * 128,
                                      mix + (size_t)row0 * DM + hq * 128, proj + (size_t)row0 * NPROJ + 1536 + hq * 128, seq, (char*)c.lds, c.tid);
        __syncthreads();
    }
}

__device__ __forceinline__ void phase_final(const Ctx& c) {
    const P& p = *c.p; const float* g = p.in[26];
    for (int m = c.gw; m < NB * SEQ; m += c.ngw) {
        float* xr = p.out + (size_t)m * DM; f32x4 v[4]; float ss = 0.f;
#pragma unroll
        for (int j = 0; j < 4; ++j) { v[j] = *(const f32x4*)(xr + 4 * c.lane + 256 * j); ss += v[j].x * v[j].x + v[j].y * v[j].y + v[j].z * v[j].z + v[j].w * v[j].w; }
        const float rstd = rsqrtf(wave_sum(ss) * (1.f / DM) + EPS);
#pragma unroll
        for (int j = 0; j < 4; ++j) { const f32x4 gv = *(const f32x4*)(g + 4 * c.lane + 256 * j); *(f32x4*)(xr + 4 * c.lane + 256 * j) = v[j] * rstd * gv; }
    }
}

enum { K_PREP_A, K_PREP_B, K_IN, K_EVENMIX, K_S5COMB, K_GLU, K_OUT, K_XPREP, K_HEADNORM, K_ATTN, K_FINAL };
#ifdef DUP_PH
constexpr int NPH = 20, NPHT = 19;
#else
constexpr int NPH = 19, NPHT = 19;
#endif
__device__ __forceinline__ void phase_decode(int ph, int& kind, int& layer) {
    constexpr int kinds[NPHT] = {K_PREP_A, K_PREP_B,
        K_IN, K_EVENMIX, K_S5COMB, K_GLU, K_OUT,
        K_IN, K_ATTN, K_OUT,
        K_IN, K_EVENMIX, K_S5COMB, K_GLU, K_OUT,
        K_IN, K_ATTN, K_OUT, K_FINAL};
    constexpr int layers[NPHT] = {0, 0, 0, 0, 0, 0, 0, 1, 1, 1, 2, 2, 2, 2, 2, 3, 3, 3, 0};
#ifdef DUP_PH
    if (ph > DUP_PH) --ph;
#endif
    kind = kinds[ph]; layer = layers[ph];
}

template <int ONLY> __device__ __forceinline__ void mega_body(const P& p) {
    extern __shared__ __attribute__((aligned(16))) unsigned char lds[];
    const int wave_u = __builtin_amdgcn_readfirstlane((int)threadIdx.x >> 6);
    if (threadIdx.x == 0) { volatile LAS unsigned long long* tab = (volatile LAS unsigned long long*)((LAS unsigned char*)lds + TAB_OFF);
#pragma unroll
        for (int i = 0; i < 27; ++i) tab[i] = (unsigned long long)p.in[i];
        tab[27] = (unsigned long long)p.out; tab[28] = (unsigned long long)p.ws; }
    if (threadIdx.x < 2) ((volatile LAS unsigned*)((LAS unsigned char*)lds + TAB_OFF + 240))[threadIdx.x] = 0u;
    __syncthreads();
    XcdBarrier bar = xcd_barrier_post((unsigned*)(p.ws + WS_CTL), (volatile LAS unsigned*)((LAS unsigned char*)lds + TAB_OFF + 240));
    for (int ph = p.ph_lo; ph < p.ph_hi; ++ph) {
        int kind, l; phase_decode(ph, kind, l);
        if (ONLY >= 0 && kind != ONLY) continue;
        unsigned z_ = 0u; asm volatile("" : "+v"(z_));
        int tid_ = (wave_u << 6) | (int)__builtin_amdgcn_mbcnt_hi(~0u, __builtin_amdgcn_mbcnt_lo(~0u, z_));
        P q;
        { unsigned tbo = TAB_OFF; asm volatile("" : "+v"(tbo));
          const volatile LAS unsigned* tab = (const volatile LAS unsigned*)((LAS unsigned char*)lds + tbo);
#pragma unroll
          for (int i = 0; i < 27; ++i) { const unsigned lo = __builtin_amdgcn_readfirstlane(tab[2 * i]), hi = __builtin_amdgcn_readfirstlane(tab[2 * i + 1]); q.in[i] = (const float*)(const __attribute__((address_space(1))) float*)(((unsigned long long)hi << 32) | lo); }
          { const unsigned lo = __builtin_amdgcn_readfirstlane(tab[54]), hi = __builtin_amdgcn_readfirstlane(tab[55]); q.out = (float*)(__attribute__((address_space(1))) float*)(((unsigned long long)hi << 32) | lo); }
          { const unsigned lo = __builtin_amdgcn_readfirstlane(tab[56]), hi = __builtin_amdgcn_readfirstlane(tab[57]); q.ws = (unsigned char*)(__attribute__((address_space(1))) unsigned char*)(((unsigned long long)hi << 32) | lo); }
          q.ph_lo = p.ph_lo; q.ph_hi = p.ph_hi; }
        Ctx c; c.p = &q; c.tid = tid_; c.wid = wave_u; c.lane = c.tid & 63; c.gw = blockIdx.x * NWAVES + c.wid; c.ngw = gridDim.x * NWAVES; c.lds = lds;
        switch (kind) {
            case K_PREP_A: phase_prep_a(c); phase_s5prep(c); break;
            case K_PREP_B: phase_bias(c); phase_xprep(c, 0, q.in[0], q.in[2]); phase_transposes(c); break;
            case K_IN: phase_in(c, l); break;
#ifdef USE_S5
#ifdef USE_GMLP
            case K_EVENMIX: phase_gmlp_fast(c, l); phase_s5_fast<false>(c, l); break;
#else
            case K_EVENMIX: phase_gmlp(c, l); phase_s5_fast<false>(c, l); break;
#endif
            case K_S5COMB: phase_s5_fast<true>(c, l); break;
#else
#ifdef USE_GMLP
            case K_EVENMIX: phase_gmlp_fast(c, l); phase_s5_naive(c, l); break;
#else
            case K_EVENMIX: phase_gmlp(c, l); phase_s5_naive(c, l); break;
#endif
            case K_S5COMB: phase_s5comb(c, l); break;
#endif
            case K_GLU: phase_glu(c, l); break;
            case K_OUT: phase_out(c, l); break;
            case K_XPREP: phase_xprep(c, l, q.out, (const float*)(q.ws + WS_CTXRES)); break;
            case K_HEADNORM: phase_headnorm(c, l); break;
#ifdef USE_ATTN
            case K_ATTN: phase_attn(c, l); break;
#else
            case K_ATTN: phase_attn_naive(c, l); break;
#endif
            case K_FINAL: phase_final(c); break;
        }
        if (ph + 1 < p.ph_hi) xcd_barrier(bar);
    }
}

__global__ void __launch_bounds__(NTHREADS) k_mega(P p) { mega_body<-1>(p); }
#ifdef PERKIND
template <int KIND> __global__ void __launch_bounds__(NTHREADS) k_one(P p) { mega_body<KIND>(p); }
template __global__ void k_one<0>(P); template __global__ void k_one<1>(P); template __global__ void k_one<2>(P); template __global__ void k_one<3>(P); template __global__ void k_one<4>(P); template __global__ void k_one<5>(P);
template __global__ void k_one<6>(P); template __global__ void k_one<7>(P); template __global__ void k_one<8>(P); template __global__ void k_one<9>(P); template __global__ void k_one<10>(P);
#endif


extern "C" void kernel_launch(void* const* d_in, const int* in_sizes, int n_in, void* d_out, int out_size, void* d_ws, size_t ws_size, hipStream_t stream) {
    static int grid = 0;
    if (grid == 0) {
        if (n_in != 27 || out_size != NB * SEQ * DM || ws_size < WS_END) { fprintf(stderr, "kernel_launch: unexpected shapes n_in %d out %d ws %zu\n", n_in, out_size, ws_size); grid = -1; return; }
        int dev = 0, cus = 0, per_cu = 0;
        hipGetDevice(&dev); hipDeviceGetAttribute(&cus, hipDeviceAttributeMultiprocessorCount, dev);
        hipFuncSetAttribute((const void*)k_mega, hipFuncAttributeMaxDynamicSharedMemorySize, LDS_BYTES);
        hipOccupancyMaxActiveBlocksPerMultiprocessor(&per_cu, (const void*)k_mega, NTHREADS, LDS_BYTES);
        if (per_cu < 1) { fprintf(stderr, "kernel_launch: occupancy query says %d blocks per CU\n", per_cu); per_cu = 1; }
        grid = cus * 1;
        fprintf(stderr, "kernel_launch: cus %d per_cu %d grid %d\n", cus, per_cu, grid);
    }
    if (grid < 0) return;
    hipMemsetAsync((char*)d_ws + WS_CTL, 0, 16384, stream);
    P p{};
    for (int i = 0; i < 27; ++i) p.in[i] = (const float*)d_in[i];
    p.out = (float*)d_out; p.ws = (unsigned char*)d_ws;
#ifdef ONE_LAUNCH
    p.ph_lo = 0; p.ph_hi = NPH;
    void* args[] = {&p};
    hipError_t e = hipLaunchCooperativeKernel((void*)k_mega, dim3(grid), dim3(NTHREADS), args, LDS_BYTES, stream);
    if (e != hipSuccess) fprintf(stderr, "cooperative launch failed: %s\n", hipGetErrorString(e));
#else
    for (int ph = 0; ph < NPH; ++ph) {
        p.ph_lo = ph; p.ph_hi = ph + 1;
        hipLaunchKernelGGL(k_mega, dim3(grid), dim3(NTHREADS), LDS_BYTES, stream, p);
    }
#endif
}
```

```cpp
#include <hip/hip_runtime.h>
#include <hip/hip_cooperative_groups.h>
#include <cstdio>
#include <cstdint>
namespace cg = cooperative_groups;
#define ONE_LAUNCH 1
#define USE_PG8 1
#define USE_ATTN 1
#define USE_S5 1
#define USE_GMLP 1

constexpr int DM = 1024, NB = 4, SEQ = 4096, NCTX = 256, TPB = NCTX + SEQ, MTOK = NB * TPB;
constexpr int NPROJ = 2560, DEPTH = 4;
constexpr float EPS = 1e-6f;
constexpr int NTHREADS = 512, NWAVES = 8;
constexpr int TAB_OFF = 147456, LDS_BYTES = TAB_OFF + 512;

typedef unsigned short bf16_t;
typedef short bf16x8 __attribute__((ext_vector_type(8)));
typedef float f32x4 __attribute__((ext_vector_type(4)));
typedef unsigned u32x2 __attribute__((ext_vector_type(2)));
typedef unsigned u32x4 __attribute__((ext_vector_type(4)));

constexpr size_t MiB = 1u << 20;
constexpr size_t WS_CTL = 0;
constexpr size_t WS_MODS = 1 * MiB;
constexpr size_t WS_BIAS = 1 * MiB + 512 * 1024;
constexpr size_t WS_RSS = 2 * MiB;
constexpr size_t WS_ROPE = 3 * MiB + 512 * 1024;
constexpr size_t WS_CTXRES = 4 * MiB;
constexpr size_t WS_WIN = 8 * MiB;
constexpr size_t WS_WOUT = 28 * MiB;
constexpr size_t WS_WGLU = 36 * MiB;
constexpr size_t WS_XM = 38 * MiB;
constexpr size_t WS_PROJ = 72 * MiB;
constexpr size_t WS_MIX = 157 * MiB;
constexpr size_t WS_YG = 191 * MiB;
constexpr size_t WS_S5 = 208 * MiB;
constexpr size_t WS_VST = WS_S5 + 14 * MiB;
constexpr size_t WS_END = 256 * MiB;

struct P {
    const float* in[27];
    float* out;
    unsigned char* ws;
    int ph_lo, ph_hi;
};

__device__ __forceinline__ unsigned f2bf(float f) { unsigned u = __builtin_bit_cast(unsigned, f); return (u + 0x7fffu + ((u >> 16) & 1u)) >> 16; }
typedef float f32x2_t __attribute__((ext_vector_type(2))); typedef __bf16 bf16x2_t __attribute__((ext_vector_type(2)));
__device__ __forceinline__ unsigned pk2(float lo, float hi) { const f32x2_t v = {lo, hi}; const bf16x2_t b = __builtin_convertvector(v, bf16x2_t); return __builtin_bit_cast(unsigned, b); }
__device__ __forceinline__ float bf2f(unsigned short h) { return __builtin_bit_cast(float, (unsigned)h << 16); }
__device__ __forceinline__ float bflo(unsigned w) { return __builtin_bit_cast(float, w << 16); }
__device__ __forceinline__ float bfhi(unsigned w) { return __builtin_bit_cast(float, w & 0xffff0000u); }
__device__ __forceinline__ float wave_sum(float v) {
#pragma unroll
    for (int o = 1; o < 64; o <<= 1) v += __shfl_xor(v, o);
    return v;
}
__device__ __forceinline__ float silu_f(float x) { return x * __builtin_amdgcn_rcpf(1.f + __expf(-x)); }
__device__ __forceinline__ float sigmoid_f(float x) { return __builtin_amdgcn_rcpf(1.f + __expf(-x)); }
__device__ __forceinline__ float gelu_tanh_f(float x) {
    const float u2 = 1.5957691216057308f * (x + 0.044715f * x * x * x);
    return x * __builtin_amdgcn_rcpf(1.f + __expf(-u2));
}
__host__ __device__ __forceinline__ int hd_logical(int h) { return (h & 0x40) | ((h & 0x04) << 3) | ((h & 0x38) >> 1) | (h & 0x03); }
__device__ __forceinline__ int in_col_logical(int l, int n) { return ((l & 1) && n < 1280) ? ((n & ~127) | hd_logical(n & 127)) : n; }
__device__ __forceinline__ int cond_row(int m) { const int b = m / TPB, t = m - b * TPB; return t < NCTX ? 4 : b; }
__device__ __forceinline__ size_t res_off(int m, bool& is_ctx) { const int b = m / TPB, t = m - b * TPB; is_ctx = t < NCTX; return is_ctx ? (size_t)(b * NCTX + t) * DM : (size_t)(b * SEQ + t - NCTX) * DM; }

struct Ctx {
    const P* p; int tid, wid, lane, gw, ngw;
    unsigned char* lds;
};

namespace pg8 {
#define PG8_LAS __attribute__((address_space(3)))
typedef unsigned short bf16_t;
typedef short bf16x8 __attribute__((ext_vector_type(8)));
typedef float f32x4 __attribute__((ext_vector_type(4)));
typedef unsigned u32x4 __attribute__((ext_vector_type(4)));
constexpr int BM = 256, BK = 64, HALF = 128, HTB = HALF * BK * 2  , STAGE_BYTES = 8 * HTB, NXCD = 8, WGM = 8;

__host__ __device__ __forceinline__ int lds_byte(int r, int c) { const int st = (r >> 4) * 2 + (c >> 5), rr = r & 15, cc = c & 31, ob = rr * 64 + cc * 2; return st * 1024 + (ob ^ (((ob >> 9) & 1) << 5)); }
__host__ __device__ __forceinline__ void stage_rc(int b, int& R, int& C) { const int st = b / 1024, sb = b % 1024, swz = sb ^ (((sb >> 9) & 1) << 5); R = (st >> 1) * 16 + swz / 64; C = (st & 1) * 32 + (swz % 64) / 2; }
__host__ __device__ __forceinline__ int perm32(int rho) { const int n = rho >> 4, i = rho & 15; return 8 * (i >> 2) + 4 * n + (i & 3); }

struct Unit { int pm, pn; };
struct Gemm { const bf16_t* A; const bf16_t* Bt; int M, N, K; };

struct StaticOrder {
    int nM, nN, nwg, G, c;
    __host__ __device__ void init(int M, int N, int G_, int c_) { nM = M / BM; nN = N / BM; nwg = nM * nN; G = G_; c = c_; }
    __host__ __device__ bool next(int i, Unit& u) const {
        const long L = (long)i * G + c; if (L >= nwg) return false;
        int wgid = (int)L; { const int q = nwg / NXCD, r = nwg % NXCD, xcd = wgid % NXCD, off = wgid / NXCD; wgid = (xcd < r ? xcd * (q + 1) : r * (q + 1) + (xcd - r) * q) + off; }
        const int nig = WGM * nN, gid = wgid / nig, fm = gid * WGM, gsz = (nM - fm) < WGM ? (nM - fm) : WGM;
        u.pm = fm + ((wgid % nig) % gsz); u.pn = (wgid % nig) / gsz; return true;
    }
    __device__ __forceinline__ void a_ready(const Unit&) const {}
    __device__ __forceinline__ void done(const Unit&) const {}
};

__device__ __forceinline__ unsigned cvt_pk_bf16(float lo, float hi) { unsigned r; asm volatile("v_cvt_pk_bf16_f32 %0, %1, %2" : "=v"(r) : "v"(lo), "v"(hi)); return r; }
template <class Epi, class Sched, bool ALIGN_EPI = false, bool SP2 = false>
__device__ __forceinline__ void gemm_phase(PG8_LAS unsigned char* lds, const Gemm g, const Sched& S, const Epi& E, const int tid) {
    const int wid = __builtin_amdgcn_readfirstlane(tid >> 6), lane = tid & 63, wr = wid >> 2, wc = wid & 3, fr = lane & 15, fq = lane >> 4;
    const int K = g.K, nt = K / BK;
    unsigned voffA[2], voffB[2];
#pragma unroll
    for (int i = 0; i < 2; ++i) { int R, C; stage_rc(tid * 16 + i * 8192, R, C); const int Rb = Epi::PERM ? ((R & ~31) + perm32(R & 31)) : R;
        voffA[i] = (unsigned)(R * K + C) * 2u; voffB[i] = (unsigned)(Rb * K + C) * 2u; }
    const size_t kstep = (size_t)(BK * 2);
    const size_t hstep = (size_t)HALF * K * 2;
    const size_t tstep = 2 * hstep;
    const unsigned ldsw = (unsigned)wid * 1024u;
    const int aoff = lds_byte(wr * 64 + fr, fq * 8), boff = lds_byte(wc * 32 + fr, fq * 8);
#define PG8_SA(b, h) (((b) * 2 + (h)) * HTB)
#define PG8_SB(b, h) ((4 + (b) * 2 + (h)) * HTB)
#define PG8_STAGE(bufoff, gbase, voff) do { _Pragma("unroll") for (int _i = 0; _i < 2; ++_i) \
        __builtin_amdgcn_global_load_lds((const unsigned*)((const char*)(gbase) + (voff)[_i]), (PG8_LAS unsigned*)(lds + (bufoff) + ldsw + _i * 8192), 16, 0, 0); } while (0)
#define PG8_LDA(dst, b, h) do { _Pragma("unroll") for (int m = 0; m < 4; ++m) _Pragma("unroll") for (int k = 0; k < 2; ++k) dst[m][k] = *(const PG8_LAS bf16x8*)(lds + PG8_SA(b, h) + aoff + m * 2048 + k * 1024); } while (0)
#define PG8_LDB(dst, b, h) do { _Pragma("unroll") for (int n = 0; n < 2; ++n) _Pragma("unroll") for (int k = 0; k < 2; ++k) dst[n][k] = *(const PG8_LAS bf16x8*)(lds + PG8_SB(b, h) + boff + n * 2048 + k * 1024); } while (0)
#define PG8_MMA(ai, bj, At, Bt) do { __builtin_amdgcn_s_setprio(1); _Pragma("unroll") for (int m = 0; m < 4; ++m) _Pragma("unroll") for (int n = 0; n < 2; ++n) _Pragma("unroll") for (int k = 0; k < 2; ++k) \
        acc[ai][bj][m][n] = __builtin_amdgcn_mfma_f32_16x16x32_bf16(Bt[n][k], At[m][k], acc[ai][bj][m][n], 0, 0, 0); __builtin_amdgcn_s_setprio(0); } while (0)
#define PG8_WAIT_V(n) asm volatile("s_waitcnt vmcnt(" #n ")" ::: "memory")
#define PG8_WAIT_L(n) asm volatile("s_waitcnt lgkmcnt(" #n ")" ::: "memory")
#define PG8_BAR __builtin_amdgcn_s_barrier()
#define PG8_SCHED __builtin_amdgcn_sched_barrier(0)
    Unit cur, nxt; int ui = 0;
    if (!S.next(0, cur)) return;
    f32x4 acc[2][2][4][2];
#pragma unroll
    for (int a = 0; a < 2; ++a)
#pragma unroll
        for (int b = 0; b < 2; ++b)
#pragma unroll
            for (int m = 0; m < 4; ++m)
#pragma unroll
                for (int n = 0; n < 2; ++n) acc[a][b][m][n] = (f32x4){0.f, 0.f, 0.f, 0.f};
    bf16x8 At[4][2], B0[2][2], B1[2][2];
    const char* cA = (const char*)g.A + (size_t)cur.pm * tstep; const char* cB = (const char*)g.Bt + (size_t)cur.pn * tstep;
    S.a_ready(cur);
    if constexpr (SP2) {
        PG8_STAGE(PG8_SB(0, 0), cB, voffB); PG8_STAGE(PG8_SB(0, 1), cB + hstep, voffB); PG8_STAGE(PG8_SA(0, 0), cA, voffA); PG8_STAGE(PG8_SA(0, 1), cA + hstep, voffA);
        if (wr == 1) PG8_BAR;
        PG8_WAIT_V(2); PG8_BAR;
        PG8_STAGE(PG8_SB(1, 0), cB + kstep, voffB); PG8_STAGE(PG8_SA(1, 0), cA + kstep, voffA); PG8_STAGE(PG8_SB(1, 1), cB + hstep + kstep, voffB);
        PG8_WAIT_V(6); PG8_BAR;
    } else {
        PG8_STAGE(PG8_SB(0, 0), cB, voffB); PG8_STAGE(PG8_SA(0, 0), cA, voffA); PG8_STAGE(PG8_SB(0, 1), cB + hstep, voffB); PG8_STAGE(PG8_SA(0, 1), cA + hstep, voffA);
        if (wr == 1) PG8_BAR;
        PG8_WAIT_V(4); PG8_BAR;
        PG8_STAGE(PG8_SB(1, 0), cB + kstep, voffB); PG8_STAGE(PG8_SA(1, 0), cA + kstep, voffA); PG8_STAGE(PG8_SB(1, 1), cB + hstep + kstep, voffB);
        PG8_WAIT_V(6); PG8_BAR;
    }
    for (;;) {
        const bool has_next = S.next(ui + 1, nxt);
        const char* nA = has_next ? (const char*)g.A + (size_t)nxt.pm * tstep : cA; const char* nB = has_next ? (const char*)g.Bt + (size_t)nxt.pn * tstep : cB;
        for (int t = 0; t < nt; t += 2) {
            const bool last = (t == nt - 2);
            const char* a1 = cA + (size_t)(t + 1) * kstep;
            const char* a2 = last ? nA : cA + (size_t)(t + 2) * kstep; const char* b2 = last ? nB : cB + (size_t)(t + 2) * kstep;
            const char* a3 = a2 + kstep; const char* b3 = b2 + kstep;
            if (last && has_next) S.a_ready(nxt);
            if constexpr (SP2) {
            PG8_LDB(B0, 0, 0); PG8_LDB(B1, 0, 1); PG8_SCHED; PG8_LDA(At, 0, 0); PG8_STAGE(PG8_SA(1, 1), a1 + hstep, voffA);
            PG8_WAIT_V(8); PG8_WAIT_L(0); PG8_BAR; PG8_MMA(0, 0, At, B0); PG8_MMA(0, 1, At, B1); PG8_BAR; PG8_SCHED;
            PG8_LDA(At, 0, 1); PG8_STAGE(PG8_SB(0, 0), b2, voffB); PG8_STAGE(PG8_SB(0, 1), b2 + hstep, voffB); PG8_STAGE(PG8_SA(0, 0), a2, voffA);
            PG8_WAIT_V(8); PG8_WAIT_L(0); PG8_BAR; PG8_MMA(1, 0, At, B0); PG8_MMA(1, 1, At, B1); PG8_BAR; PG8_SCHED;
            PG8_LDB(B0, 1, 0); PG8_LDB(B1, 1, 1); PG8_SCHED; PG8_LDA(At, 1, 0); PG8_STAGE(PG8_SA(0, 1), a2 + hstep, voffA);
            PG8_WAIT_V(8); PG8_WAIT_L(0); PG8_BAR; PG8_MMA(0, 0, At, B0); PG8_MMA(0, 1, At, B1); PG8_BAR; PG8_SCHED;
            PG8_LDA(At, 1, 1); PG8_STAGE(PG8_SB(1, 0), b3, voffB); PG8_STAGE(PG8_SB(1, 1), b3 + hstep, voffB); PG8_STAGE(PG8_SA(1, 0), a3, voffA);
            PG8_WAIT_V(8); PG8_WAIT_L(0); PG8_BAR; PG8_MMA(1, 0, At, B0); PG8_MMA(1, 1, At, B1); PG8_BAR; PG8_SCHED;
            } else {
            PG8_LDB(B0, 0, 0); PG8_SCHED; PG8_LDA(At, 0, 0); PG8_STAGE(PG8_SA(1, 1), a1 + hstep, voffA);
            PG8_WAIT_L(8); PG8_BAR; PG8_WAIT_L(0); PG8_MMA(0, 0, At, B0); PG8_BAR; PG8_SCHED;
            PG8_LDB(B1, 0, 1); PG8_STAGE(PG8_SB(0, 0), b2, voffB);
            PG8_BAR; PG8_WAIT_L(0); PG8_MMA(0, 1, At, B1); PG8_BAR;
            PG8_LDA(At, 0, 1); PG8_STAGE(PG8_SA(0, 0), a2, voffA);
            PG8_BAR; PG8_WAIT_L(0); PG8_MMA(1, 0, At, B0); PG8_BAR; PG8_SCHED;
            PG8_STAGE(PG8_SB(0, 1), b2 + hstep, voffB);
            PG8_WAIT_V(6); PG8_BAR; PG8_MMA(1, 1, At, B1); PG8_BAR;
            PG8_LDB(B0, 1, 0); PG8_SCHED; PG8_LDA(At, 1, 0); PG8_STAGE(PG8_SA(0, 1), a2 + hstep, voffA);
            PG8_WAIT_L(8); PG8_BAR; PG8_WAIT_L(0); PG8_MMA(0, 0, At, B0); PG8_BAR; PG8_SCHED;
            PG8_LDB(B1, 1, 1); PG8_STAGE(PG8_SB(1, 0), b3, voffB);
            PG8_BAR; PG8_WAIT_L(0); PG8_MMA(0, 1, At, B1); PG8_BAR;
            PG8_LDA(At, 1, 1); PG8_STAGE(PG8_SA(1, 0), a3, voffA);
            PG8_BAR; PG8_WAIT_L(0); PG8_MMA(1, 0, At, B0); PG8_BAR; PG8_SCHED;
            PG8_STAGE(PG8_SB(1, 1), b3 + hstep, voffB);
            PG8_WAIT_V(6); PG8_BAR; PG8_MMA(1, 1, At, B1); PG8_BAR;
            }
        }
        if constexpr (ALIGN_EPI) { if (wr == 0) PG8_BAR; }
        if constexpr (!Epi::AFTER_DRAIN) { E(acc, cur, wr, wc, fr, fq); S.done(cur); }
        if (!has_next) break;
#pragma unroll
        for (int a = 0; a < 2; ++a)
#pragma unroll
            for (int b = 0; b < 2; ++b)
#pragma unroll
                for (int m = 0; m < 4; ++m)
#pragma unroll
                    for (int n = 0; n < 2; ++n) acc[a][b][m][n] = (f32x4){0.f, 0.f, 0.f, 0.f};
        cur = nxt; cA = nA; cB = nB; ++ui;
        if constexpr (ALIGN_EPI) { if (wr == 1) PG8_BAR; }
    }
    PG8_WAIT_V(0);
    if constexpr (!ALIGN_EPI) { if (wr == 0) PG8_BAR; }
    PG8_BAR;
    if constexpr (Epi::AFTER_DRAIN) { E.fused(acc, cur, wr, wc, fr, fq, lds, wid, lane); S.done(cur); }
#undef PG8_SA
#undef PG8_SB
#undef PG8_STAGE
#undef PG8_LDA
#undef PG8_LDB
#undef PG8_MMA
#undef PG8_WAIT_V
#undef PG8_WAIT_L
#undef PG8_BAR
#undef PG8_SCHED
}
}

namespace attn {
constexpr int   D = 128, NW = 8, QBLK = 32, KVBLK = 64;
constexpr float SCALE = 0.088388347648318440f;
#ifndef ATTN_THR
#define ATTN_THR 8.f
#endif
constexpr float THR = ATTN_THR;
constexpr int SDEPTH = 2;
constexpr int LDQ = 2560, LDK = 2560, LDO = 1024, LDG = 2560;
constexpr size_t SHM_V = KVBLK * D * 2, SHM_K = KVBLK * D * 2, SHM_ATTN = 2 * SHM_V + 2 * SHM_K + NW * 64 * 4;
using bf16 = unsigned short;
using bf16x8 = __attribute__((ext_vector_type(8))) short;
using s16x4  = __attribute__((ext_vector_type(4))) short;
using f32x16 = __attribute__((ext_vector_type(16))) float;
using f32x8  = __attribute__((ext_vector_type(8))) float;
using u32x4  = __attribute__((ext_vector_type(4))) unsigned;
#define KSWZ(row, colB) ((row) * 256 + ((colB) ^ (((row) & 7) << 4)))
#define SBAR() __builtin_amdgcn_sched_barrier(0)
__device__ __forceinline__ int crow(int r, int hi) { return (r & 3) + 8 * (r >> 2) + 4 * hi; }
__device__ __forceinline__ unsigned cvtpk(float lo, float hi) {
  unsigned r; asm volatile("v_cvt_pk_bf16_f32 %0, %1, %2" : "=v"(r) : "v"(lo), "v"(hi)); return r;
}
template <typename TIn> struct Stage;
template <> struct Stage<bf16>  { using T = bf16x8;
  __device__ static __forceinline__ T ld8(const bf16* p) { return *reinterpret_cast<const bf16x8*>(p); }
  __device__ static __forceinline__ bf16x8 tobf(T x) { return x; } };
template <> struct Stage<float> { using T = f32x8;
  __device__ static __forceinline__ T ld8(const float* p) { return *reinterpret_cast<const f32x8*>(p); }
  __device__ static __forceinline__ bf16x8 tobf(T x) {
    u32x4 w = {cvtpk(x[0], x[1]), cvtpk(x[2], x[3]), cvtpk(x[4], x[5]), cvtpk(x[6], x[7])}; return *reinterpret_cast<bf16x8*>(&w); } };

__device__ __forceinline__ void partialSM(f32x16& p0, f32x16& p1, float& m_reg, float& mn, float& alpha) {
  constexpr float C = SCALE * 1.4426950408889634f;
  float pmax = p0[0]; for (int r = 1; r < 16; ++r) pmax = fmaxf(pmax, p0[r]); for (int r = 0; r < 16; ++r) pmax = fmaxf(pmax, p1[r]);
  { auto rr = __builtin_amdgcn_permlane32_swap(__float_as_uint(pmax), __float_as_uint(pmax), false, false);
    pmax = fmaxf(__uint_as_float(rr[0]), __uint_as_float(rr[1])); }
  if (__builtin_expect(__all(pmax - m_reg <= THR / SCALE), 1)) { mn = m_reg; alpha = 1.f; }
  else { mn = fmaxf(m_reg, pmax); alpha = __builtin_amdgcn_exp2f((m_reg - mn) * C); m_reg = mn; }
  float mnC = -mn * C;
  for (int r = 0; r < 16; ++r) p0[r] = fmaf(p0[r], C, mnC); for (int r = 0; r < 16; ++r) p1[r] = fmaf(p1[r], C, mnC);
  for (int r = 0; r < 16; ++r) p0[r] = __builtin_amdgcn_exp2f(p0[r]);
}
__device__ __forceinline__ void finishSM(f32x16& p0, f32x16& p1, float alpha, float& l_reg, bf16x8& pa0, bf16x8& pa1, bf16x8& pa2, bf16x8& pa3) {
  for (int r = 0; r < 16; ++r) p1[r] = __builtin_amdgcn_exp2f(p1[r]);
  float ps = 0; for (int r = 0; r < 16; ++r) ps += p0[r]; for (int r = 0; r < 16; ++r) ps += p1[r];
  { auto rr = __builtin_amdgcn_permlane32_swap(__float_as_uint(ps), __float_as_uint(ps), false, false);
    ps = __uint_as_float(rr[0]) + __uint_as_float(rr[1]); }
  l_reg = l_reg * alpha + ps;
#define PK4(P, BASE, OUT) do { unsigned a0 = cvtpk(P[BASE + 0], P[BASE + 1]), a1 = cvtpk(P[BASE + 2], P[BASE + 3]);   \
    unsigned b0 = cvtpk(P[BASE + 4], P[BASE + 5]), b1 = cvtpk(P[BASE + 6], P[BASE + 7]);                              \
    auto r0 = __builtin_amdgcn_permlane32_swap(a0, b0, false, false); auto r1 = __builtin_amdgcn_permlane32_swap(a1, b1, false, false); \
    u32x4 w = {r0[0], r1[0], r0[1], r1[1]}; OUT = *reinterpret_cast<bf16x8*>(&w); } while (0)
  PK4(p0, 0, pa0); PK4(p0, 8, pa1); PK4(p1, 0, pa2); PK4(p1, 8, pa3);
#undef PK4
}
__device__ __forceinline__ void qkt(f32x16& p0, f32x16& p1, const bf16* Ks, const bf16x8* qr, int r32, int hi) {
  p0 = f32x16{}; p1 = f32x16{};
  for (int d0 = 0; d0 < 8; ++d0) { int cb = (d0 * 16 + hi * 8) * 2;
    bf16x8 b0 = *reinterpret_cast<const bf16x8*>((const char*)Ks + KSWZ(r32, cb));
    bf16x8 b1 = *reinterpret_cast<const bf16x8*>((const char*)Ks + KSWZ(32 + r32, cb));
    p0 = __builtin_amdgcn_mfma_f32_32x32x16_bf16(b0, qr[d0], p0, 0, 0, 0);
    p1 = __builtin_amdgcn_mfma_f32_32x32x16_bf16(b1, qr[d0], p1, 0, 0, 0); }
}
__device__ __forceinline__ int v_st(int k, int c) { const int kk = (k & ~0xC) | ((k & 4) << 1) | ((k & 8) >> 1); return ((kk >> 3) * 4 + (c >> 5)) * 512 + ((kk & 7) * 32 + (c & 31)) * 2; }
__device__ __forceinline__ int v_rd_base(int lane) { return ((lane & 3) << 3) | (((lane >> 2) & 3) << 6) | (((lane >> 4) & 1) << 5) | (((lane >> 5) & 1) << 8); }
constexpr int v_rd_off(int d0, int ks, int half) { return d0 * 512 + ks * 4096 + half * 2048; }
template <int OFF> __device__ __forceinline__ s16x4 tr_read(int vb) {
  s16x4 r; asm volatile("ds_read_b64_tr_b16 %0, %1 offset:%2" : "=&v"(r) : "v"(vb), "i"(OFF) : "memory"); return r;
}
template <int D0> __device__ __forceinline__ void pv_one(f32x16& od, int vb, bf16x8 pa0, bf16x8 pa1, bf16x8 pa2, bf16x8 pa3) {
  const s16x4 l0 = tr_read<v_rd_off(D0, 0, 0)>(vb), h0 = tr_read<v_rd_off(D0, 0, 1)>(vb), l1 = tr_read<v_rd_off(D0, 1, 0)>(vb), h1 = tr_read<v_rd_off(D0, 1, 1)>(vb);
  const s16x4 l2 = tr_read<v_rd_off(D0, 2, 0)>(vb), h2 = tr_read<v_rd_off(D0, 2, 1)>(vb), l3 = tr_read<v_rd_off(D0, 3, 0)>(vb), h3 = tr_read<v_rd_off(D0, 3, 1)>(vb);
  asm volatile("s_waitcnt lgkmcnt(0)" ::: "memory"); SBAR();
#define PK(L, H) (bf16x8){L[0], L[1], L[2], L[3], H[0], H[1], H[2], H[3]}
  od = __builtin_amdgcn_mfma_f32_32x32x16_bf16(pa0, PK(l0, h0), od, 0, 0, 0);
  od = __builtin_amdgcn_mfma_f32_32x32x16_bf16(pa1, PK(l1, h1), od, 0, 0, 0);
  od = __builtin_amdgcn_mfma_f32_32x32x16_bf16(pa2, PK(l2, h2), od, 0, 0, 0);
  od = __builtin_amdgcn_mfma_f32_32x32x16_bf16(pa3, PK(l3, h3), od, 0, 0, 0);
#undef PK
}
__device__ __forceinline__ void pv_d0(f32x16* o, int vb, bf16x8 pa0, bf16x8 pa1, bf16x8 pa2, bf16x8 pa3) {
  pv_one<0>(o[0], vb, pa0, pa1, pa2, pa3); pv_one<1>(o[1], vb, pa0, pa1, pa2, pa3); pv_one<2>(o[2], vb, pa0, pa1, pa2, pa3); pv_one<3>(o[3], vb, pa0, pa1, pa2, pa3);
}

template <typename TQ>
__device__ __forceinline__ void attn_dense_body(const TQ* __restrict__ Qb, const bf16* __restrict__ Kh, const bf16* __restrict__ Vh,
                                                bf16* __restrict__ Ob, const bf16* __restrict__ Gb, int seq, char* lds, const int tid) {
  using St = Stage<bf16>; using SQ = Stage<TQ>;
  const int wid = __builtin_amdgcn_readfirstlane(tid >> 6), lane = tid & 63, r32 = lane & 31, hi = lane >> 5;
  bf16* V_lds = (bf16*)lds; bf16* K_lds = (bf16*)(lds + 2 * SHM_V);
  float* ws = (float*)(lds + 2 * SHM_V + 2 * SHM_K) + wid * 64; float* li_l = ws; float* al_l = ws + 32;
  float m_reg = -1e30f, l_reg = 0; f32x16 o[4] = {}; bf16x8 qr[8];
  const TQ* Qw = Qb + (long)(wid * QBLK + r32) * LDQ + hi * 8;
#pragma unroll
  for (int d0 = 0; d0 < 8; ++d0) qr[d0] = SQ::tobf(SQ::ld8(Qw + d0 * 16));
  const int sr = tid >> 4, sc = (tid & 15) * 8, vst0 = v_st(sr, sc), vst1 = v_st(32 + sr, sc);
  const int vb0 = (int)(uintptr_t)V_lds + v_rd_base(lane);
  struct { typename St::T vs0, vs1, ks0, ks1; } sr_[SDEPTH];
  const unsigned lo0 = (unsigned)(sr * LDK + sc), lo1 = (unsigned)((32 + sr) * LDK + sc);
#define SLOAD(i, k0) do { const bf16* vt_ = Vh + (long)(k0) * LDK; const bf16* kt_ = Kh + (long)(k0) * LDK; sr_[i].vs0 = St::ld8(vt_ + lo0); sr_[i].vs1 = St::ld8(vt_ + lo1); \
    sr_[i].ks0 = St::ld8(kt_ + lo0); sr_[i].ks1 = St::ld8(kt_ + lo1); } while (0)
#define SWRITE(b, i) do { *(bf16x8*)((char*)V_lds + (b) * SHM_V + vst0) = St::tobf(sr_[i].vs0);          \
    *(bf16x8*)((char*)V_lds + (b) * SHM_V + vst1) = St::tobf(sr_[i].vs1); int kc = sc * 2;               \
    *(bf16x8*)((char*)K_lds + (b) * SHM_K + KSWZ(sr, kc)) = St::tobf(sr_[i].ks0);                       \
    *(bf16x8*)((char*)K_lds + (b) * SHM_K + KSWZ(32 + sr, kc)) = St::tobf(sr_[i].ks1); } while (0)
#define SWAIT() do { if constexpr (SDEPTH == 2) asm volatile("s_waitcnt vmcnt(4)" ::: "memory"); else asm volatile("s_waitcnt vmcnt(0)" ::: "memory"); } while (0)
#define RESC(a) do { if (__any((a) < 1.f)) { if (hi == 0) al_l[r32] = (a); asm volatile("s_waitcnt lgkmcnt(0)" ::: "memory"); \
    for (int d = 0; d < 4; ++d) for (int r = 0; r < 16; ++r) o[d][r] *= al_l[crow(r, hi)]; } } while (0)
  f32x16 pA0, pA1, pB0, pB1; float mnA, mnB, alA, alB; bf16x8 pa0, pa1, pa2, pa3; const int NT = seq / KVBLK;
  constexpr int SE = 0, SO = SDEPTH - 1;
  SLOAD(SE, 0); asm volatile("s_waitcnt vmcnt(0)" ::: "memory"); SWRITE(0, SE); __syncthreads();
  qkt(pA0, pA1, K_lds, qr, r32, hi); partialSM(pA0, pA1, m_reg, mnA, alA);
  SLOAD(SO, KVBLK); if constexpr (SDEPTH == 2) { if (2 < NT) SLOAD(SE, 2 * KVBLK); }
  SWAIT(); SWRITE(1, SO); __syncthreads();
  for (int j = 1; j + 1 < NT; j += 2) {
    SBAR(); qkt(pB0, pB1, (bf16*)((char*)K_lds + SHM_K), qr, r32, hi);
    finishSM(pA0, pA1, alA, l_reg, pa0, pa1, pa2, pa3); SBAR();
    SLOAD(SO, (j + SDEPTH) * KVBLK); SBAR();
    pv_d0(o, vb0, pa0, pa1, pa2, pa3); partialSM(pB0, pB1, m_reg, mnB, alB);
    __syncthreads(); SWAIT(); SWRITE(0, SE);
    RESC(alB); __syncthreads();
    SBAR(); qkt(pA0, pA1, K_lds, qr, r32, hi);
    finishSM(pB0, pB1, alB, l_reg, pa0, pa1, pa2, pa3); SBAR();
    if (SDEPTH == 1 || j + 3 < NT) SLOAD(SE, (j + 1 + SDEPTH) * KVBLK); SBAR();
    pv_d0(o, vb0 + (int)SHM_V, pa0, pa1, pa2, pa3); partialSM(pA0, pA1, m_reg, mnA, alA);
    __syncthreads(); SWAIT(); SWRITE(1, SO);
    RESC(alA); __syncthreads();
  }
  SBAR(); qkt(pB0, pB1, (bf16*)((char*)K_lds + SHM_K), qr, r32, hi);
  finishSM(pA0, pA1, alA, l_reg, pa0, pa1, pa2, pa3); SBAR();
  pv_d0(o, vb0, pa0, pa1, pa2, pa3); partialSM(pB0, pB1, m_reg, mnB, alB);
  __syncthreads(); RESC(alB);
  finishSM(pB0, pB1, alB, l_reg, pa0, pa1, pa2, pa3); SBAR();
  pv_d0(o, vb0 + (int)SHM_V, pa0, pa1, pa2, pa3);
  if (hi == 0) li_l[r32] = l_reg; asm volatile("s_waitcnt lgkmcnt(0)" ::: "memory");
  float rli[16];
#pragma unroll
  for (int r = 0; r < 16; ++r) rli[r] = __builtin_amdgcn_rcpf(li_l[crow(r, hi)]);
  __syncthreads();
  { char* ost = lds + wid * 8704;
    int ob = hi * (4 * 272) + r32 * 2; asm volatile("" : "+v"(ob));
    char* osl = ost + ob;
#pragma unroll
    for (int r = 0; r < 16; ++r) { const int orow0 = (r & 3) + 8 * (r >> 2);
#pragma unroll
      for (int d0 = 0; d0 < 4; ++d0) *(bf16*)(osl + orow0 * 272 + d0 * 64) = (bf16)(cvtpk(o[d0][r] * rli[r], 0.f) & 0xffffu); }
    asm volatile("s_waitcnt lgkmcnt(0)" ::: "memory");
    bf16* Ow = Ob + (long)(wid * QBLK) * LDO; const bf16* Gw = Gb + (long)(wid * QBLK) * LDG;
    int ln = lane; asm volatile("" : "+v"(ln));
#pragma unroll 2
    for (int i = 0; i < 8; ++i) { const int id = i * 64 + ln, row = id >> 4, ch = id & 15;
      const u32x4 ov = *(const u32x4*)(ost + row * 272 + ch * 16); const u32x4 gv = *(const u32x4*)(Gw + (long)row * LDG + ch * 8);
      u32x4 w;
#define GMUL(O, G) cvtpk(__builtin_bit_cast(float, (O) << 16) * __builtin_bit_cast(float, (G) << 16), __builtin_bit_cast(float, (O) & 0xffff0000u) * __builtin_bit_cast(float, (G) & 0xffff0000u))
      w.x = GMUL(ov.x, gv.x); w.y = GMUL(ov.y, gv.y); w.z = GMUL(ov.z, gv.z); w.w = GMUL(ov.w, gv.w);
#undef GMUL
      *(u32x4*)(Ow + (long)row * LDO + ch * 8) = w; }
    asm volatile("s_waitcnt lgkmcnt(0)" ::: "memory");
  }
#undef SLOAD
#undef SWRITE
#undef SWAIT
#undef RESC
}

#undef KSWZ
#undef SBAR
}

#define LAS __attribute__((address_space(3)))
#define XB_TMO      128
#define XB_XCNT(j)  (256  + 64 * (j))
#define XB_XSUB(j)  (1280 + 64 * (j))
#define XB_XGEN(j)  (2304 + 64 * (j))
#define XB_TOP      3328
#define XB_TOPGEN   3392
#define XCD_BAR_WORDS 3456
#define XB_SPIN_CAP (1u << 18)

__device__ __forceinline__ unsigned xb_ld(unsigned* p)              { return __hip_atomic_load(p, __ATOMIC_RELAXED, __HIP_MEMORY_SCOPE_AGENT); }
__device__ __forceinline__ unsigned xb_add(unsigned* p, unsigned v) { return __hip_atomic_fetch_add(p, v, __ATOMIC_RELAXED, __HIP_MEMORY_SCOPE_AGENT); }
__device__ __forceinline__ unsigned xb_xcc_id() { return (unsigned)__builtin_amdgcn_s_getreg((3 << 11) | 20) & 0xFu; }
#define XB_SPIN(cond, bar) do { unsigned _sp = 0; while (cond) { __builtin_amdgcn_s_sleep(1); \
    if ((++_sp & 255u) == 0u) { if (xb_ld(&(bar)[XB_TMO])) break; if (_sp > XB_SPIN_CAP) { atomicAdd(&(bar)[XB_TMO], 1u); break; } } } } while (0)

struct XcdBarrier {
    unsigned* bar; unsigned x;
    volatile LAS unsigned* st;
};

__device__ __forceinline__ XcdBarrier xcd_barrier_post(unsigned* bar, volatile LAS unsigned* st) {
    XcdBarrier b; b.bar = bar; b.x = xb_xcc_id(); b.st = st;
    if (threadIdx.x == 0) (void)xb_add(&bar[XB_XCNT(b.x)], 1u);
    return b;
}
__device__ __forceinline__ void xcd_barrier_complete(unsigned* bar, unsigned x, unsigned& nloc, unsigned& nx) {
    const unsigned G = gridDim.x * gridDim.y * gridDim.z;
    unsigned sum, cnt, mine, sp = 0u;
    for (;;) {
        sum = 0u; cnt = 0u; mine = 0u;
#pragma unroll
        for (unsigned j = 0; j < 16; ++j) { const unsigned c = xb_ld(&bar[XB_XCNT(j)]); sum += c; cnt += (c > 0u) ? 1u : 0u; mine = (j == x) ? c : mine; }
        if (sum == G) break;
        __builtin_amdgcn_s_sleep(1);
        if ((++sp & 255u) == 0u) { if (xb_ld(&bar[XB_TMO])) break; if (sp > XB_SPIN_CAP) { atomicAdd(&bar[XB_TMO], 1u); break; } }
    }
    nloc = mine > 0u ? mine : 1u; nx = cnt > 0u ? cnt : 1u;
}

__device__ __forceinline__ void xcd_barrier(const XcdBarrier& b) {
    asm volatile("s_waitcnt vmcnt(0)" ::: "memory");
    __syncthreads();
    if (threadIdx.x == 0) {
        unsigned* bar = b.bar;
        __builtin_amdgcn_s_waitcnt(0);
        unsigned nloc = b.st[0], nx = b.st[1];
        if (nloc == 0u) { xcd_barrier_complete(bar, b.x, nloc, nx); b.st[0] = nloc; b.st[1] = nx; }
        const unsigned old = xb_add(&bar[XB_XSUB(b.x)], 1u);
        const unsigned gen = old / nloc;
        if (old + 1u == (gen + 1u) * nloc) {
            __builtin_amdgcn_fence(__ATOMIC_RELEASE, "agent");
            asm volatile("s_waitcnt vmcnt(0)" ::: "memory");
            const unsigned og = xb_add(&bar[XB_TOP], 1u);
            const unsigned tg = og / nx;
            if (og + 1u == (tg + 1u) * nx) xb_add(&bar[XB_TOPGEN], 1u);
            else XB_SPIN(xb_ld(&bar[XB_TOPGEN]) == tg, bar);
            __builtin_amdgcn_fence(__ATOMIC_ACQUIRE, "agent");
            xb_add(&bar[XB_XGEN(b.x)], 1u);
            asm volatile("s_waitcnt vmcnt(0)" ::: "memory");
        } else {
            XB_SPIN(xb_ld(&bar[XB_XGEN(b.x)]) == gen, bar);
            __builtin_amdgcn_fence(__ATOMIC_ACQUIRE, "agent");
            asm volatile("s_waitcnt vmcnt(0)" ::: "memory");
        }
    }
    __syncthreads();
}

__device__ __forceinline__ void transpose_item(const float* W, int K, int N, bf16_t* WT, int item, float* scr, int tid, int permute_below = 0) {
    const int nblk = N / 64, kb = item / nblk, nb = item % nblk, k0 = kb * 64, n0 = nb * 64;
    __syncthreads();
#pragma unroll
    for (int i = 0; i < 8; ++i) { const int kk = (tid >> 6) + 8 * i, nn = tid & 63; scr[kk * 65 + nn] = W[(size_t)(k0 + kk) * N + n0 + nn]; }
    __syncthreads();
    const int n = tid >> 3, c = tid & 7;
    const int ns = (n0 + n < permute_below) ? (hd_logical((n0 + n) & 127) & 63) : n;
    u32x4 o; const float* s = scr + (8 * c) * 65 + ns;
    o.x = pk2(s[0], s[65]); o.y = pk2(s[2 * 65], s[3 * 65]); o.z = pk2(s[4 * 65], s[5 * 65]); o.w = pk2(s[6 * 65], s[7 * 65]);
    *(u32x4*)(WT + (size_t)(n0 + n) * K + k0 + 8 * c) = o;
}
__device__ __forceinline__ void phase_prep_a(const Ctx& c) {
    const P& p = *c.p;
    float* mods = (float*)(p.ws + WS_MODS);
    {
        float* sl = (float*)(c.lds + 32768);
        float* red = (float*)(c.lds + 32768 + 20480);
        for (int e = c.tid; e < 5 * DM; e += NTHREADS) { const int r = e >> 10, k = e & 1023; sl[e] = silu_f(r < 4 ? p.in[1][r * DM + k] : p.in[3][k]); }
        __syncthreads();
        for (int it = blockIdx.x; it < DEPTH * 48; it += gridDim.x) {
            const int l = it / 48, j = (it % 48) * 64 + c.lane;
            const float* w = p.in[5] + (size_t)l * DM * 3072 + (size_t)(c.wid * 128) * 3072 + j;
            float a0 = 0.f, a1 = 0.f, a2 = 0.f, a3 = 0.f, a4 = 0.f;
#pragma unroll 16
            for (int k = 0; k < 128; ++k) { const float wv = w[(size_t)k * 3072]; const int kk = c.wid * 128 + k;
                a0 += sl[kk] * wv; a1 += sl[DM + kk] * wv; a2 += sl[2 * DM + kk] * wv; a3 += sl[3 * DM + kk] * wv; a4 += sl[4 * DM + kk] * wv; }
            float* rw = red + c.wid * 320 + c.lane; rw[0] = a0; rw[64] = a1; rw[128] = a2; rw[192] = a3; rw[256] = a4;
            __syncthreads();
            if (c.tid < 320) { float sum = 0.f;
#pragma unroll
                for (int w8 = 0; w8 < 8; ++w8) sum += red[w8 * 320 + c.tid];
                const int r = c.tid >> 6, jj = (it % 48) * 64 + (c.tid & 63);
                mods[((size_t)l * 5 + r) * 3072 + jj] = sum + p.in[6][l * 3072 + jj]; }
            __syncthreads();
        }
    }
    if (blockIdx.x == gridDim.x - 1) {
        float* rope = (float*)(p.ws + WS_ROPE);
        for (int e = c.tid; e < 64 * 32; e += NTHREADS) { const int pos = e >> 5, pr = e & 31;
            const float freq = powf(10000.f, -(float)pr / 32.f); const float ang = (float)pos * freq; rope[2 * e] = cosf(ang); rope[2 * e + 1] = sinf(ang); }
    }
}

__device__ __forceinline__ void phase_transposes(const Ctx& c) {
    const P& p = *c.p;
    float* scr = (float*)c.lds;
    constexpr int I_IN = 16 * 40, I_OUT = 16 * 16, I_GLU = 8 * 8;
    constexpr int NIT = 4 * I_IN + 4 * I_OUT + 2 * I_GLU;
    for (int it = blockIdx.x; it < NIT; it += gridDim.x) {
        int r = it;
        if (r < 4 * I_IN) { const int l = r / I_IN; const float* W = (l & 1) ? p.in[22] + (size_t)(l >> 1) * DM * NPROJ : p.in[7] + (size_t)(l >> 1) * DM * NPROJ;
            transpose_item(W, DM, NPROJ, (bf16_t*)(p.ws + WS_WIN) + (size_t)l * NPROJ * DM, r % I_IN, scr, c.tid, (l & 1) ? 1280 : 0); continue; }
        r -= 4 * I_IN;
        if (r < 4 * I_OUT) { const int l = r / I_OUT; const float* W = (l & 1) ? p.in[23] + (size_t)(l >> 1) * DM * DM : p.in[8] + (size_t)(l >> 1) * DM * DM;
            transpose_item(W, DM, DM, (bf16_t*)(p.ws + WS_WOUT) + (size_t)l * DM * DM, r % I_OUT, scr, c.tid); continue; }
        r -= 4 * I_OUT;
        { const int i = r / I_GLU; transpose_item(p.in[20] + (size_t)i * 512 * 512, 512, 512, (bf16_t*)(p.ws + WS_WGLU) + (size_t)i * 512 * 512, r % I_GLU, scr, c.tid); }
    }
    __syncthreads();
}
__device__ __forceinline__ void phase_bias(const Ctx& c) {
    const P& p = *c.p;
    const float* mods = (const float*)(p.ws + WS_MODS); float* bias = (float*)(p.ws + WS_BIAS);
    float* sl = (float*)(c.lds + 32768);
    float* red = (float*)(c.lds + 32768 + 20480);
    for (int it = blockIdx.x; it < DEPTH * 40; it += gridDim.x) {
        const int l = it / 40, n = (it % 40) * 64 + c.lane;
        __syncthreads();
        for (int e = c.tid; e < 5 * DM; e += NTHREADS) { const int r = e >> 10, k = e & 1023; sl[e] = mods[((size_t)l * 5 + r) * 3072 + k]; }
        __syncthreads();
        const float* W = ((l & 1) ? p.in[22] + (size_t)(l >> 1) * DM * NPROJ : p.in[7] + (size_t)(l >> 1) * DM * NPROJ) + (size_t)(c.wid * 128) * NPROJ + in_col_logical(l, n);
        float a0 = 0.f, a1 = 0.f, a2 = 0.f, a3 = 0.f, a4 = 0.f;
#pragma unroll 16
        for (int k = 0; k < 128; ++k) { const float wv = W[(size_t)k * NPROJ]; const int kk = c.wid * 128 + k;
            a0 += sl[kk] * wv; a1 += sl[DM + kk] * wv; a2 += sl[2 * DM + kk] * wv; a3 += sl[3 * DM + kk] * wv; a4 += sl[4 * DM + kk] * wv; }
        float* rw = red + c.wid * 320 + c.lane; rw[0] = a0; rw[64] = a1; rw[128] = a2; rw[192] = a3; rw[256] = a4;
        __syncthreads();
        if (c.tid < 320) { float sum = 0.f;
#pragma unroll
            for (int w8 = 0; w8 < 8; ++w8) sum += red[w8 * 320 + c.tid];
            const int r = c.tid >> 6, nn = (it % 40) * 64 + (c.tid & 63);
            bias[((size_t)l * 5 + r) * NPROJ + nn] = sum; }
    }
    __syncthreads();
}
__device__ __forceinline__ void phase_xprep(const Ctx& c, int l, const float* xbuf, const float* ctxbuf) {
    const P& p = *c.p;
    const float* mods = (const float*)(p.ws + WS_MODS) + (size_t)l * 5 * 3072;
    const float* g = p.in[4] + l * DM;
    bf16_t* xm = (bf16_t*)(p.ws + WS_XM); float* rss = (float*)(p.ws + WS_RSS);
    for (int m0 = 2 * c.gw; m0 < MTOK; m0 += 2 * c.ngw) {
        f32x4 v[2][4]; const float* scp[2];
#pragma unroll
        for (int rr = 0; rr < 2; ++rr) { const int m = m0 + rr; bool ic; const size_t off = res_off(m, ic); const float* src = (ic ? ctxbuf : xbuf) + off; scp[rr] = mods + cond_row(m) * 3072 + 1024;
#pragma unroll
            for (int j = 0; j < 4; ++j) v[rr][j] = *(const f32x4*)(src + 4 * c.lane + 256 * j); }
#pragma unroll
        for (int rr = 0; rr < 2; ++rr) { const int m = m0 + rr; float ss = 0.f;
#pragma unroll
            for (int j = 0; j < 4; ++j) { const int k = 4 * c.lane + 256 * j; const f32x4 x = v[rr][j]; const f32x4 gv = *(const f32x4*)(g + k), sv = *(const f32x4*)(scp[rr] + k);
                ss += x.x * x.x + x.y * x.y + x.z * x.z + x.w * x.w;
                u32x2 o; o.x = pk2(x.x * gv.x * (1.f + sv.x), x.y * gv.y * (1.f + sv.y)); o.y = pk2(x.z * gv.z * (1.f + sv.z), x.w * gv.w * (1.f + sv.w));
                *(u32x2*)(xm + (size_t)m * DM + k) = o; }
            ss = wave_sum(ss);
            if (c.lane < 16) rss[(size_t)m * 16 + c.lane] = c.lane == 0 ? ss : 0.f; }
    }
}

template <class Epi>
__device__ __forceinline__ void gemm_simple(const Ctx& c, const bf16_t* A, int lda, const bf16_t* Bt, int ldb, int M, int N, int K, const Epi& epi) {
    const int fr = c.lane & 15, fq = c.lane >> 4, wr = c.wid >> 1, wc = c.wid & 1;
    const int tn = N / 128, nt = (M / 128) * tn;
    for (int t = blockIdx.x; t < nt; t += gridDim.x) {
        const int pm = t / tn, pn = t % tn;
        f32x4 acc[2][4];
#pragma unroll
        for (int i = 0; i < 2; ++i)
#pragma unroll
            for (int j = 0; j < 4; ++j) acc[i][j] = (f32x4){0.f, 0.f, 0.f, 0.f};
        const bf16_t* a0 = A + (size_t)(pm * 128 + wr * 32 + fr) * lda + fq * 8;
        const bf16_t* b0 = Bt + (size_t)(pn * 128 + wc * 64 + fr) * ldb + fq * 8;
        for (int k = 0; k < K; k += 32) {
            bf16x8 af[2], bfr[4];
#pragma unroll
            for (int i = 0; i < 2; ++i) af[i] = *(const bf16x8*)(a0 + (size_t)i * 16 * lda + k);
#pragma unroll
            for (int j = 0; j < 4; ++j) bfr[j] = *(const bf16x8*)(b0 + (size_t)j * 16 * ldb + k);
#pragma unroll
            for (int i = 0; i < 2; ++i)
#pragma unroll
                for (int j = 0; j < 4; ++j) acc[i][j] = __builtin_amdgcn_mfma_f32_16x16x32_bf16(bfr[j], af[i], acc[i][j], 0, 0, 0);
        }
#pragma unroll
        for (int i = 0; i < 2; ++i)
#pragma unroll
            for (int j = 0; j < 4; ++j) epi(pm * 128 + wr * 32 + i * 16 + fr, pn * 128 + wc * 64 + j * 16 + 4 * fq, acc[i][j]);
    }
}

struct EpiIn {
    const float* rss; const float* bias; bf16_t* proj; int odd;
    __device__ __forceinline__ void operator()(int row, int col, f32x4 v) const {
        const f32x4* rp = (const f32x4*)(rss + (size_t)row * 16);
        const f32x4 s0 = rp[0], s1 = rp[1], s2 = rp[2], s3 = rp[3];
        const float ss = ((s0.x + s0.y) + (s0.z + s0.w)) + ((s1.x + s1.y) + (s1.z + s1.w)) + ((s2.x + s2.y) + (s2.z + s2.w)) + ((s3.x + s3.y) + (s3.z + s3.w));
        const float rstd = rsqrtf(ss * (1.f / DM) + EPS);
        const f32x4 bv = *(const f32x4*)(bias + (size_t)cond_row(row) * NPROJ + col);
        v = v * rstd + bv;
        const bool act = odd ? (col >= 1536) : ((col >= 1024 && col < 1536) || col >= 2048);
        if (act) { v.x = silu_f(v.x); v.y = silu_f(v.y); v.z = silu_f(v.z); v.w = silu_f(v.w); }
        u32x2 o; o.x = pk2(v.x, v.y); o.y = pk2(v.z, v.w);
        *(u32x2*)(proj + (size_t)row * NPROJ + col) = o;
    }
};
struct EpiOut {
    const float* xold; const float* cold; float* xnew; float* cnew; const float* mods; int skip_ctx;
    __device__ __forceinline__ void operator()(int row, int col, f32x4 v) const {
        bool ic; const size_t off = res_off(row, ic) + col;
        if (ic && skip_ctx) return;
        const f32x4 gt = *(const f32x4*)(mods + (size_t)cond_row(row) * 3072 + 2048 + col);
        const f32x4 o = *(const f32x4*)((ic ? cold : xold) + off);
        *(f32x4*)((ic ? cnew : xnew) + off) = o + gt * v;
    }
};
struct EpiGlu {
    const bf16_t* yg; const bf16_t* proj; const float* bglu; bf16_t* mix;
    __device__ __forceinline__ void operator()(int row, int col, f32x4 v) const {
        const f32x4 b = *(const f32x4*)(bglu + col);
        const u32x2 yw = *(const u32x2*)(yg + (size_t)row * 512 + col), gw = *(const u32x2*)(proj + (size_t)row * NPROJ + 2048 + col);
        const float o0 = bflo(yw.x) * sigmoid_f(v.x + b.x) * bflo(gw.x), o1 = bfhi(yw.x) * sigmoid_f(v.y + b.y) * bfhi(gw.x);
        const float o2 = bflo(yw.y) * sigmoid_f(v.z + b.z) * bflo(gw.y), o3 = bfhi(yw.y) * sigmoid_f(v.w + b.w) * bfhi(gw.y);
        u32x2 o; o.x = pk2(o0, o1); o.y = pk2(o2, o3);
        *(u32x2*)(mix + (size_t)row * DM + 512 + col) = o;
    }
};


template <class E> struct EpiTile {
    static constexpr bool PERM = false, AFTER_DRAIN = false; E e;
    __device__ __forceinline__ void operator()(const pg8::f32x4 (&acc)[2][2][4][2], const pg8::Unit& u, int wr, int wc, int fr, int fq) const {
#pragma unroll
        for (int ai = 0; ai < 2; ++ai)
#pragma unroll
            for (int m = 0; m < 4; ++m) { const int row = u.pm * 256 + ai * 128 + wr * 64 + m * 16 + fr;
#pragma unroll
                for (int bj = 0; bj < 2; ++bj)
#pragma unroll
                    for (int n = 0; n < 2; ++n) e(row, u.pn * 256 + bj * 128 + wc * 32 + n * 16 + 4 * fq, acc[ai][bj][m][n]); }
    }
};
template <class E> __device__ __forceinline__ void gemm_fast(const Ctx& c, const bf16_t* A, const bf16_t* Bt, int M, int N, int K, const E& e) {
    pg8::Gemm g{A, Bt, M, N, K}; pg8::StaticOrder S; S.init(M, N, (int)gridDim.x, (int)blockIdx.x);
    EpiTile<E> E2{e};
    pg8::gemm_phase<EpiTile<E>, pg8::StaticOrder, true, true>((PG8_LAS unsigned char*)c.lds, g, S, E2, c.tid);
    __syncthreads();
}


struct EpiInTile {
    static constexpr bool PERM = true, AFTER_DRAIN = false;
    const float* rss; const float* bias; bf16_t* proj; int odd; const float* qg; const float* kg; const float* rope; float* red; float* vst;
    __device__ __forceinline__ void operator()(const pg8::f32x4 (&acc)[2][2][4][2], const pg8::Unit& u, int wr, int wc, int fr, int fq) const {
        asm volatile("" : "+v"(fr), "+v"(fq));
        const int pmb = u.pm / 17, jt = u.pm - pmb * 17, r = jt == 0 ? 4 : pmb;
        const int colb = u.pn * 256 + wc * 32 + 8 * fq;
        f32x4 bv[2][2];
#pragma unroll
        for (int bj = 0; bj < 2; ++bj)
#pragma unroll
            for (int n = 0; n < 2; ++n) bv[bj][n] = *(const f32x4*)(bias + (size_t)r * NPROJ + colb + bj * 128 + n * 4);
        float rstd[2][4];
#pragma unroll
        for (int ai = 0; ai < 2; ++ai)
#pragma unroll
            for (int m = 0; m < 4; ++m) { const int row = u.pm * 256 + ai * 128 + wr * 64 + m * 16 + fr;
                const f32x4* rp = (const f32x4*)(rss + (size_t)row * 16);
                const f32x4 s0 = rp[0], s1 = rp[1], s2 = rp[2], s3 = rp[3];
                const float ss = ((s0.x + s0.y) + (s0.z + s0.w)) + ((s1.x + s1.y) + (s1.z + s1.w)) + ((s2.x + s2.y) + (s2.z + s2.w)) + ((s3.x + s3.y) + (s3.z + s3.w));
                float rs_ = rsqrtf(ss * (1.f / DM) + EPS); asm volatile("" : "+v"(rs_) :: "memory"); rstd[ai][m] = rs_; }
        const bool qk = odd && u.pn <= 4;
        if (qk) {
#pragma unroll
            for (int ai = 0; ai < 2; ++ai)
#pragma unroll
                for (int m = 0; m < 4; ++m)
#pragma unroll
                    for (int bj = 0; bj < 2; ++bj) { const f32x4 v0 = acc[ai][bj][m][0] * rstd[ai][m] + bv[bj][0], v1 = acc[ai][bj][m][1] * rstd[ai][m] + bv[bj][1];
                        float s_ = ((v0.x * v0.x + v0.y * v0.y) + (v0.z * v0.z + v0.w * v0.w)) + ((v1.x * v1.x + v1.y * v1.y) + (v1.z * v1.z + v1.w * v1.w));
                        s_ += __shfl_xor(s_, 16); s_ += __shfl_xor(s_, 32);
                        if (fq == 0) red[((ai * 128 + wr * 64 + m * 16 + fr) * 2 + bj) * 4 + wc] = s_; }
            asm volatile("s_waitcnt lgkmcnt(0)" ::: "memory"); __builtin_amdgcn_s_barrier(); asm volatile("" ::: "memory");
        }
        const bool vt = !odd && (u.pn == 2 || u.pn == 3);
        const float* gn = u.pn == 4 ? kg : qg;
        const int a_ = wc >> 1, p0 = (wc & 1) * 16 + fq * 4, d0 = a_ * 64 + p0;
#pragma unroll
        for (int ai = 0; ai < 2; ++ai)
#pragma unroll
            for (int m = 0; m < 4; ++m) { const int rt = ai * 128 + wr * 64 + m * 16 + fr; const int row = u.pm * 256 + rt;
                bf16_t* rowp = proj + (size_t)row * NPROJ + colb; float vs1 = 0.f, vs2 = 0.f;
                f32x4 cs0 = (f32x4){1.f, 0.f, 1.f, 0.f}, cs1 = cs0;
                if (qk && jt != 0) { const int tl = (jt - 1) * 256 + rt; const int pos = a_ == 0 ? (tl >> 6) : (tl & 63); const float* rp = rope + (size_t)(pos * 32 + p0) * 2; cs0 = *(const f32x4*)rp; cs1 = *(const f32x4*)(rp + 4); }
#pragma unroll
                for (int bj = 0; bj < 2; ++bj) { const int c0 = u.pn * 256 + bj * 128;
                    const bool act = odd ? (c0 >= 1536) : ((c0 >= 1024 && c0 < 1536) || c0 >= 2048);
                    f32x4 v0 = acc[ai][bj][m][0] * rstd[ai][m] + bv[bj][0], v1 = acc[ai][bj][m][1] * rstd[ai][m] + bv[bj][1];
                    if (act) { v0.x = silu_f(v0.x); v0.y = silu_f(v0.y); v0.z = silu_f(v0.z); v0.w = silu_f(v0.w); v1.x = silu_f(v1.x); v1.y = silu_f(v1.y); v1.z = silu_f(v1.z); v1.w = silu_f(v1.w); }
                    if (qk) { const f32x4 pr = *(const f32x4*)(red + ((rt) * 2 + bj) * 4);
                        const float hr = rsqrtf(((pr.x + pr.y) + (pr.z + pr.w)) * (1.f / 128.f) + EPS);
                        const f32x4 g1 = *(const f32x4*)(gn + d0), g2 = *(const f32x4*)(gn + d0 + 32);
                        const f32x4 x1 = v0 * hr * g1, x2 = v1 * hr * g2;
                        v0.x = x1.x * cs0.x - x2.x * cs0.y; v1.x = x1.x * cs0.y + x2.x * cs0.x; v0.y = x1.y * cs0.z - x2.y * cs0.w; v1.y = x1.y * cs0.w + x2.y * cs0.z;
                        v0.z = x1.z * cs1.x - x2.z * cs1.y; v1.z = x1.z * cs1.y + x2.z * cs1.x; v0.w = x1.w * cs1.z - x2.w * cs1.w; v1.w = x1.w * cs1.w + x2.w * cs1.z; }
                    if (vt) { vs1 += ((v0.x + v0.y) + (v0.z + v0.w)) + ((v1.x + v1.y) + (v1.z + v1.w)); vs2 += ((v0.x * v0.x + v0.y * v0.y) + (v0.z * v0.z + v0.w * v0.w)) + ((v1.x * v1.x + v1.y * v1.y) + (v1.z * v1.z + v1.w * v1.w)); }
                    u32x4 o; o.x = pk2(v0.x, v0.y); o.y = pk2(v0.z, v0.w); o.z = pk2(v1.x, v1.y); o.w = pk2(v1.z, v1.w); *(u32x4*)(rowp + bj * 128) = o; }
                if (vt) { vs1 += __shfl_xor(vs1, 16); vs1 += __shfl_xor(vs1, 32); vs2 += __shfl_xor(vs2, 16); vs2 += __shfl_xor(vs2, 32);
                    if (fq == 0) { float2 w_; w_.x = vs1; w_.y = vs2; *(float2*)(vst + ((size_t)row * 8 + (u.pn - 2) * 4 + wc) * 2) = w_; } }
            }
    }
};
struct EpiGluTile {
    static constexpr bool PERM = true, AFTER_DRAIN = false;
    const bf16_t* yg; const bf16_t* proj; const float* bglu; bf16_t* mix;
    __device__ __forceinline__ void operator()(const pg8::f32x4 (&acc)[2][2][4][2], const pg8::Unit& u, int wr, int wc, int fr, int fq) const {
        asm volatile("" : "+v"(fr), "+v"(fq));
        const int colb = u.pn * 256 + wc * 32 + 8 * fq;
        f32x4 bv[2][2];
#pragma unroll
        for (int bj = 0; bj < 2; ++bj)
#pragma unroll
            for (int n = 0; n < 2; ++n) bv[bj][n] = *(const f32x4*)(bglu + colb + bj * 128 + n * 4);
#pragma unroll
        for (int ai = 0; ai < 2; ++ai)
#pragma unroll
            for (int m = 0; m < 4; ++m) { const int row = u.pm * 256 + ai * 128 + wr * 64 + m * 16 + fr;
#pragma unroll
                for (int bj = 0; bj < 2; ++bj) { const int col = colb + bj * 128; const f32x4 v0 = acc[ai][bj][m][0] + bv[bj][0], v1 = acc[ai][bj][m][1] + bv[bj][1];
                    const u32x4 yw = *(const u32x4*)(yg + (size_t)row * 512 + col), gw = *(const u32x4*)(proj + (size_t)row * NPROJ + 2048 + col);
                    u32x4 o; o.x = pk2(bflo(yw.x) * sigmoid_f(v0.x) * bflo(gw.x), bfhi(yw.x) * sigmoid_f(v0.y) * bfhi(gw.x)); o.y = pk2(bflo(yw.y) * sigmoid_f(v0.z) * bflo(gw.y), bfhi(yw.y) * sigmoid_f(v0.w) * bfhi(gw.y));
                    o.z = pk2(bflo(yw.z) * sigmoid_f(v1.x) * bflo(gw.z), bfhi(yw.z) * sigmoid_f(v1.y) * bfhi(gw.z)); o.w = pk2(bflo(yw.w) * sigmoid_f(v1.z) * bflo(gw.w), bfhi(yw.w) * sigmoid_f(v1.w) * bfhi(gw.w));
                    *(u32x4*)(mix + (size_t)row * DM + 512 + col) = o; }
                if (m & 1) asm volatile("" ::: "memory"); }
    }
};
template <class ET> __device__ __forceinline__ void gemm_fast_tile(const Ctx& c, const bf16_t* A, const bf16_t* Bt, int M, int N, int K, const ET& e) {
    pg8::Gemm g{A, Bt, M, N, K}; pg8::StaticOrder S; S.init(M, N, (int)gridDim.x, (int)blockIdx.x);
    pg8::gemm_phase<ET, pg8::StaticOrder, true, true>((PG8_LAS unsigned char*)c.lds, g, S, e, c.tid);
    __syncthreads();
}


struct LatentOrder {
    pg8::StaticOrder s;
    __device__ void init(int N, int G_, int c_) { s.init(NB * SEQ, N, G_, c_); }
    __device__ bool next(int i, pg8::Unit& u) const { if (!s.next(i, u)) return false; u.pm = (u.pm >> 4) * 17 + (u.pm & 15) + 1; return true; }
    __device__ __forceinline__ void a_ready(const pg8::Unit&) const {}
    __device__ __forceinline__ void done(const pg8::Unit&) const {}
};
struct EpiOutTile {
    static constexpr bool PERM = true, AFTER_DRAIN = false;
    const float* xold; float* xnew; const float* mods; const float* mods_next; const float* gnext; bf16_t* xm; float* rss;
    __device__ __forceinline__ void operator()(const pg8::f32x4 (&acc)[2][2][4][2], const pg8::Unit& u, int wr, int wc, int fr, int fq) const {
        asm volatile("" : "+v"(fr), "+v"(fq));
        const int b = u.pm / 17, j = u.pm - b * 17;
        const int colb = u.pn * 256 + wc * 32 + 8 * fq;
        const size_t off0 = ((size_t)b * SEQ + (j - 1) * 256 + wr * 64 + fr) * DM + colb;
        const size_t row0 = (size_t)u.pm * 256 + wr * 64 + fr;
        float ss[2][4];
#pragma unroll
        for (int ai = 0; ai < 2; ++ai)
#pragma unroll
            for (int m = 0; m < 4; ++m) ss[ai][m] = 0.f;
#define EPI_OUT_BATCH(BJ, AI0, NAI) do { \
            f32x4 xo[NAI][4][2]; \
            _Pragma("unroll") for (int a_ = 0; a_ < NAI; ++a_) _Pragma("unroll") for (int m = 0; m < 4; ++m) { const float* xp = xold + off0 + (size_t)((AI0 + a_) * 128 + m * 16) * DM + BJ * 128; xo[a_][m][0] = *(const f32x4*)xp; xo[a_][m][1] = *(const f32x4*)(xp + 4); } \
            const int col = colb + BJ * 128; \
            const f32x4 gt0 = *(const f32x4*)(mods + (size_t)b * 3072 + 2048 + col), gt1 = *(const f32x4*)(mods + (size_t)b * 3072 + 2048 + col + 4); \
            f32x4 an0 = (f32x4){0.f, 0.f, 0.f, 0.f}, an1 = an0; \
            if (mods_next) { an0 = *(const f32x4*)(gnext + col) * (*(const f32x4*)(mods_next + (size_t)b * 3072 + 1024 + col) + 1.f); an1 = *(const f32x4*)(gnext + col + 4) * (*(const f32x4*)(mods_next + (size_t)b * 3072 + 1024 + col + 4) + 1.f); } \
            _Pragma("unroll") for (int a_ = 0; a_ < NAI; ++a_) _Pragma("unroll") for (int m = 0; m < 4; ++m) { const int ai = AI0 + a_; \
                    const f32x4 x0 = xo[a_][m][0] + gt0 * acc[ai][BJ][m][0], x1 = xo[a_][m][1] + gt1 * acc[ai][BJ][m][1]; \
                    float* xp = xnew + off0 + (size_t)(ai * 128 + m * 16) * DM + BJ * 128; *(f32x4*)xp = x0; *(f32x4*)(xp + 4) = x1; \
                    ss[ai][m] += ((x0.x * x0.x + x0.y * x0.y) + (x0.z * x0.z + x0.w * x0.w)) + ((x1.x * x1.x + x1.y * x1.y) + (x1.z * x1.z + x1.w * x1.w)); \
                    if (mods_next) { const f32x4 h0 = x0 * an0, h1 = x1 * an1; u32x4 w; w.x = pk2(h0.x, h0.y); w.y = pk2(h0.z, h0.w); w.z = pk2(h1.x, h1.y); w.w = pk2(h1.z, h1.w); \
                        *(u32x4*)(xm + (row0 + ai * 128 + m * 16) * DM + col) = w; } } \
            asm volatile("" ::: "memory"); } while (0)
        EPI_OUT_BATCH(0, 0, 1); EPI_OUT_BATCH(0, 1, 1); EPI_OUT_BATCH(1, 0, 1); EPI_OUT_BATCH(1, 1, 1);
#undef EPI_OUT_BATCH
        if (mods_next) {
#pragma unroll
            for (int ai = 0; ai < 2; ++ai)
#pragma unroll
                for (int m = 0; m < 4; ++m) { float s_ = ss[ai][m]; s_ += __shfl_xor(s_, 16); s_ += __shfl_xor(s_, 32); if (fq == 0) rss[(row0 + ai * 128 + m * 16) * 16 + u.pn * 4 + wc] = s_; }
        }
    }
};
__device__ __forceinline__ void out_ctx_small(const Ctx& c, int l, const float* cold, float* cnew) {
    const P& p = *c.p;
    const bf16_t* mix = (const bf16_t*)(p.ws + WS_MIX); const bf16_t* wt = (const bf16_t*)(p.ws + WS_WOUT) + (size_t)l * DM * DM;
    const float* mods = (const float*)(p.ws + WS_MODS) + (size_t)l * 5 * 3072 + 4 * 3072; const float* modsn = (const float*)(p.ws + WS_MODS) + (size_t)(l + 1) * 5 * 3072 + 4 * 3072;
    const float* gnext = p.in[4] + (l + 1) * DM; bf16_t* xm = (bf16_t*)(p.ws + WS_XM); float* rss = (float*)(p.ws + WS_RSS);
    const int wid = __builtin_amdgcn_readfirstlane(c.wid), fr = c.lane & 15, fq = c.lane >> 4, rg = wid & 3, kh = wid >> 2;
    float* red = (float*)c.lds;
    for (int t = blockIdx.x; t < 256; t += gridDim.x) {
        const int rm = t >> 4, cn = t & 15;
        const int cr = rm * 64 + rg * 16 + fr, b = cr >> 8, ti = cr & 255;
        const size_t m = (size_t)b * TPB + ti;
        f32x4 acc[4];
#pragma unroll
        for (int q = 0; q < 4; ++q) acc[q] = (f32x4){0.f, 0.f, 0.f, 0.f};
        const bf16_t* a0 = mix + m * DM + kh * 512 + fq * 8; const bf16_t* b0 = wt + (size_t)(cn * 64 + fr) * DM + kh * 512 + fq * 8;
#pragma unroll 4
        for (int k = 0; k < 512; k += 32) { const bf16x8 af = *(const bf16x8*)(a0 + k);
#pragma unroll
            for (int q = 0; q < 4; ++q) { const bf16x8 bf = *(const bf16x8*)(b0 + (size_t)q * 16 * DM + k); acc[q] = __builtin_amdgcn_mfma_f32_16x16x32_bf16(bf, af, acc[q], 0, 0, 0); } }
        __syncthreads();
        if (kh == 1) {
#pragma unroll
            for (int q = 0; q < 4; ++q) *(f32x4*)(red + ((rg * 64 + c.lane) * 4 + q) * 4) = acc[q]; }
        __syncthreads();
        if (kh == 0) {
            float ss = 0.f; const size_t off = ((size_t)b * NCTX + ti) * DM;
#pragma unroll
            for (int q = 0; q < 4; ++q) { const int col = cn * 64 + q * 16 + 4 * fq;
                const f32x4 a2 = acc[q] + *(const f32x4*)(red + ((rg * 64 + c.lane) * 4 + q) * 4);
                const f32x4 gt = *(const f32x4*)(mods + 2048 + col), sc = *(const f32x4*)(modsn + 1024 + col), gv = *(const f32x4*)(gnext + col);
                const f32x4 o = *(const f32x4*)(cold + off + col); const f32x4 xn = o + gt * a2;
                *(f32x4*)(cnew + off + col) = xn; ss += (xn.x * xn.x + xn.y * xn.y) + (xn.z * xn.z + xn.w * xn.w);
                const f32x4 h = xn * gv * (sc + 1.f); u32x2 w; w.x = pk2(h.x, h.y); w.y = pk2(h.z, h.w); *(u32x2*)(xm + m * DM + col) = w; }
            ss += __shfl_xor(ss, 16); ss += __shfl_xor(ss, 32); if (fq == 0) rss[m * 16 + cn] = ss;
        }
    }
    __syncthreads();
}

__device__ __forceinline__ void phase_in(const Ctx& c, int l) {
    const P& p = *c.p;
    EpiIn e{(const float*)(p.ws + WS_RSS), (const float*)(p.ws + WS_BIAS) + (size_t)l * 5 * NPROJ, (bf16_t*)(p.ws + WS_PROJ), l & 1};
    #ifdef USE_PG8
    { const int i_ = l >> 1; EpiInTile et{e.rss, e.bias, e.proj, e.odd, p.in[24] + i_ * 128, p.in[25] + i_ * 128, (const float*)(p.ws + WS_ROPE), (float*)(c.lds + 131072), (float*)(p.ws + WS_VST)}; gemm_fast_tile(c, (const bf16_t*)(p.ws + WS_XM), (const bf16_t*)(p.ws + WS_WIN) + (size_t)l * NPROJ * DM, MTOK, NPROJ, DM, et); }
#else
    gemm_simple(c, (const bf16_t*)(p.ws + WS_XM), DM, (const bf16_t*)(p.ws + WS_WIN) + (size_t)l * NPROJ * DM, DM, MTOK, NPROJ, DM, e);
#endif
}
__device__ __forceinline__ void phase_out(const Ctx& c, int l) {
    const P& p = *c.p;
    float* cres = (float*)(p.ws + WS_CTXRES);
    const bool last = l == DEPTH - 1;
    EpiOutTile e{l == 0 ? p.in[0] : p.out, p.out, (const float*)(p.ws + WS_MODS) + (size_t)l * 5 * 3072, last ? nullptr : (const float*)(p.ws + WS_MODS) + (size_t)(l + 1) * 5 * 3072,
                 last ? nullptr : p.in[4] + (l + 1) * DM, (bf16_t*)(p.ws + WS_XM), (float*)(p.ws + WS_RSS)};
    pg8::Gemm g{(const bf16_t*)(p.ws + WS_MIX), (const bf16_t*)(p.ws + WS_WOUT) + (size_t)l * DM * DM, MTOK, DM, DM};
    LatentOrder S; S.init(DM, (int)gridDim.x, (int)blockIdx.x);
    pg8::gemm_phase<EpiOutTile, LatentOrder, true, true>((PG8_LAS unsigned char*)c.lds, g, S, e, c.tid);
    __syncthreads();
    if (!last) out_ctx_small(c, l, l == 0 ? p.in[2] : cres, cres);
#if defined(DUPX) && DUPX == 3
    if (l == 0) out_ctx_small(c, l, p.in[2], cres);
#endif
}
__device__ __forceinline__ void phase_glu(const Ctx& c, int l) {
    const P& p = *c.p; const int i = l >> 1;
    EpiGlu e{(const bf16_t*)(p.ws + WS_YG), (const bf16_t*)(p.ws + WS_PROJ), p.in[21] + i * 512, (bf16_t*)(p.ws + WS_MIX)};
    #ifdef USE_PG8
    { EpiGluTile et{e.yg, e.proj, e.bglu, e.mix}; gemm_fast_tile(c, (const bf16_t*)(p.ws + WS_YG), (const bf16_t*)(p.ws + WS_WGLU) + (size_t)i * 512 * 512, MTOK, 512, 512, et); }
#else
    gemm_simple(c, (const bf16_t*)(p.ws + WS_YG), 512, (const bf16_t*)(p.ws + WS_WGLU) + (size_t)i * 512 * 512, 512, MTOK, 512, 512, e);
#endif
}

__device__ __forceinline__ void phase_gmlp(const Ctx& c, int l) {
    const P& p = *c.p; const int i = l >> 1;
    const bf16_t* proj = (const bf16_t*)(p.ws + WS_PROJ); bf16_t* mix = (bf16_t*)(p.ws + WS_MIX);
    const float* vg = p.in[9] + i * 512; const float* ws_ = p.in[10] + (size_t)i * 4 * 128 * 128; const float* bs = p.in[11] + i * 4 * 128;
    float* vn = (float*)c.lds;
    for (int it = blockIdx.x; it < 136 * 4; it += gridDim.x) {
        const int ch = it >> 2, g = it & 3;
        __syncthreads();
        for (int q = c.wid; q < 128; q += NWAVES) {
            const size_t row = (size_t)ch * 128 + q;
            const u32x4 w = *(const u32x4*)(proj + row * NPROJ + 512 + c.lane * 8);
            float v[8] = {bflo(w.x), bfhi(w.x), bflo(w.y), bfhi(w.y), bflo(w.z), bfhi(w.z), bflo(w.w), bfhi(w.w)};
            float s = 0.f;
#pragma unroll
            for (int e = 0; e < 8; ++e) s += v[e];
            const float mu = wave_sum(s) * (1.f / 512.f); float s2 = 0.f;
#pragma unroll
            for (int e = 0; e < 8; ++e) { v[e] -= mu; s2 += v[e] * v[e]; }
            const float rstd = rsqrtf(wave_sum(s2) * (1.f / 512.f) + EPS);
            if ((c.lane >> 4) == g) {
#pragma unroll
                for (int e = 0; e < 8; ++e) { const int cc = (c.lane & 15) * 8 + e; vn[q * 129 + cc] = v[e] * rstd * vg[g * 128 + cc]; }
            }
        }
        __syncthreads();
        const int cc = c.tid & 127, pq = c.tid >> 7;
        for (int pp = pq * 32; pp < pq * 32 + 32; ++pp) {
            const float* wrow = ws_ + ((size_t)g * 128 + pp) * 128;
            float acc = 0.f;
#pragma unroll 8
            for (int q = 0; q < 128; ++q) acc += wrow[q] * vn[q * 129 + cc];
            const float mixed = acc + bs[g * 128 + pp];
            const size_t row = (size_t)ch * 128 + pp;
            const float u = bf2f(proj[row * NPROJ + g * 128 + cc]), ga = bf2f(proj[row * NPROJ + 1024 + g * 128 + cc]);
            mix[row * DM + g * 128 + cc] = (bf16_t)f2bf(u * mixed * ga);
        }
    }
}

__device__ __forceinline__ void phase_s5_naive(const Ctx& c, int l) {
    const P& p = *c.p; const int i = l >> 1;
    const bf16_t* proj = (const bf16_t*)(p.ws + WS_PROJ);
    float* red = (float*)(c.lds + 80 * 1024) + c.wid * 1024;
    for (int it = c.gw; it < NB * 32 * 2; it += c.ngw) {
        const int dir = it & 1, g = (it >> 1) & 31, b = it >> 6, pl = c.lane;
        float* Y = (float*)(p.ws + (dir ? WS_XM : WS_S5));
        const size_t dg = ((size_t)(i * 2 + dir) * 32 + g);
        const float dt = expf(p.in[14][dg]);
        const float lr = p.in[12][dg * 64 + pl], li = p.in[13][dg * 64 + pl];
        const float mag = expf(lr * dt), lbr = mag * cosf(li * dt), lbi = mag * sinf(li * dt);
        const float den = lr * lr + li * li, nre = lbr - 1.f, nim = lbi;
        const float fre = (nre * lr + nim * li) / den, fim = (nim * lr - nre * li) / den;
        float bbr[16], bbi[16], cr[16], ci[16];
#pragma unroll
        for (int h = 0; h < 16; ++h) { const float br = p.in[15][(dg * 64 + pl) * 16 + h], bi = p.in[16][(dg * 64 + pl) * 16 + h];
            bbr[h] = fre * br - fim * bi; bbi[h] = fre * bi + fim * br;
            cr[h] = p.in[17][(dg * 16 + h) * 64 + pl]; ci[h] = p.in[18][(dg * 16 + h) * 64 + pl]; }
        float hr = 0.f, hi = 0.f;
        for (int s0 = 0; s0 < TPB; s0 += 4) {
            u32x4 uw[4][2];
#pragma unroll
            for (int j = 0; j < 4; ++j) { const int s = s0 + j; const int t = dir == 0 ? s : (s < NCTX ? NCTX - 1 - s : NCTX + SEQ - 1 - (s - NCTX));
                const bf16_t* up = proj + (size_t)(b * TPB + t) * NPROJ + 1536 + g * 16; uw[j][0] = *(const u32x4*)up; uw[j][1] = *(const u32x4*)(up + 8); }
#pragma unroll
            for (int j = 0; j < 4; ++j) { const int s = s0 + j; const int t = dir == 0 ? s : (s < NCTX ? NCTX - 1 - s : NCTX + SEQ - 1 - (s - NCTX));
                float u[16];
#pragma unroll
                for (int q = 0; q < 2; ++q) { u[8 * q + 0] = bflo(uw[j][q].x); u[8 * q + 1] = bfhi(uw[j][q].x); u[8 * q + 2] = bflo(uw[j][q].y); u[8 * q + 3] = bfhi(uw[j][q].y);
                    u[8 * q + 4] = bflo(uw[j][q].z); u[8 * q + 5] = bfhi(uw[j][q].z); u[8 * q + 6] = bflo(uw[j][q].w); u[8 * q + 7] = bfhi(uw[j][q].w); }
                float bur = 0.f, bui = 0.f;
#pragma unroll
                for (int h = 0; h < 16; ++h) { bur += bbr[h] * u[h]; bui += bbi[h] * u[h]; }
                const float nhr = lbr * hr - lbi * hi + bur, nhi = lbr * hi + lbi * hr + bui; hr = nhr; hi = nhi;
#pragma unroll
                for (int h = 0; h < 16; ++h) red[h * 64 + pl] = cr[h] * hr - ci[h] * hi;
                asm volatile("s_waitcnt lgkmcnt(0)" ::: "memory");
                const int hh = pl & 15, part = pl >> 4; float sum = 0.f;
#pragma unroll
                for (int q = 0; q < 16; ++q) sum += red[hh * 64 + part * 16 + q];
                sum += __shfl_xor(sum, 16); sum += __shfl_xor(sum, 32);
                if (pl < 16) Y[(size_t)(b * TPB + t) * 512 + g * 16 + pl] = sum;
                asm volatile("s_waitcnt lgkmcnt(0)" ::: "memory");
            }
        }
    }
}
__device__ __forceinline__ void phase_s5comb(const Ctx& c, int l) {
    const P& p = *c.p; const int i = l >> 1;
    const float* Yf = (const float*)(p.ws + WS_S5); const float* Yb = (const float*)(p.ws + WS_XM); const bf16_t* proj = (const bf16_t*)(p.ws + WS_PROJ);
    bf16_t* yg = (bf16_t*)(p.ws + WS_YG); const float* d = p.in[19] + i * 512;
    const size_t n4 = (size_t)MTOK * 512 / 4;
    for (size_t e = (size_t)blockIdx.x * NTHREADS + c.tid; e < n4; e += (size_t)gridDim.x * NTHREADS) {
        const size_t row = e / 128; const int col = (int)(e % 128) * 4;
        const f32x4 a = *(const f32x4*)(Yf + row * 512 + col), b = *(const f32x4*)(Yb + row * 512 + col), dv = *(const f32x4*)(d + col);
        const u32x2 xw = *(const u32x2*)(proj + row * NPROJ + 1536 + col);
        const float y0 = a.x + b.x + dv.x * bflo(xw.x), y1 = a.y + b.y + dv.y * bfhi(xw.x), y2 = a.z + b.z + dv.z * bflo(xw.y), y3 = a.w + b.w + dv.w * bfhi(xw.y);
        u32x2 o; o.x = pk2(gelu_tanh_f(y0), gelu_tanh_f(y1)); o.y = pk2(gelu_tanh_f(y2), gelu_tanh_f(y3));
        *(u32x2*)(yg + row * 512 + col) = o;
    }
}


constexpr size_t S5T_LAM = 0, S5T_BBT = 64 * 1024, S5T_CMT = 320 * 1024;
constexpr size_t WS_WST = WS_S5 + 2 * MiB;
constexpr size_t WS_SCB = WS_S5 + 5 * MiB;
constexpr size_t WS_SR = WS_S5 + 10 * MiB;
typedef float f32x16 __attribute__((ext_vector_type(16)));

__device__ __forceinline__ void phase_s5prep(const Ctx& c) {
    const P& p = *c.p;
    for (int it = c.gw; it < 2 * 2 * 32; it += c.ngw) {
        const int i = it >> 6, dir = (it >> 5) & 1, g = it & 31, pl = c.lane;
        unsigned char* tb = p.ws + WS_S5 + (size_t)i * MiB;
        const size_t dg = ((size_t)(i * 2 + dir) * 32 + g);
        const float dt = expf(p.in[14][dg]);
        const float lr = p.in[12][dg * 64 + pl], li = p.in[13][dg * 64 + pl];
        const float mag = expf(lr * dt), lbr = mag * cosf(li * dt), lbi = mag * sinf(li * dt);
        const float den = lr * lr + li * li, nre = lbr - 1.f, nim = lbi;
        const float fre = (nre * lr + nim * li) / den, fim = (nim * lr - nre * li) / den;
        float* lam = (float*)(tb + S5T_LAM) + ((size_t)(dir * 32 + g) * 64 + pl) * 2; lam[0] = lbr; lam[1] = lbi;
        bf16_t* bbt = (bf16_t*)(tb + S5T_BBT) + (size_t)(dir * 32 + g) * 2 * 64 * 16; bf16_t* cmt = (bf16_t*)(tb + S5T_CMT) + (size_t)(dir * 32 + g) * 16 * 128;
#pragma unroll
        for (int h = 0; h < 16; ++h) { const float br = p.in[15][(dg * 64 + pl) * 16 + h], bi = p.in[16][(dg * 64 + pl) * 16 + h];
            bbt[(0 * 64 + pl) * 16 + h] = (bf16_t)f2bf(fre * br - fim * bi); bbt[(1 * 64 + pl) * 16 + h] = (bf16_t)f2bf(fre * bi + fim * br);
            cmt[h * 128 + 2 * pl] = (bf16_t)f2bf(p.in[17][(dg * 16 + h) * 64 + pl]); cmt[h * 128 + 2 * pl + 1] = (bf16_t)f2bf(-p.in[18][(dg * 16 + h) * 64 + pl]); }
    }
    bf16_t* wst = (bf16_t*)(p.ws + WS_WST);
    for (size_t e = (size_t)blockIdx.x * NTHREADS + c.tid; e < (size_t)2 * 4 * 128 * 128 / 4; e += (size_t)gridDim.x * NTHREADS) {
        const f32x4 v = *(const f32x4*)(p.in[10] + e * 4); u32x2 o; o.x = pk2(v.x, v.y); o.y = pk2(v.z, v.w); *(u32x2*)(wst + e * 4) = o; }
}

__device__ __forceinline__ void phase_gmlp_fast(const Ctx& c, int l) {
    const P& p = *c.p; const int i = l >> 1;
    const bf16_t* proj = (const bf16_t*)(p.ws + WS_PROJ); bf16_t* mix = (bf16_t*)(p.ws + WS_MIX);
    const float* vg = p.in[9] + i * 512; const float* bs = p.in[11] + i * 4 * 128;
    const bf16_t* wst = (const bf16_t*)(p.ws + WS_WST) + (size_t)i * 4 * 128 * 128;
    char* lds = (char*)c.lds;
    float* st = (float*)(lds + 32768);
    const int wid = __builtin_amdgcn_readfirstlane(c.wid), lane = c.lane, r32 = lane & 31, hi = lane >> 5;
    char* ost = lds + 36864 + wid * 4608;
    for (int it = blockIdx.x; it < 136 * 4; it += gridDim.x) {
        const int ch = it >> 2, g = it & 3;
        __syncthreads();
        if (c.tid < 128) {
            const f32x4* vp = (const f32x4*)((const float*)(p.ws + WS_VST) + ((size_t)ch * 128 + c.tid) * 16);
            const f32x4 a0 = vp[0], a1 = vp[1], a2 = vp[2], a3 = vp[3];
            const float s1 = ((a0.x + a0.z) + (a1.x + a1.z)) + ((a2.x + a2.z) + (a3.x + a3.z)), s2 = ((a0.y + a0.w) + (a1.y + a1.w)) + ((a2.y + a2.w) + (a3.y + a3.w));
            const float mu = s1 * (1.f / 512.f); const float var = fmaxf(s2 * (1.f / 512.f) - mu * mu, 0.f);
            st[2 * c.tid] = mu; st[2 * c.tid + 1] = rsqrtf(var + EPS);
        }
        __syncthreads();
        { const int sr = c.tid >> 4, sc = (c.tid & 15) * 8;
            float gv[8];
#pragma unroll
            for (int e = 0; e < 8; ++e) gv[e] = vg[g * 128 + sc + e];
#pragma unroll
            for (int t = 0; t < 2; ++t)
#pragma unroll
                for (int hh = 0; hh < 2; ++hh) { const int q = t * 64 + hh * 32 + sr;
                    const u32x4 w = *(const u32x4*)(proj + ((size_t)ch * 128 + q) * NPROJ + 512 + g * 128 + sc);
                    const float mu = st[2 * q], rs = st[2 * q + 1];
                    u32x4 o; o.x = pk2((bflo(w.x) - mu) * rs * gv[0], (bfhi(w.x) - mu) * rs * gv[1]); o.y = pk2((bflo(w.y) - mu) * rs * gv[2], (bfhi(w.y) - mu) * rs * gv[3]);
                    o.z = pk2((bflo(w.z) - mu) * rs * gv[4], (bfhi(w.z) - mu) * rs * gv[5]); o.w = pk2((bflo(w.w) - mu) * rs * gv[6], (bfhi(w.w) - mu) * rs * gv[7]);
                    *(u32x4*)(lds + t * 16384 + attn::v_st(hh * 32 + sr, sc)) = o; }
        }
        __syncthreads();
        const int pw = wid & 3, cw = wid >> 2;
        f32x16 o0 = {}, o1 = {};
        const int vb = (int)(uintptr_t)lds + attn::v_rd_base(lane);
        const bf16_t* wrow = wst + ((size_t)g * 128 + pw * 32 + r32) * 128 + hi * 8;
#pragma unroll
        for (int t = 0; t < 2; ++t) {
            const bf16x8 pa0 = *(const bf16x8*)(wrow + t * 64), pa1 = *(const bf16x8*)(wrow + t * 64 + 16), pa2 = *(const bf16x8*)(wrow + t * 64 + 32), pa3 = *(const bf16x8*)(wrow + t * 64 + 48);
            if (cw == 0) { attn::pv_one<0>(o0, vb + t * 16384, pa0, pa1, pa2, pa3); attn::pv_one<1>(o1, vb + t * 16384, pa0, pa1, pa2, pa3); }
            else         { attn::pv_one<2>(o0, vb + t * 16384, pa0, pa1, pa2, pa3); attn::pv_one<3>(o1, vb + t * 16384, pa0, pa1, pa2, pa3); }
        }
        {
            int ob = hi * (4 * 144) + r32 * 2; asm volatile("" : "+v"(ob));
#pragma unroll
            for (int r = 0; r < 16; ++r) { const int prow0 = (r & 3) + 8 * (r >> 2); const float b = bs[g * 128 + pw * 32 + prow0 + 4 * hi];
                *(bf16_t*)(ost + ob + prow0 * 144) = (bf16_t)f2bf(o0[r] + b); *(bf16_t*)(ost + ob + prow0 * 144 + 64) = (bf16_t)f2bf(o1[r] + b); }
            asm volatile("s_waitcnt lgkmcnt(0)" ::: "memory");
#pragma unroll
            for (int k = 0; k < 4; ++k) { const int id = k * 64 + lane, row = id >> 3, chk = id & 7;
                const u32x4 mv = *(const u32x4*)(ost + row * 144 + chk * 16);
                const size_t grow = (size_t)ch * 128 + pw * 32 + row; const int col = g * 128 + cw * 64 + chk * 8;
                const u32x4 uv = *(const u32x4*)(proj + grow * NPROJ + col), gvv = *(const u32x4*)(proj + grow * NPROJ + 1024 + col);
                u32x4 w; w.x = pk2(bflo(uv.x) * bflo(mv.x) * bflo(gvv.x), bfhi(uv.x) * bfhi(mv.x) * bfhi(gvv.x)); w.y = pk2(bflo(uv.y) * bflo(mv.y) * bflo(gvv.y), bfhi(uv.y) * bfhi(mv.y) * bfhi(gvv.y));
                w.z = pk2(bflo(uv.z) * bflo(mv.z) * bflo(gvv.z), bfhi(uv.z) * bfhi(mv.z) * bfhi(gvv.z)); w.w = pk2(bflo(uv.w) * bflo(mv.w) * bflo(gvv.w), bfhi(uv.w) * bfhi(mv.w) * bfhi(gvv.w));
                *(u32x4*)(mix + grow * DM + col) = w; }
            asm volatile("s_waitcnt lgkmcnt(0)" ::: "memory");
        }
    }
}

struct cplx { float r, i; };
__device__ __forceinline__ cplx cmul(cplx a, cplx b) { return {a.r * b.r - a.i * b.i, a.r * b.i + a.i * b.r}; }
__device__ __forceinline__ cplx cfma(cplx a, cplx x, cplx b) { return {fmaf(a.r, x.r, fmaf(-a.i, x.i, b.r)), fmaf(a.r, x.i, fmaf(a.i, x.r, b.i))}; }
__device__ __forceinline__ cplx csel(bool s, cplx a, cplx b) { return {s ? a.r : b.r, s ? a.i : b.i}; }
template <bool BWD, bool FINAL>
__device__ __forceinline__ void s5_chunk_scan(f32x16 (&br)[2], f32x16 (&bi)[2], const cplx lam, const cplx Hin, const bool half, cplx& Hout) {
    const cplx lam2 = cmul(lam, lam), lam3 = cmul(lam2, lam), lam4 = cmul(lam2, lam2);
    cplx E[2][4];
#pragma unroll
    for (int tb = 0; tb < 2; ++tb)
#pragma unroll
        for (int q = 0; q < 4; ++q) {
            if (!BWD) { cplx w = {br[tb][4 * q], bi[tb][4 * q]};
#pragma unroll
                for (int j = 1; j < 4; ++j) { w = cfma(lam, w, (cplx){br[tb][4 * q + j], bi[tb][4 * q + j]}); br[tb][4 * q + j] = w.r; bi[tb][4 * q + j] = w.i; }
                E[tb][q] = w; }
            else { cplx w = {br[tb][4 * q + 3], bi[tb][4 * q + 3]};
#pragma unroll
                for (int j = 2; j >= 0; --j) { w = cfma(lam, w, (cplx){br[tb][4 * q + j], bi[tb][4 * q + j]}); br[tb][4 * q + j] = w.r; bi[tb][4 * q + j] = w.i; }
                E[tb][q] = w; }
        }
    cplx Eev[2][4], Eod[2][4];
#pragma unroll
    for (int tb = 0; tb < 2; ++tb)
#pragma unroll
        for (int q = 0; q < 4; ++q) { const cplx Ep = {__shfl_xor(E[tb][q].r, 32), __shfl_xor(E[tb][q].i, 32)}; Eev[tb][q] = csel(half, Ep, E[tb][q]); Eod[tb][q] = csel(half, E[tb][q], Ep); }
    cplx H = Hin; cplx Hg[2][4];
    if (!BWD) {
#pragma unroll
        for (int tb = 0; tb < 2; ++tb)
#pragma unroll
            for (int q = 0; q < 4; ++q) { const cplx He = H; H = cfma(lam4, H, Eev[tb][q]); const cplx Ho = H; H = cfma(lam4, H, Eod[tb][q]); Hg[tb][q] = csel(half, Ho, He); }
    } else {
#pragma unroll
        for (int tb = 1; tb >= 0; --tb)
#pragma unroll
            for (int q = 3; q >= 0; --q) { const cplx Ho = H; H = cfma(lam4, H, Eod[tb][q]); const cplx He = H; H = cfma(lam4, H, Eev[tb][q]); Hg[tb][q] = csel(half, Ho, He); }
    }
    Hout = H;
    if (FINAL) {
#pragma unroll
        for (int tb = 0; tb < 2; ++tb)
#pragma unroll
            for (int q = 0; q < 4; ++q)
#pragma unroll
                for (int j = 0; j < 4; ++j) { const int e = BWD ? 3 - j : j; const cplx pw = e == 0 ? lam : (e == 1 ? lam2 : (e == 2 ? lam3 : lam4));
                    const cplx h = cfma(pw, Hg[tb][q], (cplx){br[tb][4 * q + j], bi[tb][4 * q + j]}); br[tb][4 * q + j] = h.r; bi[tb][4 * q + j] = h.i; }
    }
}
__device__ __forceinline__ cplx cpow2n(cplx a, int n) { for (int k = 0; k < n; ++k) a = cmul(a, a); return a; }
__device__ __forceinline__ cplx ldc(const float* p) { const float2 v = *(const float2*)p; return {v.x, v.y}; }

__device__ __forceinline__ int s5_rs(int rk) { return rk == 0 ? 0 : (rk <= 4 ? 4 + 5 * (rk - 1) : 24 + 4 * (rk - 5)); }
__device__ __forceinline__ int s5_rl(int rk) { return (rk >= 1 && rk <= 4) ? 5 : 4; }
constexpr int S5L_LAM = 0, S5L_BB = 1024, S5L_CM = 1024 + 8192, S5L_HS = 1024 + 16384, S5L_HB = S5L_HS + 8 * 4608, S5L_END = S5L_HB + 8 * 2560;
template <bool OUT>
__device__ __forceinline__ void phase_s5_fast(const Ctx& c, int l) {
    const P& p = *c.p; const int i = l >> 1;
    const bf16_t* proj = (const bf16_t*)(p.ws + WS_PROJ);
    const unsigned char* tb_ = p.ws + WS_S5 + (size_t)i * MiB;
    float* SCB = (float*)(p.ws + WS_SCB); float* SR = (float*)(p.ws + WS_SR); bf16_t* yg = (bf16_t*)(p.ws + WS_YG);
    const int wid = __builtin_amdgcn_readfirstlane(c.wid);
    char* lds = (char*)c.lds;
    const int G = gridDim.x, nsub = G >> 5;
    if ((int)blockIdx.x >= nsub * 32) return;
    const int g = blockIdx.x & 31, sub = blockIdx.x >> 5;
    __syncthreads();
    {
        const float* LAM = (const float*)(tb_ + S5T_LAM); const bf16_t* BBT = (const bf16_t*)(tb_ + S5T_BBT); const bf16_t* CMT = (const bf16_t*)(tb_ + S5T_CMT);
        const int ln = c.lane, r32 = ln & 31, hi = ln >> 5;
        if (c.tid < 128) { const int d = c.tid >> 6, ps = c.tid & 63; *(float2*)(lds + S5L_LAM + (d * 64 + ps) * 8) = *(const float2*)(LAM + ((size_t)(d * 32 + g) * 64 + ps) * 2); }
        { const int d = wid >> 2, ri = (wid >> 1) & 1, pb = wid & 1;
            *(u32x4*)(lds + S5L_BB + (wid * 64 + ln) * 16) = *(const u32x4*)(BBT + (((size_t)(d * 32 + g) * 2 + ri) * 64 + pb * 32 + r32) * 16 + hi * 8); }
        { const int d = wid >> 2, pb = (wid >> 1) & 1, ks = wid & 1;
            *(u32x4*)(lds + S5L_CM + (wid * 64 + ln) * 16) = *(const u32x4*)(CMT + ((size_t)(d * 32 + g) * 16 + (ln & 15)) * 128 + pb * 64 + ks * 32 + (ln >> 4) * 8); }
    }
    __syncthreads();
    char* hs = lds + S5L_HS + wid * 4608;
#pragma unroll 1
    for (int j = sub * 8 + wid; j < 64; j += nsub * 8) {
        int lane = c.lane; asm volatile("" : "+v"(lane));
        const int r32 = lane & 31; const bool half = lane >= 32;
        const int b = j >> 4, rk = j & 15, c0 = s5_rs(rk), nc = s5_rl(rk);
        const size_t m0 = (size_t)b * TPB + 64 * c0;
        cplx Hf[2];
        float* hb = (float*)(lds + S5L_HB + wid * 2560);
        cplx SRf[2], SRb[2], pwb[2];
#pragma unroll
        for (int pb = 0; pb < 2; ++pb) { Hf[pb] = {0.f, 0.f}; SRf[pb] = {0.f, 0.f}; SRb[pb] = {0.f, 0.f}; pwb[pb] = {1.f, 0.f};
}
        if (OUT) {
#pragma unroll
            for (int pb = 0; pb < 2; ++pb) { const int ps = pb * 32 + r32;
                const float* srb = SR + (((size_t)(b * 16) * 32 + g) * 2 * 64 + ps) * 2;
                constexpr size_t KS = 32 * 2 * 64 * 2;
                { const cplx L64 = cpow2n(ldc((const float*)(lds + S5L_LAM + (0 * 64 + ps) * 8)), 6), L256 = cpow2n(L64, 2), L320 = cmul(L256, L64);
                    cplx v[15];
#pragma unroll
                    for (int kk = 0; kk < 15; ++kk) v[kk] = ldc(srb + kk * KS);
                    cplx H = {0.f, 0.f};
#pragma unroll
                    for (int kk = 0; kk < 15; ++kk) if (kk < rk) H = cfma((kk >= 1 && kk <= 4) ? L320 : L256, H, v[kk]);
                    Hf[pb] = H; }
                { const cplx L64 = cpow2n(ldc((const float*)(lds + S5L_LAM + (1 * 64 + ps) * 8)), 6), L256 = cpow2n(L64, 2), L320 = cmul(L256, L64);
                    cplx v[16];
#pragma unroll
                    for (int kk = 0; kk < 16; ++kk) v[kk] = ldc(srb + kk * KS + 128);
                    cplx H = {0.f, 0.f};
                    if (rk >= 1) { H = v[0];
#pragma unroll
                        for (int kk = 15; kk >= 2; --kk) if (kk > rk) H = cfma((kk >= 1 && kk <= 4) ? L320 : L256, H, v[kk]); }
                    const float* scb = SCB + ((((size_t)b * 68 + c0) * 32 + g) * 64 + ps) * 2; constexpr size_t CS = 32 * 64 * 2;
                    cplx sv[5];
#pragma unroll
                    for (int q = 1; q < 5; ++q) sv[q] = (q < nc) ? ldc(scb + q * CS) : (cplx){0.f, 0.f};
#define HB_ST(q, Hv) do { if (!half) { float2 o_; o_.x = (Hv).r; o_.y = (Hv).i; *(float2*)(hb + ((pb * 5 + (q)) * 32 + r32) * 2) = o_; } } while (0)
                    if (nc == 5) { HB_ST(4, H); H = cfma(L64, H, sv[4]); }
                    HB_ST(3, H); H = cfma(L64, H, sv[3]); HB_ST(2, H); H = cfma(L64, H, sv[2]); HB_ST(1, H); H = cfma(L64, H, sv[1]); HB_ST(0, H); }
#undef HB_ST
            }
        }
        asm volatile("s_waitcnt lgkmcnt(0)" ::: "memory");
        bf16x8 dfr;
        { const int hh = lane & 15, l4 = lane >> 4; const unsigned dv = f2bf(p.in[19][i * 512 + g * 16 + hh]);
#pragma unroll
            for (int e = 0; e < 8; ++e) dfr[e] = (short)((8 * l4 + e == hh) ? dv : 0u); }
        bf16x8 ua[2];
#pragma unroll
        for (int tb = 0; tb < 2; ++tb) ua[tb] = *(const bf16x8*)(proj + (m0 + tb * 32 + r32) * NPROJ + 1536 + g * 16 + (lane >> 5) * 8);
#pragma unroll 1
        for (int cc = 0; cc < nc; ++cc) {
            int ln = lane; asm volatile("" : "+v"(ln));
            const int r32c = ln & 31, hi = ln >> 5, l15 = ln & 15, l4 = ln >> 4;
            const size_t mc = m0 + 64 * cc; const size_t chunk = (size_t)b * 68 + c0 + cc;
            const bf16x8 u0 = ua[0], u1 = ua[1];
            if (cc + 1 < nc) {
#pragma unroll
                for (int tb = 0; tb < 2; ++tb) ua[tb] = *(const bf16x8*)(proj + (mc + 64 + tb * 32 + r32c) * NPROJ + 1536 + g * 16 + hi * 8); }
            f32x4 yacc[4];
            if (OUT) {
#pragma unroll
                for (int t = 0; t < 4; ++t) { bf16x8 xa = (bf16x8){0, 0, 0, 0, 0, 0, 0, 0};
                    if (l4 < 2) xa = *(const bf16x8*)(proj + (mc + t * 16 + l15) * NPROJ + 1536 + g * 16 + l4 * 8);
                    yacc[t] = __builtin_amdgcn_mfma_f32_16x16x32_bf16(xa, dfr, (f32x4){0.f, 0.f, 0.f, 0.f}, 0, 0, 0); }
            }
#pragma unroll
            for (int pb = 0; pb < 2; ++pb)
#pragma unroll 1
                for (int d = 0; d < 2; ++d) {
                    const cplx lam_ = ldc((const float*)(lds + S5L_LAM + (d * 64 + pb * 32 + r32c) * 8)); const cplx L64_ = cpow2n(lam_, 6);
                    const bf16x8 bre = *(const bf16x8*)(lds + S5L_BB + (((d * 2 + 0) * 2 + pb) * 64 + ln) * 16), bim = *(const bf16x8*)(lds + S5L_BB + (((d * 2 + 1) * 2 + pb) * 64 + ln) * 16);
                    f32x16 br[2], bi[2];
                    br[0] = __builtin_amdgcn_mfma_f32_32x32x16_bf16(u0, bre, (f32x16){}, 0, 0, 0); bi[0] = __builtin_amdgcn_mfma_f32_32x32x16_bf16(u0, bim, (f32x16){}, 0, 0, 0);
                    br[1] = __builtin_amdgcn_mfma_f32_32x32x16_bf16(u1, bre, (f32x16){}, 0, 0, 0); bi[1] = __builtin_amdgcn_mfma_f32_32x32x16_bf16(u1, bim, (f32x16){}, 0, 0, 0);
                    cplx Hin = {0.f, 0.f}, Hout;
                    if (OUT) { if (d == 0) Hin = Hf[pb]; else Hin = ldc(hb + ((pb * 5 + cc) * 32 + r32c) * 2); }
                    if (d == 0) s5_chunk_scan<false, OUT>(br, bi, lam_, Hin, half, Hout); else s5_chunk_scan<true, OUT>(br, bi, lam_, Hin, half, Hout);
                    if (OUT) {
                        if (d == 0) Hf[pb] = Hout;
#pragma unroll
                        for (int tb = 0; tb < 2; ++tb) {
                            int ob = hi * (4 * 144) + r32c * 4; asm volatile("" : "+v"(ob));
#pragma unroll
                            for (int r = 0; r < 16; ++r) *(unsigned*)(hs + ob + ((r & 3) + 8 * (r >> 2)) * 144) = pk2(br[tb][r], bi[tb][r]);
                            asm volatile("s_waitcnt lgkmcnt(0)" ::: "memory");
#pragma unroll
                            for (int ks = 0; ks < 2; ++ks) { const bf16x8 cf = *(const bf16x8*)(lds + S5L_CM + (((d * 2 + pb) * 2 + ks) * 64 + ln) * 16);
#pragma unroll
                                for (int tq = 0; tq < 2; ++tq) { const bf16x8 af = *(const bf16x8*)(hs + (tq * 16 + l15) * 144 + ks * 64 + l4 * 16);
                                    yacc[tb * 2 + tq] = __builtin_amdgcn_mfma_f32_16x16x32_bf16(af, cf, yacc[tb * 2 + tq], 0, 0, 0); } }
                            asm volatile("s_waitcnt lgkmcnt(0)" ::: "memory");
                        }
                    } else {
                        if (d == 0) SRf[pb] = cfma(L64_, SRf[pb], Hout);
                        else { SRb[pb] = cfma(pwb[pb], Hout, SRb[pb]); pwb[pb] = cmul(pwb[pb], L64_);
                            if (!half) { float2 o; o.x = Hout.r; o.y = Hout.i; *(float2*)(SCB + ((chunk * 32 + g) * 64 + pb * 32 + r32c) * 2) = o; } }
                    }
                }
            if (OUT) {
#pragma unroll
                for (int tq = 0; tq < 4; ++tq)
#pragma unroll
                    for (int e = 0; e < 4; ++e) *(bf16_t*)(hs + (tq * 16 + l4 * 4 + e) * 48 + l15 * 2) = (bf16_t)f2bf(gelu_tanh_f(yacc[tq][e]));
                asm volatile("s_waitcnt lgkmcnt(0)" ::: "memory");
#pragma unroll
                for (int q = 0; q < 2; ++q) { const int id = q * 64 + ln, row = id >> 1, hf = id & 1;
                    *(u32x4*)(yg + (mc + row) * 512 + g * 16 + hf * 8) = *(const u32x4*)(hs + row * 48 + hf * 16); }
                asm volatile("s_waitcnt lgkmcnt(0)" ::: "memory");
            }
        }
        if (!OUT) {
            if (!half) {
#pragma unroll
                for (int pb = 0; pb < 2; ++pb) { float2 o; o.x = SRf[pb].r; o.y = SRf[pb].i; *(float2*)(SR + ((((size_t)(b * 16 + rk) * 32 + g) * 2 + 0) * 64 + pb * 32 + r32) * 2) = o;
                    o.x = SRb[pb].r; o.y = SRb[pb].i; *(float2*)(SR + ((((size_t)(b * 16 + rk) * 32 + g) * 2 + 1) * 64 + pb * 32 + r32) * 2) = o; }
            }
        }
    }
    __syncthreads();
}

__device__ __forceinline__ void phase_headnorm(const Ctx& c, int l) {
    const P& p = *c.p; const int i = l >> 1;
    bf16_t* proj = (bf16_t*)(p.ws + WS_PROJ); const float* rope = (const float*)(p.ws + WS_ROPE);
    for (int it = c.gw; it < MTOK * 10; it += c.ngw) {
        const int m = it / 10, hd = it % 10; const int col0 = hd < 8 ? hd * 128 : 1024 + (hd - 8) * 128;
        const float* g = (hd < 8 ? p.in[24] : p.in[25]) + i * 128;
        const int a = c.lane >> 5, pr = c.lane & 31, i1 = a * 64 + pr, i2 = i1 + 32;
        bf16_t* hp = proj + (size_t)m * NPROJ + col0;
        const float x1 = bf2f(hp[i1]), x2 = bf2f(hp[i2]);
        const float hr = rsqrtf(wave_sum(x1 * x1 + x2 * x2) * (1.f / 128.f) + EPS);
        float y1 = x1 * hr * g[i1], y2 = x2 * hr * g[i2];
        const int t = m % TPB;
        if (t >= NCTX) { const int tl = t - NCTX; const int pos = a == 0 ? tl / 64 : tl % 64; const float cs = rope[2 * (pos * 32 + pr)], sn = rope[2 * (pos * 32 + pr) + 1];
            const float o1 = y1 * cs - y2 * sn, o2 = y1 * sn + y2 * cs; y1 = o1; y2 = o2; }
        hp[i1] = (bf16_t)f2bf(y1); hp[i2] = (bf16_t)f2bf(y2);
    }
}
__device__ __forceinline__ void phase_attn_naive(const Ctx& c, int l) {
    const P& p = *c.p;
    const bf16_t* proj = (const bf16_t*)(p.ws + WS_PROJ); bf16_t* mix = (bf16_t*)(p.ws + WS_MIX);
    float* sc = (float*)c.lds + c.wid * TPB;
    const bool with_ctx = l != DEPTH - 1;
    const int nit = with_ctx ? MTOK : NB * SEQ;
    const float scale = 0.08838834764831845f;
    for (int it = blockIdx.x; it < nit; it += gridDim.x) {
        int m; if (with_ctx) m = it; else { const int b = it / SEQ; m = b * TPB + NCTX + (it - b * SEQ); }
        const int b = m / TPB, t = m - b * TPB; const int nk = t < NCTX ? NCTX : TPB;
        const int hq = c.wid, kv = hq >> 2;
        const bf16_t* qp = proj + (size_t)m * NPROJ + hq * 128;
        float* qs = (float*)(c.lds + 140 * 1024) + c.wid * 128;
        { const unsigned w = *(const unsigned*)(qp + 2 * c.lane); qs[2 * c.lane] = bflo(w); qs[2 * c.lane + 1] = bfhi(w); }
        asm volatile("s_waitcnt lgkmcnt(0)" ::: "memory");
        float mx = -1e30f;
        for (int j0 = 0; j0 < nk; j0 += 64) {
            const bf16_t* kp = proj + (size_t)(b * TPB + j0 + c.lane) * NPROJ + 1024 + kv * 128;
            float s = 0.f;
#pragma unroll 4
            for (int d8 = 0; d8 < 16; ++d8) { const u32x4 w = *(const u32x4*)(kp + d8 * 8); const f32x4 qa = *(const f32x4*)(qs + d8 * 8), qb = *(const f32x4*)(qs + d8 * 8 + 4);
                s += qa.x * bflo(w.x) + qa.y * bfhi(w.x) + qa.z * bflo(w.y) + qa.w * bfhi(w.y) + qb.x * bflo(w.z) + qb.y * bfhi(w.z) + qb.z * bflo(w.w) + qb.w * bfhi(w.w); }
            s *= scale; sc[j0 + c.lane] = s; mx = fmaxf(mx, s);
        }
#pragma unroll
        for (int o = 1; o < 64; o <<= 1) mx = fmaxf(mx, __shfl_xor(mx, o));
        float ls = 0.f;
        for (int j0 = 0; j0 < nk; j0 += 64) { const float e = __expf(sc[j0 + c.lane] - mx); sc[j0 + c.lane] = e; ls += e; }
        ls = wave_sum(ls);
        asm volatile("s_waitcnt lgkmcnt(0)" ::: "memory");
        float o0 = 0.f, o1 = 0.f;
        const bf16_t* vp = proj + (size_t)(b * TPB) * NPROJ + 1280 + kv * 128 + 2 * c.lane;
#pragma unroll 4
        for (int j = 0; j < nk; ++j) { const unsigned w = *(const unsigned*)(vp + (size_t)j * NPROJ); const float pj = sc[j]; o0 += pj * bflo(w); o1 += pj * bfhi(w); }
        const float inv = 1.f / ls;
        const unsigned gw_ = *(const unsigned*)(proj + (size_t)m * NPROJ + 1536 + hq * 128 + 2 * c.lane);
        *(unsigned*)(mix + (size_t)m * DM + hq * 128 + 2 * c.lane) = pk2(o0 * inv * bflo(gw_), o1 * inv * bfhi(gw_));
        asm volatile("s_waitcnt lgkmcnt(0)" ::: "memory");
    }
}


__device__ __forceinline__ void phase_attn(const Ctx& c, int l) {
    const P& p = *c.p;
    const bf16_t* proj = (const bf16_t*)(p.ws + WS_PROJ); bf16_t* mix = (bf16_t*)(p.ws + WS_MIX);
    const int G = gridDim.x, bid = blockIdx.x; const int vcu = (G % 8 == 0) ? (bid % 8) * (G / 8) + bid / 8 : bid;
    const int nu = 512 + (l != DEPTH - 1 ? 32 : 0);
    for (int u = vcu; u < nu; u += G) {
        int b, hq, row0, seq;
        if (u < 512) { const int qb = u & 15, hql = (u >> 4) & 3, kvh = (u >> 6) & 1; b = u >> 7; hq = kvh * 4 + hql; row0 = b * TPB + NCTX + qb * 256; seq = TPB; }
        else { const int v = u - 512; b = v >> 3; hq = v & 7; row0 = b * TPB; seq = NCTX; }
        const int kv = hq >> 2;
        const bf16_t* kvb = proj + (size_t)b * TPB * NPROJ;
        attn::attn_dense_body<bf16_t>(proj + (size_t)row0 * NPROJ + hq * 128, kvb + 1024 + kv * 128, kvb + 1280 + kv * 128,
                                      mix + (size_t)row0 * DM + hq * 128, proj + (size_t)row0 * NPROJ + 1536 + hq * 128, seq, (char*)c.lds, c.tid);
        __syncthreads();
    }
}

__device__ __forceinline__ void phase_final(const Ctx& c) {
    const P& p = *c.p; const float* g = p.in[26];
    for (int m0 = 2 * c.gw; m0 < NB * SEQ; m0 += 2 * c.ngw) {
        f32x4 v[2][4];
#pragma unroll
        for (int rr = 0; rr < 2; ++rr)
#pragma unroll
            for (int j = 0; j < 4; ++j) v[rr][j] = *(const f32x4*)(p.out + (size_t)(m0 + rr) * DM + 4 * c.lane + 256 * j);
#pragma unroll
        for (int rr = 0; rr < 2; ++rr) { float* xr = p.out + (size_t)(m0 + rr) * DM; float ss = 0.f;
#pragma unroll
            for (int j = 0; j < 4; ++j) ss += v[rr][j].x * v[rr][j].x + v[rr][j].y * v[rr][j].y + v[rr][j].z * v[rr][j].z + v[rr][j].w * v[rr][j].w;
            const float rstd = rsqrtf(wave_sum(ss) * (1.f / DM) + EPS);
#pragma unroll
            for (int j = 0; j < 4; ++j) { const f32x4 gv = *(const f32x4*)(g + 4 * c.lane + 256 * j); *(f32x4*)(xr + 4 * c.lane + 256 * j) = v[rr][j] * rstd * gv; } }
    }
}

enum { K_PREP_A, K_PREP_B, K_IN, K_EVENMIX, K_S5COMB, K_GLU, K_OUT, K_XPREP, K_HEADNORM, K_ATTN, K_FINAL };
#ifdef DUP_PH
constexpr int NPH = 20, NPHT = 19;
#else
constexpr int NPH = 19, NPHT = 19;
#endif
__device__ __forceinline__ void phase_decode(int ph, int& kind, int& layer) {
    constexpr int kinds[NPHT] = {K_PREP_A, K_PREP_B,
        K_IN, K_EVENMIX, K_S5COMB, K_GLU, K_OUT,
        K_IN, K_ATTN, K_OUT,
        K_IN, K_EVENMIX, K_S5COMB, K_GLU, K_OUT,
        K_IN, K_ATTN, K_OUT, K_FINAL};
    constexpr int layers[NPHT] = {0, 0, 0, 0, 0, 0, 0, 1, 1, 1, 2, 2, 2, 2, 2, 3, 3, 3, 0};
#ifdef DUP_PH
    if (ph > DUP_PH) --ph;
#endif
    kind = kinds[ph]; layer = layers[ph];
}

template <int ONLY> __device__ __forceinline__ void mega_body(const P& p) {
    extern __shared__ __attribute__((aligned(16))) unsigned char lds[];
    const int wave_u = __builtin_amdgcn_readfirstlane((int)threadIdx.x >> 6);
    if (threadIdx.x == 0) { volatile LAS unsigned long long* tab = (volatile LAS unsigned long long*)((LAS unsigned char*)lds + TAB_OFF);
#pragma unroll
        for (int i = 0; i < 27; ++i) tab[i] = (unsigned long long)p.in[i];
        tab[27] = (unsigned long long)p.out; tab[28] = (unsigned long long)p.ws; }
    if (threadIdx.x < 2) ((volatile LAS unsigned*)((LAS unsigned char*)lds + TAB_OFF + 240))[threadIdx.x] = 0u;
    __syncthreads();
    XcdBarrier bar = xcd_barrier_post((unsigned*)(p.ws + WS_CTL), (volatile LAS unsigned*)((LAS unsigned char*)lds + TAB_OFF + 240));
    for (int ph = p.ph_lo; ph < p.ph_hi; ++ph) {
        int kind, l; phase_decode(ph, kind, l);
        if (ONLY >= 0 && kind != ONLY) continue;
        unsigned z_ = 0u; asm volatile("" : "+v"(z_));
        int tid_ = (wave_u << 6) | (int)__builtin_amdgcn_mbcnt_hi(~0u, __builtin_amdgcn_mbcnt_lo(~0u, z_));
        P q;
        { unsigned tbo = TAB_OFF; asm volatile("" : "+v"(tbo));
          const volatile LAS unsigned* tab = (const volatile LAS unsigned*)((LAS unsigned char*)lds + tbo);
#pragma unroll
          for (int i = 0; i < 27; ++i) { const unsigned lo = __builtin_amdgcn_readfirstlane(tab[2 * i]), hi = __builtin_amdgcn_readfirstlane(tab[2 * i + 1]); q.in[i] = (const float*)(const __attribute__((address_space(1))) float*)(((unsigned long long)hi << 32) | lo); }
          { const unsigned lo = __builtin_amdgcn_readfirstlane(tab[54]), hi = __builtin_amdgcn_readfirstlane(tab[55]); q.out = (float*)(__attribute__((address_space(1))) float*)(((unsigned long long)hi << 32) | lo); }
          { const unsigned lo = __builtin_amdgcn_readfirstlane(tab[56]), hi = __builtin_amdgcn_readfirstlane(tab[57]); q.ws = (unsigned char*)(__attribute__((address_space(1))) unsigned char*)(((unsigned long long)hi << 32) | lo); }
          q.ph_lo = p.ph_lo; q.ph_hi = p.ph_hi; }
        Ctx c; c.p = &q; c.tid = tid_; c.wid = wave_u; c.lane = c.tid & 63; c.gw = blockIdx.x * NWAVES + c.wid; c.ngw = gridDim.x * NWAVES; c.lds = lds;
        switch (kind) {
            case K_PREP_A: phase_prep_a(c); phase_s5prep(c); break;
            case K_PREP_B: phase_bias(c); phase_xprep(c, 0, q.in[0], q.in[2]); phase_transposes(c);
#if defined(DUPX) && DUPX == 4
                phase_bias(c);
#elif defined(DUPX) && DUPX == 5
                phase_xprep(c, 0, q.in[0], q.in[2]);
#elif defined(DUPX) && DUPX == 6
                phase_transposes(c);
#endif
                break;
            case K_IN: phase_in(c, l); break;
#ifdef USE_S5
#ifdef USE_GMLP
            case K_EVENMIX: phase_gmlp_fast(c, l);
#if defined(DUPX) && DUPX == 1
                phase_gmlp_fast(c, l);
#endif
                phase_s5_fast<false>(c, l);
#if defined(DUPX) && DUPX == 2
                phase_s5_fast<false>(c, l);
#endif
                break;
#else
            case K_EVENMIX: phase_gmlp(c, l); phase_s5_fast<false>(c, l); break;
#endif
            case K_S5COMB: phase_s5_fast<true>(c, l); break;
#else
#ifdef USE_GMLP
            case K_EVENMIX: phase_gmlp_fast(c, l); phase_s5_naive(c, l); break;
#else
            case K_EVENMIX: phase_gmlp(c, l); phase_s5_naive(c, l); break;
#endif
            case K_S5COMB: phase_s5comb(c, l); break;
#endif
            case K_GLU: phase_glu(c, l); break;
            case K_OUT: phase_out(c, l); break;
            case K_XPREP: phase_xprep(c, l, q.out, (const float*)(q.ws + WS_CTXRES)); break;
            case K_HEADNORM: phase_headnorm(c, l); break;
#ifdef USE_ATTN
            case K_ATTN: phase_attn(c, l); break;
#else
            case K_ATTN: phase_attn_naive(c, l); break;
#endif
            case K_FINAL: phase_final(c); break;
        }
        if (ph + 1 < p.ph_hi) xcd_barrier(bar);
    }
}

__global__ void __launch_bounds__(NTHREADS) k_mega(P p) { mega_body<-1>(p); }
#ifdef PERKIND
template <int KIND> __global__ void __launch_bounds__(NTHREADS) k_one(P p) { mega_body<KIND>(p); }
template __global__ void k_one<0>(P); template __global__ void k_one<1>(P); template __global__ void k_one<2>(P); template __global__ void k_one<3>(P); template __global__ void k_one<4>(P); template __global__ void k_one<5>(P);
template __global__ void k_one<6>(P); template __global__ void k_one<7>(P); template __global__ void k_one<8>(P); template __global__ void k_one<9>(P); template __global__ void k_one<10>(P);
#endif


extern "C" void kernel_launch(void* const* d_in, const int* in_sizes, int n_in, void* d_out, int out_size, void* d_ws, size_t ws_size, hipStream_t stream) {
    static int grid = 0;
    if (grid == 0) {
        if (n_in != 27 || out_size != NB * SEQ * DM || ws_size < WS_END) { fprintf(stderr, "kernel_launch: unexpected shapes n_in %d out %d ws %zu\n", n_in, out_size, ws_size); grid = -1; return; }
        int dev = 0, cus = 0, per_cu = 0;
        hipGetDevice(&dev); hipDeviceGetAttribute(&cus, hipDeviceAttributeMultiprocessorCount, dev);
        hipFuncSetAttribute((const void*)k_mega, hipFuncAttributeMaxDynamicSharedMemorySize, LDS_BYTES);
        hipOccupancyMaxActiveBlocksPerMultiprocessor(&per_cu, (const void*)k_mega, NTHREADS, LDS_BYTES);
        if (per_cu < 1) { fprintf(stderr, "kernel_launch: occupancy query says %d blocks per CU\n", per_cu); per_cu = 1; }
        grid = cus * 1;
        fprintf(stderr, "kernel_launch: cus %d per_cu %d grid %d\n", cus, per_cu, grid);
    }
    if (grid < 0) return;
    hipMemsetAsync((char*)d_ws + WS_CTL, 0, 16384, stream);
    P p{};
    for (int i = 0; i < 27; ++i) p.in[i] = (const float*)d_in[i];
    p.out = (float*)d_out; p.ws = (unsigned char*)d_ws;
#ifdef ONE_LAUNCH
    p.ph_lo = 0; p.ph_hi = NPH;
    void* args[] = {&p};
    hipError_t e = hipLaunchCooperativeKernel((void*)k_mega, dim3(grid), dim3(NTHREADS), args, LDS_BYTES, stream);
    if (e != hipSuccess) fprintf(stderr, "cooperative launch failed: %s\n", hipGetErrorString(e));
#else
    for (int ph = 0; ph < NPH; ++ph) {
        p.ph_lo = ph; p.ph_hi = ph + 1;
        hipLaunchKernelGGL(k_mega, dim3(grid), dim3(NTHREADS), LDS_BYTES, stream, p);
    }
#endif
}
```

```cpp
#include <hip/hip_runtime.h>
#include <hip/hip_cooperative_groups.h>
#include <cstdio>
#include <cstdint>
namespace cg = cooperative_groups;
#define ONE_LAUNCH 1
#define USE_PG8 1
#define USE_ATTN 1
#define USE_S5 1
#define USE_GMLP 1

constexpr int DM = 1024, NB = 4, SEQ = 4096, NCTX = 256, TPB = NCTX + SEQ, MTOK = NB * TPB;
constexpr int NPROJ = 2560, DEPTH = 4;
constexpr float EPS = 1e-6f;
constexpr int NTHREADS = 512, NWAVES = 8;
constexpr int TAB_OFF = 147456, LDS_BYTES = TAB_OFF + 512;

typedef unsigned short bf16_t;
typedef short bf16x8 __attribute__((ext_vector_type(8)));
typedef float f32x4 __attribute__((ext_vector_type(4)));
typedef unsigned u32x2 __attribute__((ext_vector_type(2)));
typedef unsigned u32x4 __attribute__((ext_vector_type(4)));

constexpr size_t MiB = 1u << 20;
constexpr size_t WS_CTL = 0;
constexpr size_t WS_MODS = 1 * MiB;
constexpr size_t WS_BIAS = 1 * MiB + 512 * 1024;
constexpr size_t WS_RSS = 2 * MiB;
constexpr size_t WS_ROPE = 3 * MiB + 512 * 1024;
constexpr size_t WS_CTXRES = 4 * MiB;
constexpr size_t WS_WIN = 8 * MiB;
constexpr size_t WS_WOUT = 28 * MiB;
constexpr size_t WS_WGLU = 36 * MiB;
constexpr size_t WS_XM = 38 * MiB;
constexpr size_t WS_PROJ = 72 * MiB;
constexpr size_t WS_MIX = 157 * MiB;
constexpr size_t WS_YG = 191 * MiB;
constexpr size_t WS_S5 = 208 * MiB;
constexpr size_t WS_VST = WS_S5 + 14 * MiB;
constexpr size_t WS_XB = 224 * MiB;
constexpr size_t WS_END = 256 * MiB;

struct P {
    const float* in[27];
    float* out;
    unsigned char* ws;
    int ph_lo, ph_hi;
};

__device__ __forceinline__ unsigned f2bf(float f) { unsigned u = __builtin_bit_cast(unsigned, f); return (u + 0x7fffu + ((u >> 16) & 1u)) >> 16; }
typedef float f32x2_t __attribute__((ext_vector_type(2))); typedef __bf16 bf16x2_t __attribute__((ext_vector_type(2)));
__device__ __forceinline__ unsigned pk2(float lo, float hi) { const f32x2_t v = {lo, hi}; const bf16x2_t b = __builtin_convertvector(v, bf16x2_t); return __builtin_bit_cast(unsigned, b); }
__device__ __forceinline__ float bf2f(unsigned short h) { return __builtin_bit_cast(float, (unsigned)h << 16); }
__device__ __forceinline__ float bflo(unsigned w) { return __builtin_bit_cast(float, w << 16); }
__device__ __forceinline__ float bfhi(unsigned w) { return __builtin_bit_cast(float, w & 0xffff0000u); }
__device__ __forceinline__ float wave_sum(float v) {
#pragma unroll
    for (int o = 1; o < 64; o <<= 1) v += __shfl_xor(v, o);
    return v;
}
__device__ __forceinline__ float silu_f(float x) { return x * __builtin_amdgcn_rcpf(1.f + __expf(-x)); }
__device__ __forceinline__ float sigmoid_f(float x) { return __builtin_amdgcn_rcpf(1.f + __expf(-x)); }
__device__ __forceinline__ float gelu_tanh_f(float x) {
    const float u2 = 1.5957691216057308f * (x + 0.044715f * x * x * x);
    return x * __builtin_amdgcn_rcpf(1.f + __expf(-u2));
}
__host__ __device__ __forceinline__ int hd_logical(int h) { return (h & 0x40) | ((h & 0x04) << 3) | ((h & 0x38) >> 1) | (h & 0x03); }
__device__ __forceinline__ int in_col_logical(int l, int n) { return ((l & 1) && n < 1280) ? ((n & ~127) | hd_logical(n & 127)) : n; }
__device__ __forceinline__ int cond_row(int m) { const int b = m / TPB, t = m - b * TPB; return t < NCTX ? 4 : b; }
__device__ __forceinline__ size_t res_off(int m, bool& is_ctx) { const int b = m / TPB, t = m - b * TPB; is_ctx = t < NCTX; return is_ctx ? (size_t)(b * NCTX + t) * DM : (size_t)(b * SEQ + t - NCTX) * DM; }

struct Ctx {
    const P* p; int tid, wid, lane, gw, ngw;
    unsigned char* lds;
};

namespace pg8 {
#define PG8_LAS __attribute__((address_space(3)))
typedef unsigned short bf16_t;
typedef short bf16x8 __attribute__((ext_vector_type(8)));
typedef float f32x4 __attribute__((ext_vector_type(4)));
typedef unsigned u32x4 __attribute__((ext_vector_type(4)));
constexpr int BM = 256, BK = 64, HALF = 128, HTB = HALF * BK * 2  , STAGE_BYTES = 8 * HTB, NXCD = 8, WGM = 8;

__host__ __device__ __forceinline__ int lds_byte(int r, int c) { const int st = (r >> 4) * 2 + (c >> 5), rr = r & 15, cc = c & 31, ob = rr * 64 + cc * 2; return st * 1024 + (ob ^ (((ob >> 9) & 1) << 5)); }
__host__ __device__ __forceinline__ void stage_rc(int b, int& R, int& C) { const int st = b / 1024, sb = b % 1024, swz = sb ^ (((sb >> 9) & 1) << 5); R = (st >> 1) * 16 + swz / 64; C = (st & 1) * 32 + (swz % 64) / 2; }
__host__ __device__ __forceinline__ int perm32(int rho) { const int n = rho >> 4, i = rho & 15; return 8 * (i >> 2) + 4 * n + (i & 3); }

struct Unit { int pm, pn; };
struct Gemm { const bf16_t* A; const bf16_t* Bt; int M, N, K; };

struct StaticOrder {
    int nM, nN, nwg, G, c;
    __host__ __device__ void init(int M, int N, int G_, int c_) { nM = M / BM; nN = N / BM; nwg = nM * nN; G = G_; c = c_; }
    __host__ __device__ bool next(int i, Unit& u) const {
        const long L = (long)i * G + c; if (L >= nwg) return false;
        int wgid = (int)L; { const int q = nwg / NXCD, r = nwg % NXCD, xcd = wgid % NXCD, off = wgid / NXCD; wgid = (xcd < r ? xcd * (q + 1) : r * (q + 1) + (xcd - r) * q) + off; }
        const int nig = WGM * nN, gid = wgid / nig, fm = gid * WGM, gsz = (nM - fm) < WGM ? (nM - fm) : WGM;
        u.pm = fm + ((wgid % nig) % gsz); u.pn = (wgid % nig) / gsz; return true;
    }
    __device__ __forceinline__ void a_ready(const Unit&) const {}
    __device__ __forceinline__ void done(const Unit&) const {}
};

__device__ __forceinline__ unsigned cvt_pk_bf16(float lo, float hi) { unsigned r; asm volatile("v_cvt_pk_bf16_f32 %0, %1, %2" : "=v"(r) : "v"(lo), "v"(hi)); return r; }
template <class Epi, class Sched, bool ALIGN_EPI = false, bool SP2 = false>
__device__ __forceinline__ void gemm_phase(PG8_LAS unsigned char* lds, const Gemm g, const Sched& S, const Epi& E, const int tid) {
    const int wid = __builtin_amdgcn_readfirstlane(tid >> 6), lane = tid & 63, wr = wid >> 2, wc = wid & 3, fr = lane & 15, fq = lane >> 4;
    const int K = g.K, nt = K / BK;
    unsigned voffA[2], voffB[2];
#pragma unroll
    for (int i = 0; i < 2; ++i) { int R, C; stage_rc(tid * 16 + i * 8192, R, C); const int Rb = Epi::PERM ? ((R & ~31) + perm32(R & 31)) : R;
        voffA[i] = (unsigned)(R * K + C) * 2u; voffB[i] = (unsigned)(Rb * K + C) * 2u; }
    const size_t kstep = (size_t)(BK * 2);
    const size_t hstep = (size_t)HALF * K * 2;
    const size_t tstep = 2 * hstep;
    const unsigned ldsw = (unsigned)wid * 1024u;
    const int aoff = lds_byte(wr * 64 + fr, fq * 8), boff = lds_byte(wc * 32 + fr, fq * 8);
#define PG8_SA(b, h) (((b) * 2 + (h)) * HTB)
#define PG8_SB(b, h) ((4 + (b) * 2 + (h)) * HTB)
#define PG8_STAGE(bufoff, gbase, voff) do { _Pragma("unroll") for (int _i = 0; _i < 2; ++_i) \
        __builtin_amdgcn_global_load_lds((const unsigned*)((const char*)(gbase) + (voff)[_i]), (PG8_LAS unsigned*)(lds + (bufoff) + ldsw + _i * 8192), 16, 0, 0); } while (0)
#define PG8_LDA(dst, b, h) do { _Pragma("unroll") for (int m = 0; m < 4; ++m) _Pragma("unroll") for (int k = 0; k < 2; ++k) dst[m][k] = *(const PG8_LAS bf16x8*)(lds + PG8_SA(b, h) + aoff + m * 2048 + k * 1024); } while (0)
#define PG8_LDB(dst, b, h) do { _Pragma("unroll") for (int n = 0; n < 2; ++n) _Pragma("unroll") for (int k = 0; k < 2; ++k) dst[n][k] = *(const PG8_LAS bf16x8*)(lds + PG8_SB(b, h) + boff + n * 2048 + k * 1024); } while (0)
#define PG8_MMA(ai, bj, At, Bt) do { __builtin_amdgcn_s_setprio(1); _Pragma("unroll") for (int m = 0; m < 4; ++m) _Pragma("unroll") for (int n = 0; n < 2; ++n) _Pragma("unroll") for (int k = 0; k < 2; ++k) \
        acc[ai][bj][m][n] = __builtin_amdgcn_mfma_f32_16x16x32_bf16(Bt[n][k], At[m][k], acc[ai][bj][m][n], 0, 0, 0); __builtin_amdgcn_s_setprio(0); } while (0)
#define PG8_WAIT_V(n) asm volatile("s_waitcnt vmcnt(" #n ")" ::: "memory")
#define PG8_WAIT_L(n) asm volatile("s_waitcnt lgkmcnt(" #n ")" ::: "memory")
#define PG8_BAR __builtin_amdgcn_s_barrier()
#define PG8_SCHED __builtin_amdgcn_sched_barrier(0)
    Unit cur, nxt; int ui = 0;
    if (!S.next(0, cur)) return;
    f32x4 acc[2][2][4][2];
#pragma unroll
    for (int a = 0; a < 2; ++a)
#pragma unroll
        for (int b = 0; b < 2; ++b)
#pragma unroll
            for (int m = 0; m < 4; ++m)
#pragma unroll
                for (int n = 0; n < 2; ++n) acc[a][b][m][n] = (f32x4){0.f, 0.f, 0.f, 0.f};
    bf16x8 At[4][2], B0[2][2], B1[2][2];
    const char* cA = (const char*)g.A + (size_t)cur.pm * tstep; const char* cB = (const char*)g.Bt + (size_t)cur.pn * tstep;
    S.a_ready(cur);
    if constexpr (SP2) {
        PG8_STAGE(PG8_SB(0, 0), cB, voffB); PG8_STAGE(PG8_SB(0, 1), cB + hstep, voffB); PG8_STAGE(PG8_SA(0, 0), cA, voffA); PG8_STAGE(PG8_SA(0, 1), cA + hstep, voffA);
        if (wr == 1) PG8_BAR;
        PG8_WAIT_V(2); PG8_BAR;
        PG8_STAGE(PG8_SB(1, 0), cB + kstep, voffB); PG8_STAGE(PG8_SA(1, 0), cA + kstep, voffA); PG8_STAGE(PG8_SB(1, 1), cB + hstep + kstep, voffB);
        PG8_WAIT_V(6); PG8_BAR;
    } else {
        PG8_STAGE(PG8_SB(0, 0), cB, voffB); PG8_STAGE(PG8_SA(0, 0), cA, voffA); PG8_STAGE(PG8_SB(0, 1), cB + hstep, voffB); PG8_STAGE(PG8_SA(0, 1), cA + hstep, voffA);
        if (wr == 1) PG8_BAR;
        PG8_WAIT_V(4); PG8_BAR;
        PG8_STAGE(PG8_SB(1, 0), cB + kstep, voffB); PG8_STAGE(PG8_SA(1, 0), cA + kstep, voffA); PG8_STAGE(PG8_SB(1, 1), cB + hstep + kstep, voffB);
        PG8_WAIT_V(6); PG8_BAR;
    }
    for (;;) {
        const bool has_next = S.next(ui + 1, nxt);
        const char* nA = has_next ? (const char*)g.A + (size_t)nxt.pm * tstep : cA; const char* nB = has_next ? (const char*)g.Bt + (size_t)nxt.pn * tstep : cB;
        for (int t = 0; t < nt; t += 2) {
            const bool last = (t == nt - 2);
            const char* a1 = cA + (size_t)(t + 1) * kstep;
            const char* a2 = last ? nA : cA + (size_t)(t + 2) * kstep; const char* b2 = last ? nB : cB + (size_t)(t + 2) * kstep;
            const char* a3 = a2 + kstep; const char* b3 = b2 + kstep;
            if (last && has_next) S.a_ready(nxt);
            if constexpr (SP2) {
            PG8_LDB(B0, 0, 0); PG8_LDB(B1, 0, 1); PG8_SCHED; PG8_LDA(At, 0, 0); PG8_STAGE(PG8_SA(1, 1), a1 + hstep, voffA);
            PG8_WAIT_V(8); PG8_WAIT_L(0); PG8_BAR; PG8_MMA(0, 0, At, B0); PG8_MMA(0, 1, At, B1); PG8_BAR; PG8_SCHED;
            PG8_LDA(At, 0, 1); PG8_STAGE(PG8_SB(0, 0), b2, voffB); PG8_STAGE(PG8_SB(0, 1), b2 + hstep, voffB); PG8_STAGE(PG8_SA(0, 0), a2, voffA);
            PG8_WAIT_V(8); PG8_WAIT_L(0); PG8_BAR; PG8_MMA(1, 0, At, B0); PG8_MMA(1, 1, At, B1); PG8_BAR; PG8_SCHED;
            PG8_LDB(B0, 1, 0); PG8_LDB(B1, 1, 1); PG8_SCHED; PG8_LDA(At, 1, 0); PG8_STAGE(PG8_SA(0, 1), a2 + hstep, voffA);
            PG8_WAIT_V(8); PG8_WAIT_L(0); PG8_BAR; PG8_MMA(0, 0, At, B0); PG8_MMA(0, 1, At, B1); PG8_BAR; PG8_SCHED;
            PG8_LDA(At, 1, 1); PG8_STAGE(PG8_SB(1, 0), b3, voffB); PG8_STAGE(PG8_SB(1, 1), b3 + hstep, voffB); PG8_STAGE(PG8_SA(1, 0), a3, voffA);
            PG8_WAIT_V(8); PG8_WAIT_L(0); PG8_BAR; PG8_MMA(1, 0, At, B0); PG8_MMA(1, 1, At, B1); PG8_BAR; PG8_SCHED;
            } else {
            PG8_LDB(B0, 0, 0); PG8_SCHED; PG8_LDA(At, 0, 0); PG8_STAGE(PG8_SA(1, 1), a1 + hstep, voffA);
            PG8_WAIT_L(8); PG8_BAR; PG8_WAIT_L(0); PG8_MMA(0, 0, At, B0); PG8_BAR; PG8_SCHED;
            PG8_LDB(B1, 0, 1); PG8_STAGE(PG8_SB(0, 0), b2, voffB);
            PG8_BAR; PG8_WAIT_L(0); PG8_MMA(0, 1, At, B1); PG8_BAR;
            PG8_LDA(At, 0, 1); PG8_STAGE(PG8_SA(0, 0), a2, voffA);
            PG8_BAR; PG8_WAIT_L(0); PG8_MMA(1, 0, At, B0); PG8_BAR; PG8_SCHED;
            PG8_STAGE(PG8_SB(0, 1), b2 + hstep, voffB);
            PG8_WAIT_V(6); PG8_BAR; PG8_MMA(1, 1, At, B1); PG8_BAR;
            PG8_LDB(B0, 1, 0); PG8_SCHED; PG8_LDA(At, 1, 0); PG8_STAGE(PG8_SA(0, 1), a2 + hstep, voffA);
            PG8_WAIT_L(8); PG8_BAR; PG8_WAIT_L(0); PG8_MMA(0, 0, At, B0); PG8_BAR; PG8_SCHED;
            PG8_LDB(B1, 1, 1); PG8_STAGE(PG8_SB(1, 0), b3, voffB);
            PG8_BAR; PG8_WAIT_L(0); PG8_MMA(0, 1, At, B1); PG8_BAR;
            PG8_LDA(At, 1, 1); PG8_STAGE(PG8_SA(1, 0), a3, voffA);
            PG8_BAR; PG8_WAIT_L(0); PG8_MMA(1, 0, At, B0); PG8_BAR; PG8_SCHED;
            PG8_STAGE(PG8_SB(1, 1), b3 + hstep, voffB);
            PG8_WAIT_V(6); PG8_BAR; PG8_MMA(1, 1, At, B1); PG8_BAR;
            }
        }
        if constexpr (ALIGN_EPI) { if (wr == 0) PG8_BAR; }
        if constexpr (!Epi::AFTER_DRAIN) { E(acc, cur, wr, wc, fr, fq); S.done(cur); }
        if (!has_next) break;
#pragma unroll
        for (int a = 0; a < 2; ++a)
#pragma unroll
            for (int b = 0; b < 2; ++b)
#pragma unroll
                for (int m = 0; m < 4; ++m)
#pragma unroll
                    for (int n = 0; n < 2; ++n) acc[a][b][m][n] = (f32x4){0.f, 0.f, 0.f, 0.f};
        cur = nxt; cA = nA; cB = nB; ++ui;
        if constexpr (ALIGN_EPI) { if (wr == 1) PG8_BAR; }
    }
    PG8_WAIT_V(0);
    if constexpr (!ALIGN_EPI) { if (wr == 0) PG8_BAR; }
    PG8_BAR;
    if constexpr (Epi::AFTER_DRAIN) { E.fused(acc, cur, wr, wc, fr, fq, lds, wid, lane); S.done(cur); }
#undef PG8_SA
#undef PG8_SB
#undef PG8_STAGE
#undef PG8_LDA
#undef PG8_LDB
#undef PG8_MMA
#undef PG8_WAIT_V
#undef PG8_WAIT_L
#undef PG8_BAR
#undef PG8_SCHED
}
}

namespace attn {
constexpr int   D = 128, NW = 8, QBLK = 32, KVBLK = 64;
constexpr float SCALE = 0.088388347648318440f;
#ifndef ATTN_THR
#define ATTN_THR 8.f
#endif
constexpr float THR = ATTN_THR;
constexpr int SDEPTH = 2;
constexpr int LDQ = 2560, LDK = 2560, LDO = 1024, LDG = 2560;
constexpr size_t SHM_V = KVBLK * D * 2, SHM_K = KVBLK * D * 2, SHM_ATTN = 2 * SHM_V + 2 * SHM_K + NW * 64 * 4;
using bf16 = unsigned short;
using bf16x8 = __attribute__((ext_vector_type(8))) short;
using s16x4  = __attribute__((ext_vector_type(4))) short;
using f32x16 = __attribute__((ext_vector_type(16))) float;
using f32x8  = __attribute__((ext_vector_type(8))) float;
using u32x4  = __attribute__((ext_vector_type(4))) unsigned;
#define KSWZ(row, colB) ((row) * 256 + ((colB) ^ (((row) & 7) << 4)))
#define SBAR() __builtin_amdgcn_sched_barrier(0)
__device__ __forceinline__ int crow(int r, int hi) { return (r & 3) + 8 * (r >> 2) + 4 * hi; }
__device__ __forceinline__ unsigned cvtpk(float lo, float hi) {
  unsigned r; asm volatile("v_cvt_pk_bf16_f32 %0, %1, %2" : "=v"(r) : "v"(lo), "v"(hi)); return r;
}
template <typename TIn> struct Stage;
template <> struct Stage<bf16>  { using T = bf16x8;
  __device__ static __forceinline__ T ld8(const bf16* p) { return *reinterpret_cast<const bf16x8*>(p); }
  __device__ static __forceinline__ bf16x8 tobf(T x) { return x; } };
template <> struct Stage<float> { using T = f32x8;
  __device__ static __forceinline__ T ld8(const float* p) { return *reinterpret_cast<const f32x8*>(p); }
  __device__ static __forceinline__ bf16x8 tobf(T x) {
    u32x4 w = {cvtpk(x[0], x[1]), cvtpk(x[2], x[3]), cvtpk(x[4], x[5]), cvtpk(x[6], x[7])}; return *reinterpret_cast<bf16x8*>(&w); } };

__device__ __forceinline__ void partialSM(f32x16& p0, f32x16& p1, float& m_reg, float& mn, float& alpha) {
  constexpr float C = SCALE * 1.4426950408889634f;
  float pmax = p0[0]; for (int r = 1; r < 16; ++r) pmax = fmaxf(pmax, p0[r]); for (int r = 0; r < 16; ++r) pmax = fmaxf(pmax, p1[r]);
  { auto rr = __builtin_amdgcn_permlane32_swap(__float_as_uint(pmax), __float_as_uint(pmax), false, false);
    pmax = fmaxf(__uint_as_float(rr[0]), __uint_as_float(rr[1])); }
  if (__builtin_expect(__all(pmax - m_reg <= THR / SCALE), 1)) { mn = m_reg; alpha = 1.f; }
  else { mn = fmaxf(m_reg, pmax); alpha = __builtin_amdgcn_exp2f((m_reg - mn) * C); m_reg = mn; }
  float mnC = -mn * C;
  for (int r = 0; r < 16; ++r) p0[r] = fmaf(p0[r], C, mnC); for (int r = 0; r < 16; ++r) p1[r] = fmaf(p1[r], C, mnC);
  for (int r = 0; r < 16; ++r) p0[r] = __builtin_amdgcn_exp2f(p0[r]);
}
__device__ __forceinline__ void finishSM(f32x16& p0, f32x16& p1, float alpha, float& l_reg, bf16x8& pa0, bf16x8& pa1, bf16x8& pa2, bf16x8& pa3) {
  for (int r = 0; r < 16; ++r) p1[r] = __builtin_amdgcn_exp2f(p1[r]);
  float ps = 0; for (int r = 0; r < 16; ++r) ps += p0[r]; for (int r = 0; r < 16; ++r) ps += p1[r];
  { auto rr = __builtin_amdgcn_permlane32_swap(__float_as_uint(ps), __float_as_uint(ps), false, false);
    ps = __uint_as_float(rr[0]) + __uint_as_float(rr[1]); }
  l_reg = l_reg * alpha + ps;
#define PK4(P, BASE, OUT) do { unsigned a0 = cvtpk(P[BASE + 0], P[BASE + 1]), a1 = cvtpk(P[BASE + 2], P[BASE + 3]);   \
    unsigned b0 = cvtpk(P[BASE + 4], P[BASE + 5]), b1 = cvtpk(P[BASE + 6], P[BASE + 7]);                              \
    auto r0 = __builtin_amdgcn_permlane32_swap(a0, b0, false, false); auto r1 = __builtin_amdgcn_permlane32_swap(a1, b1, false, false); \
    u32x4 w = {r0[0], r1[0], r0[1], r1[1]}; OUT = *reinterpret_cast<bf16x8*>(&w); } while (0)
  PK4(p0, 0, pa0); PK4(p0, 8, pa1); PK4(p1, 0, pa2); PK4(p1, 8, pa3);
#undef PK4
}
__device__ __forceinline__ void qkt(f32x16& p0, f32x16& p1, const bf16* Ks, const bf16x8* qr, int r32, int hi) {
  p0 = f32x16{}; p1 = f32x16{};
  for (int d0 = 0; d0 < 8; ++d0) { int cb = (d0 * 16 + hi * 8) * 2;
    bf16x8 b0 = *reinterpret_cast<const bf16x8*>((const char*)Ks + KSWZ(r32, cb));
    bf16x8 b1 = *reinterpret_cast<const bf16x8*>((const char*)Ks + KSWZ(32 + r32, cb));
    p0 = __builtin_amdgcn_mfma_f32_32x32x16_bf16(b0, qr[d0], p0, 0, 0, 0);
    p1 = __builtin_amdgcn_mfma_f32_32x32x16_bf16(b1, qr[d0], p1, 0, 0, 0); }
}
__device__ __forceinline__ int v_st(int k, int c) { const int kk = (k & ~0xC) | ((k & 4) << 1) | ((k & 8) >> 1); return ((kk >> 3) * 4 + (c >> 5)) * 512 + ((kk & 7) * 32 + (c & 31)) * 2; }
__device__ __forceinline__ int v_rd_base(int lane) { return ((lane & 3) << 3) | (((lane >> 2) & 3) << 6) | (((lane >> 4) & 1) << 5) | (((lane >> 5) & 1) << 8); }
constexpr int v_rd_off(int d0, int ks, int half) { return d0 * 512 + ks * 4096 + half * 2048; }
template <int OFF> __device__ __forceinline__ s16x4 tr_read(int vb) {
  s16x4 r; asm volatile("ds_read_b64_tr_b16 %0, %1 offset:%2" : "=&v"(r) : "v"(vb), "i"(OFF) : "memory"); return r;
}
template <int D0> __device__ __forceinline__ void pv_one(f32x16& od, int vb, bf16x8 pa0, bf16x8 pa1, bf16x8 pa2, bf16x8 pa3) {
  const s16x4 l0 = tr_read<v_rd_off(D0, 0, 0)>(vb), h0 = tr_read<v_rd_off(D0, 0, 1)>(vb), l1 = tr_read<v_rd_off(D0, 1, 0)>(vb), h1 = tr_read<v_rd_off(D0, 1, 1)>(vb);
  const s16x4 l2 = tr_read<v_rd_off(D0, 2, 0)>(vb), h2 = tr_read<v_rd_off(D0, 2, 1)>(vb), l3 = tr_read<v_rd_off(D0, 3, 0)>(vb), h3 = tr_read<v_rd_off(D0, 3, 1)>(vb);
  asm volatile("s_waitcnt lgkmcnt(0)" ::: "memory"); SBAR();
#define PK(L, H) (bf16x8){L[0], L[1], L[2], L[3], H[0], H[1], H[2], H[3]}
  od = __builtin_amdgcn_mfma_f32_32x32x16_bf16(pa0, PK(l0, h0), od, 0, 0, 0);
  od = __builtin_amdgcn_mfma_f32_32x32x16_bf16(pa1, PK(l1, h1), od, 0, 0, 0);
  od = __builtin_amdgcn_mfma_f32_32x32x16_bf16(pa2, PK(l2, h2), od, 0, 0, 0);
  od = __builtin_amdgcn_mfma_f32_32x32x16_bf16(pa3, PK(l3, h3), od, 0, 0, 0);
#undef PK
}
__device__ __forceinline__ void pv_d0(f32x16* o, int vb, bf16x8 pa0, bf16x8 pa1, bf16x8 pa2, bf16x8 pa3) {
  pv_one<0>(o[0], vb, pa0, pa1, pa2, pa3); pv_one<1>(o[1], vb, pa0, pa1, pa2, pa3); pv_one<2>(o[2], vb, pa0, pa1, pa2, pa3); pv_one<3>(o[3], vb, pa0, pa1, pa2, pa3);
}

template <typename TQ>
__device__ __forceinline__ void attn_dense_body(const TQ* __restrict__ Qb, const bf16* __restrict__ Kh, const bf16* __restrict__ Vh,
                                                bf16* __restrict__ Ob, const bf16* __restrict__ Gb, int seq, char* lds, const int tid) {
  using St = Stage<bf16>; using SQ = Stage<TQ>;
  const int wid = __builtin_amdgcn_readfirstlane(tid >> 6), lane = tid & 63, r32 = lane & 31, hi = lane >> 5;
  bf16* V_lds = (bf16*)lds; bf16* K_lds = (bf16*)(lds + 2 * SHM_V);
  float* ws = (float*)(lds + 2 * SHM_V + 2 * SHM_K) + wid * 64; float* li_l = ws; float* al_l = ws + 32;
  float m_reg = -1e30f, l_reg = 0; f32x16 o[4] = {}; bf16x8 qr[8];
  const TQ* Qw = Qb + (long)(wid * QBLK + r32) * LDQ + hi * 8;
#pragma unroll
  for (int d0 = 0; d0 < 8; ++d0) qr[d0] = SQ::tobf(SQ::ld8(Qw + d0 * 16));
  const int sr = tid >> 4, sc = (tid & 15) * 8, vst0 = v_st(sr, sc), vst1 = v_st(32 + sr, sc);
  const int vb0 = (int)(uintptr_t)V_lds + v_rd_base(lane);
  struct { typename St::T vs0, vs1, ks0, ks1; } sr_[SDEPTH];
  const unsigned lo0 = (unsigned)(sr * LDK + sc), lo1 = (unsigned)((32 + sr) * LDK + sc);
#define SLOAD(i, k0) do { const bf16* vt_ = Vh + (long)(k0) * LDK; const bf16* kt_ = Kh + (long)(k0) * LDK; sr_[i].vs0 = St::ld8(vt_ + lo0); sr_[i].vs1 = St::ld8(vt_ + lo1); \
    sr_[i].ks0 = St::ld8(kt_ + lo0); sr_[i].ks1 = St::ld8(kt_ + lo1); } while (0)
#define SWRITE(b, i) do { *(bf16x8*)((char*)V_lds + (b) * SHM_V + vst0) = St::tobf(sr_[i].vs0);          \
    *(bf16x8*)((char*)V_lds + (b) * SHM_V + vst1) = St::tobf(sr_[i].vs1); int kc = sc * 2;               \
    *(bf16x8*)((char*)K_lds + (b) * SHM_K + KSWZ(sr, kc)) = St::tobf(sr_[i].ks0);                       \
    *(bf16x8*)((char*)K_lds + (b) * SHM_K + KSWZ(32 + sr, kc)) = St::tobf(sr_[i].ks1); } while (0)
#define SWAIT() do { if constexpr (SDEPTH == 2) asm volatile("s_waitcnt vmcnt(4)" ::: "memory"); else asm volatile("s_waitcnt vmcnt(0)" ::: "memory"); } while (0)
#define RESC(a) do { if (__any((a) < 1.f)) { if (hi == 0) al_l[r32] = (a); asm volatile("s_waitcnt lgkmcnt(0)" ::: "memory"); \
    for (int d = 0; d < 4; ++d) for (int r = 0; r < 16; ++r) o[d][r] *= al_l[crow(r, hi)]; } } while (0)
  f32x16 pA0, pA1, pB0, pB1; float mnA, mnB, alA, alB; bf16x8 pa0, pa1, pa2, pa3; const int NT = seq / KVBLK;
  constexpr int SE = 0, SO = SDEPTH - 1;
  SLOAD(SE, 0); asm volatile("s_waitcnt vmcnt(0)" ::: "memory"); SWRITE(0, SE); __syncthreads();
  qkt(pA0, pA1, K_lds, qr, r32, hi); partialSM(pA0, pA1, m_reg, mnA, alA);
  SLOAD(SO, KVBLK); if constexpr (SDEPTH == 2) { if (2 < NT) SLOAD(SE, 2 * KVBLK); }
  SWAIT(); SWRITE(1, SO); __syncthreads();
  for (int j = 1; j + 1 < NT; j += 2) {
    SBAR(); qkt(pB0, pB1, (bf16*)((char*)K_lds + SHM_K), qr, r32, hi);
    finishSM(pA0, pA1, alA, l_reg, pa0, pa1, pa2, pa3); SBAR();
    SLOAD(SO, (j + SDEPTH) * KVBLK); SBAR();
    pv_d0(o, vb0, pa0, pa1, pa2, pa3); partialSM(pB0, pB1, m_reg, mnB, alB);
    __syncthreads(); SWAIT(); SWRITE(0, SE);
    RESC(alB); __syncthreads();
    SBAR(); qkt(pA0, pA1, K_lds, qr, r32, hi);
    finishSM(pB0, pB1, alB, l_reg, pa0, pa1, pa2, pa3); SBAR();
    if (SDEPTH == 1 || j + 3 < NT) SLOAD(SE, (j + 1 + SDEPTH) * KVBLK); SBAR();
    pv_d0(o, vb0 + (int)SHM_V, pa0, pa1, pa2, pa3); partialSM(pA0, pA1, m_reg, mnA, alA);
    __syncthreads(); SWAIT(); SWRITE(1, SO);
    RESC(alA); __syncthreads();
  }
  SBAR(); qkt(pB0, pB1, (bf16*)((char*)K_lds + SHM_K), qr, r32, hi);
  finishSM(pA0, pA1, alA, l_reg, pa0, pa1, pa2, pa3); SBAR();
  pv_d0(o, vb0, pa0, pa1, pa2, pa3); partialSM(pB0, pB1, m_reg, mnB, alB);
  __syncthreads(); RESC(alB);
  finishSM(pB0, pB1, alB, l_reg, pa0, pa1, pa2, pa3); SBAR();
  pv_d0(o, vb0 + (int)SHM_V, pa0, pa1, pa2, pa3);
  if (hi == 0) li_l[r32] = l_reg; asm volatile("s_waitcnt lgkmcnt(0)" ::: "memory");
  float rli[16];
#pragma unroll
  for (int r = 0; r < 16; ++r) rli[r] = __builtin_amdgcn_rcpf(li_l[crow(r, hi)]);
  __syncthreads();
  { char* ost = lds + wid * 8704;
    int ob = hi * (4 * 272) + r32 * 2; asm volatile("" : "+v"(ob));
    char* osl = ost + ob;
#pragma unroll
    for (int r = 0; r < 16; ++r) { const int orow0 = (r & 3) + 8 * (r >> 2);
#pragma unroll
      for (int d0 = 0; d0 < 4; ++d0) *(bf16*)(osl + orow0 * 272 + d0 * 64) = (bf16)(cvtpk(o[d0][r] * rli[r], 0.f) & 0xffffu); }
    asm volatile("s_waitcnt lgkmcnt(0)" ::: "memory");
    bf16* Ow = Ob + (long)(wid * QBLK) * LDO; const bf16* Gw = Gb + (long)(wid * QBLK) * LDG;
    int ln = lane; asm volatile("" : "+v"(ln));
#pragma unroll 2
    for (int i = 0; i < 8; ++i) { const int id = i * 64 + ln, row = id >> 4, ch = id & 15;
      const u32x4 ov = *(const u32x4*)(ost + row * 272 + ch * 16); const u32x4 gv = *(const u32x4*)(Gw + (long)row * LDG + ch * 8);
      u32x4 w;
#define GMUL(O, G) cvtpk(__builtin_bit_cast(float, (O) << 16) * __builtin_bit_cast(float, (G) << 16), __builtin_bit_cast(float, (O) & 0xffff0000u) * __builtin_bit_cast(float, (G) & 0xffff0000u))
      w.x = GMUL(ov.x, gv.x); w.y = GMUL(ov.y, gv.y); w.z = GMUL(ov.z, gv.z); w.w = GMUL(ov.w, gv.w);
#undef GMUL
      *(u32x4*)(Ow + (long)row * LDO + ch * 8) = w; }
    asm volatile("s_waitcnt lgkmcnt(0)" ::: "memory");
  }
#undef SLOAD
#undef SWRITE
#undef SWAIT
#undef RESC
}

#undef KSWZ
#undef SBAR
}

#define LAS __attribute__((address_space(3)))
#define XB_TMO      128
#define XB_XCNT(j)  (256  + 64 * (j))
#define XB_XSUB(j)  (1280 + 64 * (j))
#define XB_XGEN(j)  (2304 + 64 * (j))
#define XB_TOP      3328
#define XB_TOPGEN   3392
#define XCD_BAR_WORDS 3456
#define XB_SPIN_CAP (1u << 18)

__device__ __forceinline__ unsigned xb_ld(unsigned* p)              { return __hip_atomic_load(p, __ATOMIC_RELAXED, __HIP_MEMORY_SCOPE_AGENT); }
__device__ __forceinline__ unsigned xb_add(unsigned* p, unsigned v) { return __hip_atomic_fetch_add(p, v, __ATOMIC_RELAXED, __HIP_MEMORY_SCOPE_AGENT); }
__device__ __forceinline__ unsigned xb_xcc_id() { return (unsigned)__builtin_amdgcn_s_getreg((3 << 11) | 20) & 0xFu; }
#define XB_SPIN(cond, bar) do { unsigned _sp = 0; while (cond) { __builtin_amdgcn_s_sleep(1); \
    if ((++_sp & 255u) == 0u) { if (xb_ld(&(bar)[XB_TMO])) break; if (_sp > XB_SPIN_CAP) { atomicAdd(&(bar)[XB_TMO], 1u); break; } } } } while (0)

struct XcdBarrier {
    unsigned* bar; unsigned x;
    volatile LAS unsigned* st;
};

__device__ __forceinline__ XcdBarrier xcd_barrier_post(unsigned* bar, volatile LAS unsigned* st) {
    XcdBarrier b; b.bar = bar; b.x = xb_xcc_id(); b.st = st;
    if (threadIdx.x == 0) (void)xb_add(&bar[XB_XCNT(b.x)], 1u);
    return b;
}
__device__ __forceinline__ void xcd_barrier_complete(unsigned* bar, unsigned x, unsigned& nloc, unsigned& nx) {
    const unsigned G = gridDim.x * gridDim.y * gridDim.z;
    unsigned sum, cnt, mine, sp = 0u;
    for (;;) {
        sum = 0u; cnt = 0u; mine = 0u;
#pragma unroll
        for (unsigned j = 0; j < 16; ++j) { const unsigned c = xb_ld(&bar[XB_XCNT(j)]); sum += c; cnt += (c > 0u) ? 1u : 0u; mine = (j == x) ? c : mine; }
        if (sum == G) break;
        __builtin_amdgcn_s_sleep(1);
        if ((++sp & 255u) == 0u) { if (xb_ld(&bar[XB_TMO])) break; if (sp > XB_SPIN_CAP) { atomicAdd(&bar[XB_TMO], 1u); break; } }
    }
    nloc = mine > 0u ? mine : 1u; nx = cnt > 0u ? cnt : 1u;
}

__device__ __forceinline__ void xcd_barrier(const XcdBarrier& b) {
    asm volatile("s_waitcnt vmcnt(0)" ::: "memory");
    __syncthreads();
    if (threadIdx.x == 0) {
        unsigned* bar = b.bar;
        __builtin_amdgcn_s_waitcnt(0);
        unsigned nloc = b.st[0], nx = b.st[1];
        if (nloc == 0u) { xcd_barrier_complete(bar, b.x, nloc, nx); b.st[0] = nloc; b.st[1] = nx; }
        const unsigned old = xb_add(&bar[XB_XSUB(b.x)], 1u);
        const unsigned gen = old / nloc;
        if (old + 1u == (gen + 1u) * nloc) {
            __builtin_amdgcn_fence(__ATOMIC_RELEASE, "agent");
            asm volatile("s_waitcnt vmcnt(0)" ::: "memory");
            const unsigned og = xb_add(&bar[XB_TOP], 1u);
            const unsigned tg = og / nx;
            if (og + 1u == (tg + 1u) * nx) xb_add(&bar[XB_TOPGEN], 1u);
            else XB_SPIN(xb_ld(&bar[XB_TOPGEN]) == tg, bar);
            __builtin_amdgcn_fence(__ATOMIC_ACQUIRE, "agent");
            xb_add(&bar[XB_XGEN(b.x)], 1u);
            asm volatile("s_waitcnt vmcnt(0)" ::: "memory");
        } else {
            XB_SPIN(xb_ld(&bar[XB_XGEN(b.x)]) == gen, bar);
            __builtin_amdgcn_fence(__ATOMIC_ACQUIRE, "agent");
            asm volatile("s_waitcnt vmcnt(0)" ::: "memory");
        }
    }
    __syncthreads();
}

__device__ __forceinline__ void transpose_item(const float* W, int K, int N, bf16_t* WT, int item, float* scr, int tid, int permute_below = 0) {
    const int nblk = N / 64, kb = item / nblk, nb = item % nblk, k0 = kb * 64, n0 = nb * 64;
    __syncthreads();
#pragma unroll
    for (int i = 0; i < 8; ++i) { const int kk = (tid >> 6) + 8 * i, nn = tid & 63; scr[kk * 65 + nn] = W[(size_t)(k0 + kk) * N + n0 + nn]; }
    __syncthreads();
    const int n = tid >> 3, c = tid & 7;
    const int ns = (n0 + n < permute_below) ? (hd_logical((n0 + n) & 127) & 63) : n;
    u32x4 o; const float* s = scr + (8 * c) * 65 + ns;
    o.x = pk2(s[0], s[65]); o.y = pk2(s[2 * 65], s[3 * 65]); o.z = pk2(s[4 * 65], s[5 * 65]); o.w = pk2(s[6 * 65], s[7 * 65]);
    *(u32x4*)(WT + (size_t)(n0 + n) * K + k0 + 8 * c) = o;
}
__device__ __forceinline__ void phase_prep_a(const Ctx& c) {
    const P& p = *c.p;
    float* mods = (float*)(p.ws + WS_MODS);
    {
        float* sl = (float*)(c.lds + 32768);
        float* red = (float*)(c.lds + 32768 + 20480);
        for (int e = c.tid; e < 5 * DM; e += NTHREADS) { const int r = e >> 10, k = e & 1023; sl[e] = silu_f(r < 4 ? p.in[1][r * DM + k] : p.in[3][k]); }
        __syncthreads();
        for (int it = blockIdx.x; it < DEPTH * 48; it += gridDim.x) {
            const int l = it / 48, j = (it % 48) * 64 + c.lane;
            const float* w = p.in[5] + (size_t)l * DM * 3072 + (size_t)(c.wid * 128) * 3072 + j;
            float a0 = 0.f, a1 = 0.f, a2 = 0.f, a3 = 0.f, a4 = 0.f;
#pragma unroll 16
            for (int k = 0; k < 128; ++k) { const float wv = w[(size_t)k * 3072]; const int kk = c.wid * 128 + k;
                a0 += sl[kk] * wv; a1 += sl[DM + kk] * wv; a2 += sl[2 * DM + kk] * wv; a3 += sl[3 * DM + kk] * wv; a4 += sl[4 * DM + kk] * wv; }
            float* rw = red + c.wid * 320 + c.lane; rw[0] = a0; rw[64] = a1; rw[128] = a2; rw[192] = a3; rw[256] = a4;
            __syncthreads();
            if (c.tid < 320) { float sum = 0.f;
#pragma unroll
                for (int w8 = 0; w8 < 8; ++w8) sum += red[w8 * 320 + c.tid];
                const int r = c.tid >> 6, jj = (it % 48) * 64 + (c.tid & 63);
                mods[((size_t)l * 5 + r) * 3072 + jj] = sum + p.in[6][l * 3072 + jj]; }
            __syncthreads();
        }
    }
    if (blockIdx.x == gridDim.x - 1) {
        float* rope = (float*)(p.ws + WS_ROPE);
        for (int e = c.tid; e < 64 * 32; e += NTHREADS) { const int pos = e >> 5, pr = e & 31;
            const float freq = powf(10000.f, -(float)pr / 32.f); const float ang = (float)pos * freq; rope[2 * e] = cosf(ang); rope[2 * e + 1] = sinf(ang); }
    }
}

__device__ __forceinline__ void phase_transposes(const Ctx& c) {
    const P& p = *c.p;
    float* scr = (float*)c.lds;
    constexpr int I_IN = 16 * 40, I_OUT = 16 * 16, I_GLU = 8 * 8;
    constexpr int NIT = 4 * I_IN + 4 * I_OUT + 2 * I_GLU;
    for (int it = blockIdx.x; it < NIT; it += gridDim.x) {
        int r = it;
        if (r < 4 * I_IN) { const int l = r / I_IN; const float* W = (l & 1) ? p.in[22] + (size_t)(l >> 1) * DM * NPROJ : p.in[7] + (size_t)(l >> 1) * DM * NPROJ;
            transpose_item(W, DM, NPROJ, (bf16_t*)(p.ws + WS_WIN) + (size_t)l * NPROJ * DM, r % I_IN, scr, c.tid, (l & 1) ? 1280 : 0); continue; }
        r -= 4 * I_IN;
        if (r < 4 * I_OUT) { const int l = r / I_OUT; const float* W = (l & 1) ? p.in[23] + (size_t)(l >> 1) * DM * DM : p.in[8] + (size_t)(l >> 1) * DM * DM;
            transpose_item(W, DM, DM, (bf16_t*)(p.ws + WS_WOUT) + (size_t)l * DM * DM, r % I_OUT, scr, c.tid); continue; }
        r -= 4 * I_OUT;
        { const int i = r / I_GLU; transpose_item(p.in[20] + (size_t)i * 512 * 512, 512, 512, (bf16_t*)(p.ws + WS_WGLU) + (size_t)i * 512 * 512, r % I_GLU, scr, c.tid); }
    }
    __syncthreads();
}
__device__ __forceinline__ void phase_bias(const Ctx& c) {
    const P& p = *c.p;
    const float* mods = (const float*)(p.ws + WS_MODS); float* bias = (float*)(p.ws + WS_BIAS);
    float* sl = (float*)(c.lds + 32768);
    float* red = (float*)(c.lds + 32768 + 20480);
    for (int it = blockIdx.x; it < DEPTH * 40; it += gridDim.x) {
        const int l = it / 40, n = (it % 40) * 64 + c.lane;
        __syncthreads();
        for (int e = c.tid; e < 5 * DM; e += NTHREADS) { const int r = e >> 10, k = e & 1023; sl[e] = mods[((size_t)l * 5 + r) * 3072 + k]; }
        __syncthreads();
        const float* W = ((l & 1) ? p.in[22] + (size_t)(l >> 1) * DM * NPROJ : p.in[7] + (size_t)(l >> 1) * DM * NPROJ) + (size_t)(c.wid * 128) * NPROJ + in_col_logical(l, n);
        float a0 = 0.f, a1 = 0.f, a2 = 0.f, a3 = 0.f, a4 = 0.f;
#pragma unroll 16
        for (int k = 0; k < 128; ++k) { const float wv = W[(size_t)k * NPROJ]; const int kk = c.wid * 128 + k;
            a0 += sl[kk] * wv; a1 += sl[DM + kk] * wv; a2 += sl[2 * DM + kk] * wv; a3 += sl[3 * DM + kk] * wv; a4 += sl[4 * DM + kk] * wv; }
        float* rw = red + c.wid * 320 + c.lane; rw[0] = a0; rw[64] = a1; rw[128] = a2; rw[192] = a3; rw[256] = a4;
        __syncthreads();
        if (c.tid < 320) { float sum = 0.f;
#pragma unroll
            for (int w8 = 0; w8 < 8; ++w8) sum += red[w8 * 320 + c.tid];
            const int r = c.tid >> 6, nn = (it % 40) * 64 + (c.tid & 63);
            bias[((size_t)l * 5 + r) * NPROJ + nn] = sum; }
    }
    __syncthreads();
}
__device__ __forceinline__ void phase_xprep(const Ctx& c, int l, const float* xbuf, const float* ctxbuf) {
    const P& p = *c.p;
    const float* mods = (const float*)(p.ws + WS_MODS) + (size_t)l * 5 * 3072;
    const float* g = p.in[4] + l * DM;
    bf16_t* xm = (bf16_t*)(p.ws + WS_XM); float* rss = (float*)(p.ws + WS_RSS);
    for (int m0 = 2 * c.gw; m0 < MTOK; m0 += 2 * c.ngw) {
        f32x4 v[2][4]; const float* scp[2];
#pragma unroll
        for (int rr = 0; rr < 2; ++rr) { const int m = m0 + rr; bool ic; const size_t off = res_off(m, ic); const float* src = (ic ? ctxbuf : xbuf) + off; scp[rr] = mods + cond_row(m) * 3072 + 1024;
#pragma unroll
            for (int j = 0; j < 4; ++j) v[rr][j] = *(const f32x4*)(src + 4 * c.lane + 256 * j); }
#pragma unroll
        for (int rr = 0; rr < 2; ++rr) { const int m = m0 + rr; float ss = 0.f;
#pragma unroll
            for (int j = 0; j < 4; ++j) { const int k = 4 * c.lane + 256 * j; const f32x4 x = v[rr][j]; const f32x4 gv = *(const f32x4*)(g + k), sv = *(const f32x4*)(scp[rr] + k);
                ss += x.x * x.x + x.y * x.y + x.z * x.z + x.w * x.w;
                u32x2 o; o.x = pk2(x.x * gv.x * (1.f + sv.x), x.y * gv.y * (1.f + sv.y)); o.y = pk2(x.z * gv.z * (1.f + sv.z), x.w * gv.w * (1.f + sv.w));
                *(u32x2*)(xm + (size_t)m * DM + k) = o; }
            ss = wave_sum(ss);
            if (c.lane < 16) rss[(size_t)m * 16 + c.lane] = c.lane == 0 ? ss : 0.f; }
    }
}

template <class Epi>
__device__ __forceinline__ void gemm_simple(const Ctx& c, const bf16_t* A, int lda, const bf16_t* Bt, int ldb, int M, int N, int K, const Epi& epi) {
    const int fr = c.lane & 15, fq = c.lane >> 4, wr = c.wid >> 1, wc = c.wid & 1;
    const int tn = N / 128, nt = (M / 128) * tn;
    for (int t = blockIdx.x; t < nt; t += gridDim.x) {
        const int pm = t / tn, pn = t % tn;
        f32x4 acc[2][4];
#pragma unroll
        for (int i = 0; i < 2; ++i)
#pragma unroll
            for (int j = 0; j < 4; ++j) acc[i][j] = (f32x4){0.f, 0.f, 0.f, 0.f};
        const bf16_t* a0 = A + (size_t)(pm * 128 + wr * 32 + fr) * lda + fq * 8;
        const bf16_t* b0 = Bt + (size_t)(pn * 128 + wc * 64 + fr) * ldb + fq * 8;
        for (int k = 0; k < K; k += 32) {
            bf16x8 af[2], bfr[4];
#pragma unroll
            for (int i = 0; i < 2; ++i) af[i] = *(const bf16x8*)(a0 + (size_t)i * 16 * lda + k);
#pragma unroll
            for (int j = 0; j < 4; ++j) bfr[j] = *(const bf16x8*)(b0 + (size_t)j * 16 * ldb + k);
#pragma unroll
            for (int i = 0; i < 2; ++i)
#pragma unroll
                for (int j = 0; j < 4; ++j) acc[i][j] = __builtin_amdgcn_mfma_f32_16x16x32_bf16(bfr[j], af[i], acc[i][j], 0, 0, 0);
        }
#pragma unroll
        for (int i = 0; i < 2; ++i)
#pragma unroll
            for (int j = 0; j < 4; ++j) epi(pm * 128 + wr * 32 + i * 16 + fr, pn * 128 + wc * 64 + j * 16 + 4 * fq, acc[i][j]);
    }
}

struct EpiIn {
    const float* rss; const float* bias; bf16_t* proj; int odd;
    __device__ __forceinline__ void operator()(int row, int col, f32x4 v) const {
        const f32x4* rp = (const f32x4*)(rss + (size_t)row * 16);
        const f32x4 s0 = rp[0], s1 = rp[1], s2 = rp[2], s3 = rp[3];
        const float ss = ((s0.x + s0.y) + (s0.z + s0.w)) + ((s1.x + s1.y) + (s1.z + s1.w)) + ((s2.x + s2.y) + (s2.z + s2.w)) + ((s3.x + s3.y) + (s3.z + s3.w));
        const float rstd = rsqrtf(ss * (1.f / DM) + EPS);
        const f32x4 bv = *(const f32x4*)(bias + (size_t)cond_row(row) * NPROJ + col);
        v = v * rstd + bv;
        const bool act = odd ? (col >= 1536) : ((col >= 1024 && col < 1536) || col >= 2048);
        if (act) { v.x = silu_f(v.x); v.y = silu_f(v.y); v.z = silu_f(v.z); v.w = silu_f(v.w); }
        u32x2 o; o.x = pk2(v.x, v.y); o.y = pk2(v.z, v.w);
        *(u32x2*)(proj + (size_t)row * NPROJ + col) = o;
    }
};
struct EpiOut {
    const float* xold; const float* cold; float* xnew; float* cnew; const float* mods; int skip_ctx;
    __device__ __forceinline__ void operator()(int row, int col, f32x4 v) const {
        bool ic; const size_t off = res_off(row, ic) + col;
        if (ic && skip_ctx) return;
        const f32x4 gt = *(const f32x4*)(mods + (size_t)cond_row(row) * 3072 + 2048 + col);
        const f32x4 o = *(const f32x4*)((ic ? cold : xold) + off);
        *(f32x4*)((ic ? cnew : xnew) + off) = o + gt * v;
    }
};
struct EpiGlu {
    const bf16_t* yg; const bf16_t* proj; const float* bglu; bf16_t* mix;
    __device__ __forceinline__ void operator()(int row, int col, f32x4 v) const {
        const f32x4 b = *(const f32x4*)(bglu + col);
        const u32x2 yw = *(const u32x2*)(yg + (size_t)row * 512 + col), gw = *(const u32x2*)(proj + (size_t)row * NPROJ + 2048 + col);
        const float o0 = bflo(yw.x) * sigmoid_f(v.x + b.x) * bflo(gw.x), o1 = bfhi(yw.x) * sigmoid_f(v.y + b.y) * bfhi(gw.x);
        const float o2 = bflo(yw.y) * sigmoid_f(v.z + b.z) * bflo(gw.y), o3 = bfhi(yw.y) * sigmoid_f(v.w + b.w) * bfhi(gw.y);
        u32x2 o; o.x = pk2(o0, o1); o.y = pk2(o2, o3);
        *(u32x2*)(mix + (size_t)row * DM + 512 + col) = o;
    }
};


template <class E> struct EpiTile {
    static constexpr bool PERM = false, AFTER_DRAIN = false; E e;
    __device__ __forceinline__ void operator()(const pg8::f32x4 (&acc)[2][2][4][2], const pg8::Unit& u, int wr, int wc, int fr, int fq) const {
#pragma unroll
        for (int ai = 0; ai < 2; ++ai)
#pragma unroll
            for (int m = 0; m < 4; ++m) { const int row = u.pm * 256 + ai * 128 + wr * 64 + m * 16 + fr;
#pragma unroll
                for (int bj = 0; bj < 2; ++bj)
#pragma unroll
                    for (int n = 0; n < 2; ++n) e(row, u.pn * 256 + bj * 128 + wc * 32 + n * 16 + 4 * fq, acc[ai][bj][m][n]); }
    }
};
template <class E> __device__ __forceinline__ void gemm_fast(const Ctx& c, const bf16_t* A, const bf16_t* Bt, int M, int N, int K, const E& e) {
    pg8::Gemm g{A, Bt, M, N, K}; pg8::StaticOrder S; S.init(M, N, (int)gridDim.x, (int)blockIdx.x);
    EpiTile<E> E2{e};
    pg8::gemm_phase<EpiTile<E>, pg8::StaticOrder, true, true>((PG8_LAS unsigned char*)c.lds, g, S, E2, c.tid);
    __syncthreads();
}


struct EpiInTile {
    static constexpr bool PERM = true, AFTER_DRAIN = false;
    const float* rss; const float* bias; bf16_t* proj; int odd; const float* qg; const float* kg; const float* rope; float* red; float* vst;
    __device__ __forceinline__ void operator()(const pg8::f32x4 (&acc)[2][2][4][2], const pg8::Unit& u, int wr, int wc, int fr, int fq) const {
        asm volatile("" : "+v"(fr), "+v"(fq));
        const int pmb = u.pm / 17, jt = u.pm - pmb * 17, r = jt == 0 ? 4 : pmb;
        const int colb = u.pn * 256 + wc * 32 + 8 * fq;
        f32x4 bv[2][2];
#pragma unroll
        for (int bj = 0; bj < 2; ++bj)
#pragma unroll
            for (int n = 0; n < 2; ++n) bv[bj][n] = *(const f32x4*)(bias + (size_t)r * NPROJ + colb + bj * 128 + n * 4);
        float rstd[2][4];
        {
            int tl = (wr * 4 + wc) * 64 + fq * 16 + fr; asm volatile("" : "+v"(tl));
            if (tl < 256) { const f32x4* rp = (const f32x4*)(rss + ((size_t)u.pm * 256 + tl) * 16);
                const f32x4 s0 = rp[0], s1 = rp[1], s2 = rp[2], s3 = rp[3];
                const float ss = ((s0.x + s0.y) + (s0.z + s0.w)) + ((s1.x + s1.y) + (s1.z + s1.w)) + ((s2.x + s2.y) + (s2.z + s2.w)) + ((s3.x + s3.y) + (s3.z + s3.w));
                red[2048 + tl] = rsqrtf(ss * (1.f / DM) + EPS); }
            asm volatile("s_waitcnt lgkmcnt(0)" ::: "memory"); __builtin_amdgcn_s_barrier(); asm volatile("" ::: "memory");
#pragma unroll
            for (int ai = 0; ai < 2; ++ai)
#pragma unroll
                for (int m = 0; m < 4; ++m) rstd[ai][m] = red[2048 + ai * 128 + wr * 64 + m * 16 + fr];
        }
        const bool qk = odd && u.pn <= 4;
        if (qk) {
#pragma unroll
            for (int ai = 0; ai < 2; ++ai)
#pragma unroll
                for (int m = 0; m < 4; ++m)
#pragma unroll
                    for (int bj = 0; bj < 2; ++bj) { const f32x4 v0 = acc[ai][bj][m][0] * rstd[ai][m] + bv[bj][0], v1 = acc[ai][bj][m][1] * rstd[ai][m] + bv[bj][1];
                        float s_ = ((v0.x * v0.x + v0.y * v0.y) + (v0.z * v0.z + v0.w * v0.w)) + ((v1.x * v1.x + v1.y * v1.y) + (v1.z * v1.z + v1.w * v1.w));
                        s_ += __shfl_xor(s_, 16); s_ += __shfl_xor(s_, 32);
                        if (fq == 0) red[((ai * 128 + wr * 64 + m * 16 + fr) * 2 + bj) * 4 + wc] = s_; }
            asm volatile("s_waitcnt lgkmcnt(0)" ::: "memory"); __builtin_amdgcn_s_barrier(); asm volatile("" ::: "memory");
        }
        const bool vt = !odd && (u.pn == 2 || u.pn == 3);
        const float* gn = u.pn == 4 ? kg : qg;
        const int a_ = wc >> 1, p0 = (wc & 1) * 16 + fq * 4, d0 = a_ * 64 + p0;
#pragma unroll
        for (int ai = 0; ai < 2; ++ai)
#pragma unroll
            for (int m = 0; m < 4; ++m) { const int rt = ai * 128 + wr * 64 + m * 16 + fr; const int row = u.pm * 256 + rt;
                bf16_t* rowp = proj + (size_t)row * NPROJ + colb; float vs1 = 0.f, vs2 = 0.f;
                f32x4 cs0 = (f32x4){1.f, 0.f, 1.f, 0.f}, cs1 = cs0;
                if (qk && jt != 0) { const int tl = (jt - 1) * 256 + rt; const int pos = a_ == 0 ? (tl >> 6) : (tl & 63); const float* rp = rope + (size_t)(pos * 32 + p0) * 2; cs0 = *(const f32x4*)rp; cs1 = *(const f32x4*)(rp + 4); }
#pragma unroll
                for (int bj = 0; bj < 2; ++bj) { const int c0 = u.pn * 256 + bj * 128;
                    const bool act = odd ? (c0 >= 1536) : ((c0 >= 1024 && c0 < 1536) || c0 >= 2048);
                    f32x4 v0 = acc[ai][bj][m][0] * rstd[ai][m] + bv[bj][0], v1 = acc[ai][bj][m][1] * rstd[ai][m] + bv[bj][1];
                    if (act) { v0.x = silu_f(v0.x); v0.y = silu_f(v0.y); v0.z = silu_f(v0.z); v0.w = silu_f(v0.w); v1.x = silu_f(v1.x); v1.y = silu_f(v1.y); v1.z = silu_f(v1.z); v1.w = silu_f(v1.w); }
                    if (qk) { const f32x4 pr = *(const f32x4*)(red + ((rt) * 2 + bj) * 4);
                        const float hr = rsqrtf(((pr.x + pr.y) + (pr.z + pr.w)) * (1.f / 128.f) + EPS);
                        const f32x4 g1 = *(const f32x4*)(gn + d0), g2 = *(const f32x4*)(gn + d0 + 32);
                        const f32x4 x1 = v0 * hr * g1, x2 = v1 * hr * g2;
                        v0.x = x1.x * cs0.x - x2.x * cs0.y; v1.x = x1.x * cs0.y + x2.x * cs0.x; v0.y = x1.y * cs0.z - x2.y * cs0.w; v1.y = x1.y * cs0.w + x2.y * cs0.z;
                        v0.z = x1.z * cs1.x - x2.z * cs1.y; v1.z = x1.z * cs1.y + x2.z * cs1.x; v0.w = x1.w * cs1.z - x2.w * cs1.w; v1.w = x1.w * cs1.w + x2.w * cs1.z; }
                    if (vt) { vs1 += ((v0.x + v0.y) + (v0.z + v0.w)) + ((v1.x + v1.y) + (v1.z + v1.w)); vs2 += ((v0.x * v0.x + v0.y * v0.y) + (v0.z * v0.z + v0.w * v0.w)) + ((v1.x * v1.x + v1.y * v1.y) + (v1.z * v1.z + v1.w * v1.w)); }
                    u32x4 o; o.x = pk2(v0.x, v0.y); o.y = pk2(v0.z, v0.w); o.z = pk2(v1.x, v1.y); o.w = pk2(v1.z, v1.w); *(u32x4*)(rowp + bj * 128) = o; }
                if (vt) { vs1 += __shfl_xor(vs1, 16); vs1 += __shfl_xor(vs1, 32); vs2 += __shfl_xor(vs2, 16); vs2 += __shfl_xor(vs2, 32);
                    if (fq == 0) { float2 w_; w_.x = vs1; w_.y = vs2; *(float2*)(vst + ((size_t)row * 8 + (u.pn - 2) * 4 + wc) * 2) = w_; } }
            }
    }
};
struct EpiGluTile {
    static constexpr bool PERM = true, AFTER_DRAIN = false;
    const bf16_t* yg; const bf16_t* proj; const float* bglu; bf16_t* mix;
    __device__ __forceinline__ void operator()(const pg8::f32x4 (&acc)[2][2][4][2], const pg8::Unit& u, int wr, int wc, int fr, int fq) const {
        asm volatile("" : "+v"(fr), "+v"(fq));
        const int colb = u.pn * 256 + wc * 32 + 8 * fq;
        f32x4 bv[2][2];
#pragma unroll
        for (int bj = 0; bj < 2; ++bj)
#pragma unroll
            for (int n = 0; n < 2; ++n) bv[bj][n] = *(const f32x4*)(bglu + colb + bj * 128 + n * 4);
#pragma unroll
        for (int ai = 0; ai < 2; ++ai)
#pragma unroll
            for (int m = 0; m < 4; ++m) { const int row = u.pm * 256 + ai * 128 + wr * 64 + m * 16 + fr;
#pragma unroll
                for (int bj = 0; bj < 2; ++bj) { const int col = colb + bj * 128; const f32x4 v0 = acc[ai][bj][m][0] + bv[bj][0], v1 = acc[ai][bj][m][1] + bv[bj][1];
                    const u32x4 yw = *(const u32x4*)(yg + (size_t)row * 512 + col), gw = *(const u32x4*)(proj + (size_t)row * NPROJ + 2048 + col);
                    u32x4 o; o.x = pk2(bflo(yw.x) * sigmoid_f(v0.x) * bflo(gw.x), bfhi(yw.x) * sigmoid_f(v0.y) * bfhi(gw.x)); o.y = pk2(bflo(yw.y) * sigmoid_f(v0.z) * bflo(gw.y), bfhi(yw.y) * sigmoid_f(v0.w) * bfhi(gw.y));
                    o.z = pk2(bflo(yw.z) * sigmoid_f(v1.x) * bflo(gw.z), bfhi(yw.z) * sigmoid_f(v1.y) * bfhi(gw.z)); o.w = pk2(bflo(yw.w) * sigmoid_f(v1.z) * bflo(gw.w), bfhi(yw.w) * sigmoid_f(v1.w) * bfhi(gw.w));
                    *(u32x4*)(mix + (size_t)row * DM + 512 + col) = o; }
                if (m & 1) asm volatile("" ::: "memory"); }
    }
};
template <class ET> __device__ __forceinline__ void gemm_fast_tile(const Ctx& c, const bf16_t* A, const bf16_t* Bt, int M, int N, int K, const ET& e) {
    pg8::Gemm g{A, Bt, M, N, K}; pg8::StaticOrder S; S.init(M, N, (int)gridDim.x, (int)blockIdx.x);
    pg8::gemm_phase<ET, pg8::StaticOrder, true, true>((PG8_LAS unsigned char*)c.lds, g, S, e, c.tid);
    __syncthreads();
}


struct LatentOrder {
    pg8::StaticOrder s;
    __device__ void init(int N, int G_, int c_) { s.init(NB * SEQ, N, G_, c_); }
    __device__ bool next(int i, pg8::Unit& u) const { if (!s.next(i, u)) return false; u.pm = (u.pm >> 4) * 17 + (u.pm & 15) + 1; return true; }
    __device__ __forceinline__ void a_ready(const pg8::Unit&) const {}
    __device__ __forceinline__ void done(const pg8::Unit&) const {}
};
struct EpiOutTile {
    static constexpr bool PERM = true, AFTER_DRAIN = false;
    const float* xold_f; const bf16_t* xold_b; float* xnew_f; bf16_t* xnew_b;
    const float* mods; const float* mods_next; const float* gnext; bf16_t* xm; float* rss;
    __device__ __forceinline__ void operator()(const pg8::f32x4 (&acc)[2][2][4][2], const pg8::Unit& u, int wr, int wc, int fr, int fq) const {
        asm volatile("" : "+v"(fr), "+v"(fq));
        const int b = u.pm / 17, j = u.pm - b * 17;
        const int colb = u.pn * 256 + wc * 32 + 8 * fq;
        const size_t off0 = ((size_t)b * SEQ + (j - 1) * 256 + wr * 64 + fr) * DM + colb;
        const size_t row0 = (size_t)u.pm * 256 + wr * 64 + fr;
        float ss[2][4];
#pragma unroll
        for (int ai = 0; ai < 2; ++ai)
#pragma unroll
            for (int m = 0; m < 4; ++m) ss[ai][m] = 0.f;
#define EPI_OUT_BATCH(BJ, AI0) do { \
            f32x4 xo[4][2]; \
            if (xold_b) { _Pragma("unroll") for (int m = 0; m < 4; ++m) { const u32x4 w_ = *(const u32x4*)(xold_b + off0 + (size_t)((AI0) * 128 + m * 16) * DM + BJ * 128); \
                    xo[m][0] = (f32x4){bflo(w_.x), bfhi(w_.x), bflo(w_.y), bfhi(w_.y)}; xo[m][1] = (f32x4){bflo(w_.z), bfhi(w_.z), bflo(w_.w), bfhi(w_.w)}; } } \
            else { _Pragma("unroll") for (int m = 0; m < 4; ++m) { const float* xp = xold_f + off0 + (size_t)((AI0) * 128 + m * 16) * DM + BJ * 128; xo[m][0] = *(const f32x4*)xp; xo[m][1] = *(const f32x4*)(xp + 4); } } \
            const int col = colb + BJ * 128; \
            const f32x4 gt0 = *(const f32x4*)(mods + (size_t)b * 3072 + 2048 + col), gt1 = *(const f32x4*)(mods + (size_t)b * 3072 + 2048 + col + 4); \
            f32x4 an0 = (f32x4){0.f, 0.f, 0.f, 0.f}, an1 = an0; \
            if (mods_next) { an0 = *(const f32x4*)(gnext + col) * (*(const f32x4*)(mods_next + (size_t)b * 3072 + 1024 + col) + 1.f); an1 = *(const f32x4*)(gnext + col + 4) * (*(const f32x4*)(mods_next + (size_t)b * 3072 + 1024 + col + 4) + 1.f); } \
            _Pragma("unroll") for (int m = 0; m < 4; ++m) { const int ai = AI0; \
                    const f32x4 x0 = xo[m][0] + gt0 * acc[ai][BJ][m][0], x1 = xo[m][1] + gt1 * acc[ai][BJ][m][1]; \
                    const size_t o_ = off0 + (size_t)(ai * 128 + m * 16) * DM + BJ * 128; \
                    if (xnew_b) { u32x4 w; w.x = pk2(x0.x, x0.y); w.y = pk2(x0.z, x0.w); w.z = pk2(x1.x, x1.y); w.w = pk2(x1.z, x1.w); *(u32x4*)(xnew_b + o_) = w; } \
                    else { *(f32x4*)(xnew_f + o_) = x0; *(f32x4*)(xnew_f + o_ + 4) = x1; } \
                    ss[ai][m] += ((x0.x * x0.x + x0.y * x0.y) + (x0.z * x0.z + x0.w * x0.w)) + ((x1.x * x1.x + x1.y * x1.y) + (x1.z * x1.z + x1.w * x1.w)); \
                    if (mods_next) { const f32x4 h0 = x0 * an0, h1 = x1 * an1; u32x4 w; w.x = pk2(h0.x, h0.y); w.y = pk2(h0.z, h0.w); w.z = pk2(h1.x, h1.y); w.w = pk2(h1.z, h1.w); \
                        *(u32x4*)(xm + (row0 + ai * 128 + m * 16) * DM + col) = w; } } \
            asm volatile("" ::: "memory"); } while (0)
        EPI_OUT_BATCH(0, 0); EPI_OUT_BATCH(0, 1); EPI_OUT_BATCH(1, 0); EPI_OUT_BATCH(1, 1);
#undef EPI_OUT_BATCH
        if (mods_next) {
#pragma unroll
            for (int ai = 0; ai < 2; ++ai)
#pragma unroll
                for (int m = 0; m < 4; ++m) { float s_ = ss[ai][m]; s_ += __shfl_xor(s_, 16); s_ += __shfl_xor(s_, 32); if (fq == 0) rss[(row0 + ai * 128 + m * 16) * 16 + u.pn * 4 + wc] = s_; }
        }
    }
};
__device__ __forceinline__ void out_ctx_small(const Ctx& c, int l, const float* cold, float* cnew) {
    const P& p = *c.p;
    const bf16_t* mix = (const bf16_t*)(p.ws + WS_MIX); const bf16_t* wt = (const bf16_t*)(p.ws + WS_WOUT) + (size_t)l * DM * DM;
    const float* mods = (const float*)(p.ws + WS_MODS) + (size_t)l * 5 * 3072 + 4 * 3072; const float* modsn = (const float*)(p.ws + WS_MODS) + (size_t)(l + 1) * 5 * 3072 + 4 * 3072;
    const float* gnext = p.in[4] + (l + 1) * DM; bf16_t* xm = (bf16_t*)(p.ws + WS_XM); float* rss = (float*)(p.ws + WS_RSS);
    const int wid = __builtin_amdgcn_readfirstlane(c.wid), fr = c.lane & 15, fq = c.lane >> 4, rg = wid & 3, kh = wid >> 2;
    float* red = (float*)c.lds;
    for (int t = blockIdx.x; t < 256; t += gridDim.x) {
        const int rm = t >> 4, cn = t & 15;
        const int cr = rm * 64 + rg * 16 + fr, b = cr >> 8, ti = cr & 255;
        const size_t m = (size_t)b * TPB + ti;
        f32x4 acc[4];
#pragma unroll
        for (int q = 0; q < 4; ++q) acc[q] = (f32x4){0.f, 0.f, 0.f, 0.f};
        const bf16_t* a0 = mix + m * DM + kh * 512 + fq * 8; const bf16_t* b0 = wt + (size_t)(cn * 64 + fr) * DM + kh * 512 + fq * 8;
#pragma unroll 4
        for (int k = 0; k < 512; k += 32) { const bf16x8 af = *(const bf16x8*)(a0 + k);
#pragma unroll
            for (int q = 0; q < 4; ++q) { const bf16x8 bf = *(const bf16x8*)(b0 + (size_t)q * 16 * DM + k); acc[q] = __builtin_amdgcn_mfma_f32_16x16x32_bf16(bf, af, acc[q], 0, 0, 0); } }
        __syncthreads();
        if (kh == 1) {
#pragma unroll
            for (int q = 0; q < 4; ++q) *(f32x4*)(red + ((rg * 64 + c.lane) * 4 + q) * 4) = acc[q]; }
        __syncthreads();
        if (kh == 0) {
            float ss = 0.f; const size_t off = ((size_t)b * NCTX + ti) * DM;
#pragma unroll
            for (int q = 0; q < 4; ++q) { const int col = cn * 64 + q * 16 + 4 * fq;
                const f32x4 a2 = acc[q] + *(const f32x4*)(red + ((rg * 64 + c.lane) * 4 + q) * 4);
                const f32x4 gt = *(const f32x4*)(mods + 2048 + col), sc = *(const f32x4*)(modsn + 1024 + col), gv = *(const f32x4*)(gnext + col);
                const f32x4 o = *(const f32x4*)(cold + off + col); const f32x4 xn = o + gt * a2;
                *(f32x4*)(cnew + off + col) = xn; ss += (xn.x * xn.x + xn.y * xn.y) + (xn.z * xn.z + xn.w * xn.w);
                const f32x4 h = xn * gv * (sc + 1.f); u32x2 w; w.x = pk2(h.x, h.y); w.y = pk2(h.z, h.w); *(u32x2*)(xm + m * DM + col) = w; }
            ss += __shfl_xor(ss, 16); ss += __shfl_xor(ss, 32); if (fq == 0) rss[m * 16 + cn] = ss;
        }
    }
    __syncthreads();
}

__device__ __forceinline__ void phase_in(const Ctx& c, int l) {
    const P& p = *c.p;
    EpiIn e{(const float*)(p.ws + WS_RSS), (const float*)(p.ws + WS_BIAS) + (size_t)l * 5 * NPROJ, (bf16_t*)(p.ws + WS_PROJ), l & 1};
    #ifdef USE_PG8
    { const int i_ = l >> 1; EpiInTile et{e.rss, e.bias, e.proj, e.odd, p.in[24] + i_ * 128, p.in[25] + i_ * 128, (const float*)(p.ws + WS_ROPE), (float*)(c.lds + 131072), (float*)(p.ws + WS_VST)}; gemm_fast_tile(c, (const bf16_t*)(p.ws + WS_XM), (const bf16_t*)(p.ws + WS_WIN) + (size_t)l * NPROJ * DM, MTOK, NPROJ, DM, et); }
#else
    gemm_simple(c, (const bf16_t*)(p.ws + WS_XM), DM, (const bf16_t*)(p.ws + WS_WIN) + (size_t)l * NPROJ * DM, DM, MTOK, NPROJ, DM, e);
#endif
}
__device__ __forceinline__ void phase_out(const Ctx& c, int l) {
    const P& p = *c.p;
    float* cres = (float*)(p.ws + WS_CTXRES);
    const bool last = l == DEPTH - 1;
    bf16_t* xb = (bf16_t*)(p.ws + WS_XB);
    EpiOutTile e{l == 0 ? p.in[0] : nullptr, l == 0 ? nullptr : xb, last ? p.out : nullptr, last ? nullptr : xb, (const float*)(p.ws + WS_MODS) + (size_t)l * 5 * 3072, last ? nullptr : (const float*)(p.ws + WS_MODS) + (size_t)(l + 1) * 5 * 3072,
                 last ? nullptr : p.in[4] + (l + 1) * DM, (bf16_t*)(p.ws + WS_XM), (float*)(p.ws + WS_RSS)};
    pg8::Gemm g{(const bf16_t*)(p.ws + WS_MIX), (const bf16_t*)(p.ws + WS_WOUT) + (size_t)l * DM * DM, MTOK, DM, DM};
    LatentOrder S; S.init(DM, (int)gridDim.x, (int)blockIdx.x);
    pg8::gemm_phase<EpiOutTile, LatentOrder, true, true>((PG8_LAS unsigned char*)c.lds, g, S, e, c.tid);
    __syncthreads();
    if (!last) out_ctx_small(c, l, l == 0 ? p.in[2] : cres, cres);
#if defined(DUPX) && DUPX == 3
    if (l == 0) out_ctx_small(c, l, p.in[2], cres);
#endif
}
__device__ __forceinline__ void phase_gmlp_fast(const Ctx& c, int l, int blk0, int nblk);
__device__ __forceinline__ void phase_glu(const Ctx& c, int l) {
    const P& p = *c.p; const int i = l >> 1;
    const int G = gridDim.x, ng = G >= 200 ? 136 : G;
    if ((int)blockIdx.x < ng) {
        EpiGluTile et{(const bf16_t*)(p.ws + WS_YG), (const bf16_t*)(p.ws + WS_PROJ), p.in[21] + i * 512, (bf16_t*)(p.ws + WS_MIX)};
        pg8::Gemm g{(const bf16_t*)(p.ws + WS_YG), (const bf16_t*)(p.ws + WS_WGLU) + (size_t)i * 512 * 512, MTOK, 512, 512}; pg8::StaticOrder S; S.init(MTOK, 512, ng, (int)blockIdx.x);
        pg8::gemm_phase<EpiGluTile, pg8::StaticOrder, true, true>((PG8_LAS unsigned char*)c.lds, g, S, et, c.tid);
        __syncthreads();
        if (ng == G) phase_gmlp_fast(c, l, 0, G);
    } else phase_gmlp_fast(c, l, ng, G - ng);
}

__device__ __forceinline__ void phase_gmlp(const Ctx& c, int l) {
    const P& p = *c.p; const int i = l >> 1;
    const bf16_t* proj = (const bf16_t*)(p.ws + WS_PROJ); bf16_t* mix = (bf16_t*)(p.ws + WS_MIX);
    const float* vg = p.in[9] + i * 512; const float* ws_ = p.in[10] + (size_t)i * 4 * 128 * 128; const float* bs = p.in[11] + i * 4 * 128;
    float* vn = (float*)c.lds;
    for (int it = blockIdx.x; it < 136 * 4; it += gridDim.x) {
        const int ch = it >> 2, g = it & 3;
        __syncthreads();
        for (int q = c.wid; q < 128; q += NWAVES) {
            const size_t row = (size_t)ch * 128 + q;
            const u32x4 w = *(const u32x4*)(proj + row * NPROJ + 512 + c.lane * 8);
            float v[8] = {bflo(w.x), bfhi(w.x), bflo(w.y), bfhi(w.y), bflo(w.z), bfhi(w.z), bflo(w.w), bfhi(w.w)};
            float s = 0.f;
#pragma unroll
            for (int e = 0; e < 8; ++e) s += v[e];
            const float mu = wave_sum(s) * (1.f / 512.f); float s2 = 0.f;
#pragma unroll
            for (int e = 0; e < 8; ++e) { v[e] -= mu; s2 += v[e] * v[e]; }
            const float rstd = rsqrtf(wave_sum(s2) * (1.f / 512.f) + EPS);
            if ((c.lane >> 4) == g) {
#pragma unroll
                for (int e = 0; e < 8; ++e) { const int cc = (c.lane & 15) * 8 + e; vn[q * 129 + cc] = v[e] * rstd * vg[g * 128 + cc]; }
            }
        }
        __syncthreads();
        const int cc = c.tid & 127, pq = c.tid >> 7;
        for (int pp = pq * 32; pp < pq * 32 + 32; ++pp) {
            const float* wrow = ws_ + ((size_t)g * 128 + pp) * 128;
            float acc = 0.f;
#pragma unroll 8
            for (int q = 0; q < 128; ++q) acc += wrow[q] * vn[q * 129 + cc];
            const float mixed = acc + bs[g * 128 + pp];
            const size_t row = (size_t)ch * 128 + pp;
            const float u = bf2f(proj[row * NPROJ + g * 128 + cc]), ga = bf2f(proj[row * NPROJ + 1024 + g * 128 + cc]);
            mix[row * DM + g * 128 + cc] = (bf16_t)f2bf(u * mixed * ga);
        }
    }
}

__device__ __forceinline__ void phase_s5_naive(const Ctx& c, int l) {
    const P& p = *c.p; const int i = l >> 1;
    const bf16_t* proj = (const bf16_t*)(p.ws + WS_PROJ);
    float* red = (float*)(c.lds + 80 * 1024) + c.wid * 1024;
    for (int it = c.gw; it < NB * 32 * 2; it += c.ngw) {
        const int dir = it & 1, g = (it >> 1) & 31, b = it >> 6, pl = c.lane;
        float* Y = (float*)(p.ws + (dir ? WS_XM : WS_S5));
        const size_t dg = ((size_t)(i * 2 + dir) * 32 + g);
        const float dt = expf(p.in[14][dg]);
        const float lr = p.in[12][dg * 64 + pl], li = p.in[13][dg * 64 + pl];
        const float mag = expf(lr * dt), lbr = mag * cosf(li * dt), lbi = mag * sinf(li * dt);
        const float den = lr * lr + li * li, nre = lbr - 1.f, nim = lbi;
        const float fre = (nre * lr + nim * li) / den, fim = (nim * lr - nre * li) / den;
        float bbr[16], bbi[16], cr[16], ci[16];
#pragma unroll
        for (int h = 0; h < 16; ++h) { const float br = p.in[15][(dg * 64 + pl) * 16 + h], bi = p.in[16][(dg * 64 + pl) * 16 + h];
            bbr[h] = fre * br - fim * bi; bbi[h] = fre * bi + fim * br;
            cr[h] = p.in[17][(dg * 16 + h) * 64 + pl]; ci[h] = p.in[18][(dg * 16 + h) * 64 + pl]; }
        float hr = 0.f, hi = 0.f;
        for (int s0 = 0; s0 < TPB; s0 += 4) {
            u32x4 uw[4][2];
#pragma unroll
            for (int j = 0; j < 4; ++j) { const int s = s0 + j; const int t = dir == 0 ? s : (s < NCTX ? NCTX - 1 - s : NCTX + SEQ - 1 - (s - NCTX));
                const bf16_t* up = proj + (size_t)(b * TPB + t) * NPROJ + 1536 + g * 16; uw[j][0] = *(const u32x4*)up; uw[j][1] = *(const u32x4*)(up + 8); }
#pragma unroll
            for (int j = 0; j < 4; ++j) { const int s = s0 + j; const int t = dir == 0 ? s : (s < NCTX ? NCTX - 1 - s : NCTX + SEQ - 1 - (s - NCTX));
                float u[16];
#pragma unroll
                for (int q = 0; q < 2; ++q) { u[8 * q + 0] = bflo(uw[j][q].x); u[8 * q + 1] = bfhi(uw[j][q].x); u[8 * q + 2] = bflo(uw[j][q].y); u[8 * q + 3] = bfhi(uw[j][q].y);
                    u[8 * q + 4] = bflo(uw[j][q].z); u[8 * q + 5] = bfhi(uw[j][q].z); u[8 * q + 6] = bflo(uw[j][q].w); u[8 * q + 7] = bfhi(uw[j][q].w); }
                float bur = 0.f, bui = 0.f;
#pragma unroll
                for (int h = 0; h < 16; ++h) { bur += bbr[h] * u[h]; bui += bbi[h] * u[h]; }
                const float nhr = lbr * hr - lbi * hi + bur, nhi = lbr * hi + lbi * hr + bui; hr = nhr; hi = nhi;
#pragma unroll
                for (int h = 0; h < 16; ++h) red[h * 64 + pl] = cr[h] * hr - ci[h] * hi;
                asm volatile("s_waitcnt lgkmcnt(0)" ::: "memory");
                const int hh = pl & 15, part = pl >> 4; float sum = 0.f;
#pragma unroll
                for (int q = 0; q < 16; ++q) sum += red[hh * 64 + part * 16 + q];
                sum += __shfl_xor(sum, 16); sum += __shfl_xor(sum, 32);
                if (pl < 16) Y[(size_t)(b * TPB + t) * 512 + g * 16 + pl] = sum;
                asm volatile("s_waitcnt lgkmcnt(0)" ::: "memory");
            }
        }
    }
}
__device__ __forceinline__ void phase_s5comb(const Ctx& c, int l) {
    const P& p = *c.p; const int i = l >> 1;
    const float* Yf = (const float*)(p.ws + WS_S5); const float* Yb = (const float*)(p.ws + WS_XM); const bf16_t* proj = (const bf16_t*)(p.ws + WS_PROJ);
    bf16_t* yg = (bf16_t*)(p.ws + WS_YG); const float* d = p.in[19] + i * 512;
    const size_t n4 = (size_t)MTOK * 512 / 4;
    for (size_t e = (size_t)blockIdx.x * NTHREADS + c.tid; e < n4; e += (size_t)gridDim.x * NTHREADS) {
        const size_t row = e / 128; const int col = (int)(e % 128) * 4;
        const f32x4 a = *(const f32x4*)(Yf + row * 512 + col), b = *(const f32x4*)(Yb + row * 512 + col), dv = *(const f32x4*)(d + col);
        const u32x2 xw = *(const u32x2*)(proj + row * NPROJ + 1536 + col);
        const float y0 = a.x + b.x + dv.x * bflo(xw.x), y1 = a.y + b.y + dv.y * bfhi(xw.x), y2 = a.z + b.z + dv.z * bflo(xw.y), y3 = a.w + b.w + dv.w * bfhi(xw.y);
        u32x2 o; o.x = pk2(gelu_tanh_f(y0), gelu_tanh_f(y1)); o.y = pk2(gelu_tanh_f(y2), gelu_tanh_f(y3));
        *(u32x2*)(yg + row * 512 + col) = o;
    }
}


constexpr size_t S5T_LAM = 0, S5T_BBT = 64 * 1024, S5T_CMT = 320 * 1024;
constexpr size_t WS_WST = WS_S5 + 2 * MiB;
constexpr size_t WS_SCB = WS_S5 + 5 * MiB;
constexpr size_t WS_SR = WS_S5 + 10 * MiB;
typedef float f32x16 __attribute__((ext_vector_type(16)));

__device__ __forceinline__ void phase_s5prep(const Ctx& c) {
    const P& p = *c.p;
    for (int it = c.gw; it < 2 * 2 * 32; it += c.ngw) {
        const int i = it >> 6, dir = (it >> 5) & 1, g = it & 31, pl = c.lane;
        unsigned char* tb = p.ws + WS_S5 + (size_t)i * MiB;
        const size_t dg = ((size_t)(i * 2 + dir) * 32 + g);
        const float dt = expf(p.in[14][dg]);
        const float lr = p.in[12][dg * 64 + pl], li = p.in[13][dg * 64 + pl];
        const float mag = expf(lr * dt), lbr = mag * cosf(li * dt), lbi = mag * sinf(li * dt);
        const float den = lr * lr + li * li, nre = lbr - 1.f, nim = lbi;
        const float fre = (nre * lr + nim * li) / den, fim = (nim * lr - nre * li) / den;
        float* lam = (float*)(tb + S5T_LAM) + ((size_t)(dir * 32 + g) * 64 + pl) * 2; lam[0] = lbr; lam[1] = lbi;
        bf16_t* bbt = (bf16_t*)(tb + S5T_BBT) + (size_t)(dir * 32 + g) * 2 * 64 * 16; bf16_t* cmt = (bf16_t*)(tb + S5T_CMT) + (size_t)(dir * 32 + g) * 16 * 128;
#pragma unroll
        for (int h = 0; h < 16; ++h) { const float br = p.in[15][(dg * 64 + pl) * 16 + h], bi = p.in[16][(dg * 64 + pl) * 16 + h];
            bbt[(0 * 64 + pl) * 16 + h] = (bf16_t)f2bf(fre * br - fim * bi); bbt[(1 * 64 + pl) * 16 + h] = (bf16_t)f2bf(fre * bi + fim * br);
            cmt[h * 128 + 2 * pl] = (bf16_t)f2bf(p.in[17][(dg * 16 + h) * 64 + pl]); cmt[h * 128 + 2 * pl + 1] = (bf16_t)f2bf(-p.in[18][(dg * 16 + h) * 64 + pl]); }
    }
    bf16_t* wst = (bf16_t*)(p.ws + WS_WST);
    for (size_t e = (size_t)blockIdx.x * NTHREADS + c.tid; e < (size_t)2 * 4 * 128 * 128 / 4; e += (size_t)gridDim.x * NTHREADS) {
        const f32x4 v = *(const f32x4*)(p.in[10] + e * 4); u32x2 o; o.x = pk2(v.x, v.y); o.y = pk2(v.z, v.w); *(u32x2*)(wst + e * 4) = o; }
}

__device__ __forceinline__ void phase_gmlp_fast(const Ctx& c, int l, int blk0, int nblk) {
    const P& p = *c.p; const int i = l >> 1;
    const bf16_t* proj = (const bf16_t*)(p.ws + WS_PROJ); bf16_t* mix = (bf16_t*)(p.ws + WS_MIX);
    const float* vg = p.in[9] + i * 512; const float* bs = p.in[11] + i * 4 * 128;
    const bf16_t* wst = (const bf16_t*)(p.ws + WS_WST) + (size_t)i * 4 * 128 * 128;
    char* lds = (char*)c.lds;
    float* st = (float*)(lds + 32768);
    const int wid = __builtin_amdgcn_readfirstlane(c.wid), lane = c.lane, r32 = lane & 31, hi = lane >> 5;
    char* ost = lds + 36864 + wid * 4608;
    for (int it = (int)blockIdx.x - blk0; it < 136 * 4; it += nblk) {
        const int ch = it >> 2, g = it & 3;
        __syncthreads();
        if (c.tid < 128) {
            const f32x4* vp = (const f32x4*)((const float*)(p.ws + WS_VST) + ((size_t)ch * 128 + c.tid) * 16);
            const f32x4 a0 = vp[0], a1 = vp[1], a2 = vp[2], a3 = vp[3];
            const float s1 = ((a0.x + a0.z) + (a1.x + a1.z)) + ((a2.x + a2.z) + (a3.x + a3.z)), s2 = ((a0.y + a0.w) + (a1.y + a1.w)) + ((a2.y + a2.w) + (a3.y + a3.w));
            const float mu = s1 * (1.f / 512.f); const float var = fmaxf(s2 * (1.f / 512.f) - mu * mu, 0.f);
            st[2 * c.tid] = mu; st[2 * c.tid + 1] = rsqrtf(var + EPS);
        }
        __syncthreads();
        { const int sr = c.tid >> 4, sc = (c.tid & 15) * 8;
            float gv[8];
#pragma unroll
            for (int e = 0; e < 8; ++e) gv[e] = vg[g * 128 + sc + e];
#pragma unroll
            for (int t = 0; t < 2; ++t)
#pragma unroll
                for (int hh = 0; hh < 2; ++hh) { const int q = t * 64 + hh * 32 + sr;
                    const u32x4 w = *(const u32x4*)(proj + ((size_t)ch * 128 + q) * NPROJ + 512 + g * 128 + sc);
                    const float mu = st[2 * q], rs = st[2 * q + 1];
                    u32x4 o; o.x = pk2((bflo(w.x) - mu) * rs * gv[0], (bfhi(w.x) - mu) * rs * gv[1]); o.y = pk2((bflo(w.y) - mu) * rs * gv[2], (bfhi(w.y) - mu) * rs * gv[3]);
                    o.z = pk2((bflo(w.z) - mu) * rs * gv[4], (bfhi(w.z) - mu) * rs * gv[5]); o.w = pk2((bflo(w.w) - mu) * rs * gv[6], (bfhi(w.w) - mu) * rs * gv[7]);
                    *(u32x4*)(lds + t * 16384 + attn::v_st(hh * 32 + sr, sc)) = o; }
        }
        __syncthreads();
        const int pw = wid & 3, cw = wid >> 2;
        f32x16 o0 = {}, o1 = {};
        const int vb = (int)(uintptr_t)lds + attn::v_rd_base(lane);
        const bf16_t* wrow = wst + ((size_t)g * 128 + pw * 32 + r32) * 128 + hi * 8;
#pragma unroll
        for (int t = 0; t < 2; ++t) {
            const bf16x8 pa0 = *(const bf16x8*)(wrow + t * 64), pa1 = *(const bf16x8*)(wrow + t * 64 + 16), pa2 = *(const bf16x8*)(wrow + t * 64 + 32), pa3 = *(const bf16x8*)(wrow + t * 64 + 48);
            if (cw == 0) { attn::pv_one<0>(o0, vb + t * 16384, pa0, pa1, pa2, pa3); attn::pv_one<1>(o1, vb + t * 16384, pa0, pa1, pa2, pa3); }
            else         { attn::pv_one<2>(o0, vb + t * 16384, pa0, pa1, pa2, pa3); attn::pv_one<3>(o1, vb + t * 16384, pa0, pa1, pa2, pa3); }
        }
        {
            int ob = hi * (4 * 144) + r32 * 2; asm volatile("" : "+v"(ob));
#pragma unroll
            for (int r = 0; r < 16; ++r) { const int prow0 = (r & 3) + 8 * (r >> 2); const float b = bs[g * 128 + pw * 32 + prow0 + 4 * hi];
                *(bf16_t*)(ost + ob + prow0 * 144) = (bf16_t)f2bf(o0[r] + b); *(bf16_t*)(ost + ob + prow0 * 144 + 64) = (bf16_t)f2bf(o1[r] + b); }
            asm volatile("s_waitcnt lgkmcnt(0)" ::: "memory");
#pragma unroll
            for (int k = 0; k < 4; ++k) { const int id = k * 64 + lane, row = id >> 3, chk = id & 7;
                const u32x4 mv = *(const u32x4*)(ost + row * 144 + chk * 16);
                const size_t grow = (size_t)ch * 128 + pw * 32 + row; const int col = g * 128 + cw * 64 + chk * 8;
                const u32x4 uv = *(const u32x4*)(proj + grow * NPROJ + col), gvv = *(const u32x4*)(proj + grow * NPROJ + 1024 + col);
                u32x4 w; w.x = pk2(bflo(uv.x) * bflo(mv.x) * bflo(gvv.x), bfhi(uv.x) * bfhi(mv.x) * bfhi(gvv.x)); w.y = pk2(bflo(uv.y) * bflo(mv.y) * bflo(gvv.y), bfhi(uv.y) * bfhi(mv.y) * bfhi(gvv.y));
                w.z = pk2(bflo(uv.z) * bflo(mv.z) * bflo(gvv.z), bfhi(uv.z) * bfhi(mv.z) * bfhi(gvv.z)); w.w = pk2(bflo(uv.w) * bflo(mv.w) * bflo(gvv.w), bfhi(uv.w) * bfhi(mv.w) * bfhi(gvv.w));
                *(u32x4*)(mix + grow * DM + col) = w; }
            asm volatile("s_waitcnt lgkmcnt(0)" ::: "memory");
        }
    }
}

struct cplx { float r, i; };
__device__ __forceinline__ cplx cmul(cplx a, cplx b) { return {a.r * b.r - a.i * b.i, a.r * b.i + a.i * b.r}; }
__device__ __forceinline__ cplx cfma(cplx a, cplx x, cplx b) { return {fmaf(a.r, x.r, fmaf(-a.i, x.i, b.r)), fmaf(a.r, x.i, fmaf(a.i, x.r, b.i))}; }
__device__ __forceinline__ cplx csel(bool s, cplx a, cplx b) { return {s ? a.r : b.r, s ? a.i : b.i}; }
template <bool BWD, bool FINAL>
__device__ __forceinline__ void s5_chunk_scan(f32x16 (&br)[2], f32x16 (&bi)[2], const cplx lam, const cplx Hin, const bool half, cplx& Hout) {
    const cplx lam2 = cmul(lam, lam), lam3 = cmul(lam2, lam), lam4 = cmul(lam2, lam2);
    cplx E[2][4];
#pragma unroll
    for (int tb = 0; tb < 2; ++tb)
#pragma unroll
        for (int q = 0; q < 4; ++q) {
            if (!BWD) { cplx w = {br[tb][4 * q], bi[tb][4 * q]};
#pragma unroll
                for (int j = 1; j < 4; ++j) { w = cfma(lam, w, (cplx){br[tb][4 * q + j], bi[tb][4 * q + j]}); br[tb][4 * q + j] = w.r; bi[tb][4 * q + j] = w.i; }
                E[tb][q] = w; }
            else { cplx w = {br[tb][4 * q + 3], bi[tb][4 * q + 3]};
#pragma unroll
                for (int j = 2; j >= 0; --j) { w = cfma(lam, w, (cplx){br[tb][4 * q + j], bi[tb][4 * q + j]}); br[tb][4 * q + j] = w.r; bi[tb][4 * q + j] = w.i; }
                E[tb][q] = w; }
        }
    cplx Eev[2][4], Eod[2][4];
#pragma unroll
    for (int tb = 0; tb < 2; ++tb)
#pragma unroll
        for (int q = 0; q < 4; ++q) {
            const auto rr = __builtin_amdgcn_permlane32_swap(__float_as_uint(E[tb][q].r), __float_as_uint(E[tb][q].r), false, false);
            const auto ri = __builtin_amdgcn_permlane32_swap(__float_as_uint(E[tb][q].i), __float_as_uint(E[tb][q].i), false, false);
            Eev[tb][q] = {__uint_as_float(rr[0]), __uint_as_float(ri[0])}; Eod[tb][q] = {__uint_as_float(rr[1]), __uint_as_float(ri[1])}; }
    cplx H = Hin; cplx Hg[2][4];
    if (!BWD) {
#pragma unroll
        for (int tb = 0; tb < 2; ++tb)
#pragma unroll
            for (int q = 0; q < 4; ++q) { const cplx He = H; H = cfma(lam4, H, Eev[tb][q]); const cplx Ho = H; H = cfma(lam4, H, Eod[tb][q]); Hg[tb][q] = csel(half, Ho, He); }
    } else {
#pragma unroll
        for (int tb = 1; tb >= 0; --tb)
#pragma unroll
            for (int q = 3; q >= 0; --q) { const cplx Ho = H; H = cfma(lam4, H, Eod[tb][q]); const cplx He = H; H = cfma(lam4, H, Eev[tb][q]); Hg[tb][q] = csel(half, Ho, He); }
    }
    Hout = H;
    if (FINAL) {
#pragma unroll
        for (int tb = 0; tb < 2; ++tb)
#pragma unroll
            for (int q = 0; q < 4; ++q)
#pragma unroll
                for (int j = 0; j < 4; ++j) { const int e = BWD ? 3 - j : j; const cplx pw = e == 0 ? lam : (e == 1 ? lam2 : (e == 2 ? lam3 : lam4));
                    const cplx h = cfma(pw, Hg[tb][q], (cplx){br[tb][4 * q + j], bi[tb][4 * q + j]}); br[tb][4 * q + j] = h.r; bi[tb][4 * q + j] = h.i; }
    }
}
__device__ __forceinline__ cplx cpow2n(cplx a, int n) { for (int k = 0; k < n; ++k) a = cmul(a, a); return a; }
__device__ __forceinline__ cplx ldc(const float* p) { const float2 v = *(const float2*)p; return {v.x, v.y}; }

__device__ __forceinline__ int s5_rs(int rk) { return rk == 0 ? 0 : (rk <= 4 ? 4 + 5 * (rk - 1) : 24 + 4 * (rk - 5)); }
__device__ __forceinline__ int s5_rl(int rk) { return (rk >= 1 && rk <= 4) ? 5 : 4; }
constexpr int S5L_LAM = 0, S5L_BB = 1024, S5L_CM = 1024 + 8192, S5L_HS = 1024 + 16384, S5L_HB = S5L_HS + 8 * 4608, S5L_END = S5L_HB + 8 * 2560;
template <bool OUT>
__device__ __forceinline__ void phase_s5_fast(const Ctx& c, int l) {
    const P& p = *c.p; const int i = l >> 1;
    const bf16_t* proj = (const bf16_t*)(p.ws + WS_PROJ);
    const unsigned char* tb_ = p.ws + WS_S5 + (size_t)i * MiB;
    float* SCB = (float*)(p.ws + WS_SCB); float* SR = (float*)(p.ws + WS_SR); bf16_t* yg = (bf16_t*)(p.ws + WS_YG);
    const int wid = __builtin_amdgcn_readfirstlane(c.wid);
    char* lds = (char*)c.lds;
    const int G = gridDim.x, nsub = G >> 5;
    if ((int)blockIdx.x >= nsub * 32) return;
    const int g = blockIdx.x & 31, sub = blockIdx.x >> 5;
    __syncthreads();
    {
        const float* LAM = (const float*)(tb_ + S5T_LAM); const bf16_t* BBT = (const bf16_t*)(tb_ + S5T_BBT); const bf16_t* CMT = (const bf16_t*)(tb_ + S5T_CMT);
        const int ln = c.lane, r32 = ln & 31, hi = ln >> 5;
        if (c.tid < 128) { const int d = c.tid >> 6, ps = c.tid & 63; *(float2*)(lds + S5L_LAM + (d * 64 + ps) * 8) = *(const float2*)(LAM + ((size_t)(d * 32 + g) * 64 + ps) * 2); }
        { const int d = wid >> 2, ri = (wid >> 1) & 1, pb = wid & 1;
            *(u32x4*)(lds + S5L_BB + (wid * 64 + ln) * 16) = *(const u32x4*)(BBT + (((size_t)(d * 32 + g) * 2 + ri) * 64 + pb * 32 + r32) * 16 + hi * 8); }
        { const int d = wid >> 2, pb = (wid >> 1) & 1, ks = wid & 1;
            *(u32x4*)(lds + S5L_CM + (wid * 64 + ln) * 16) = *(const u32x4*)(CMT + ((size_t)(d * 32 + g) * 16 + (ln & 15)) * 128 + pb * 64 + ks * 32 + (ln >> 4) * 8); }
    }
    __syncthreads();
    char* hs = lds + S5L_HS + wid * 4608;
#pragma unroll 1
    for (int j = sub * 8 + wid; j < 64; j += nsub * 8) {
        int lane = c.lane; asm volatile("" : "+v"(lane));
        const int r32 = lane & 31; const bool half = lane >= 32;
        const int b = j >> 4, rk = j & 15, c0 = s5_rs(rk), nc = s5_rl(rk);
        const size_t m0 = (size_t)b * TPB + 64 * c0;
        cplx Hf[2];
        float* hb = (float*)(lds + S5L_HB + wid * 2560);
        cplx SRf[2], SRb[2], pwb[2];
#pragma unroll
        for (int pb = 0; pb < 2; ++pb) { Hf[pb] = {0.f, 0.f}; SRf[pb] = {0.f, 0.f}; SRb[pb] = {0.f, 0.f}; pwb[pb] = {1.f, 0.f};
}
        if (OUT) {
            constexpr size_t KS = 32 * 2 * 64 * 2, CS = 32 * 64 * 2;
            cplx vf[2][15], vb[2][16], sv[2][5];
#pragma unroll
            for (int pb = 0; pb < 2; ++pb) { const int ps = pb * 32 + r32;
                const float* srb = SR + (((size_t)(b * 16) * 32 + g) * 2 * 64 + ps) * 2;
                const float* scb = SCB + ((((size_t)b * 68 + c0) * 32 + g) * 64 + ps) * 2;
#pragma unroll
                for (int kk = 0; kk < 15; ++kk) vf[pb][kk] = ldc(srb + kk * KS);
#pragma unroll
                for (int kk = 0; kk < 16; ++kk) vb[pb][kk] = ldc(srb + kk * KS + 128);
#pragma unroll
                for (int q = 1; q < 5; ++q) sv[pb][q] = (q < nc) ? ldc(scb + q * CS) : (cplx){0.f, 0.f}; }
#pragma unroll
            for (int pb = 0; pb < 2; ++pb) { const int ps = pb * 32 + r32;
                { const cplx L64 = cpow2n(ldc((const float*)(lds + S5L_LAM + (0 * 64 + ps) * 8)), 6), L256 = cpow2n(L64, 2), L320 = cmul(L256, L64);
                    cplx H = {0.f, 0.f};
#pragma unroll
                    for (int kk = 0; kk < 15; ++kk) if (kk < rk) H = cfma((kk >= 1 && kk <= 4) ? L320 : L256, H, vf[pb][kk]);
                    Hf[pb] = H; }
                { const cplx L64 = cpow2n(ldc((const float*)(lds + S5L_LAM + (1 * 64 + ps) * 8)), 6), L256 = cpow2n(L64, 2), L320 = cmul(L256, L64);
                    cplx H = {0.f, 0.f};
                    if (rk >= 1) { H = vb[pb][0];
#pragma unroll
                        for (int kk = 15; kk >= 2; --kk) if (kk > rk) H = cfma((kk >= 1 && kk <= 4) ? L320 : L256, H, vb[pb][kk]); }
#define HB_ST(q, Hv) do { if (!half) { float2 o_; o_.x = (Hv).r; o_.y = (Hv).i; *(float2*)(hb + ((pb * 5 + (q)) * 32 + r32) * 2) = o_; } } while (0)
                    if (nc == 5) { HB_ST(4, H); H = cfma(L64, H, sv[pb][4]); }
                    HB_ST(3, H); H = cfma(L64, H, sv[pb][3]); HB_ST(2, H); H = cfma(L64, H, sv[pb][2]); HB_ST(1, H); H = cfma(L64, H, sv[pb][1]); HB_ST(0, H); }
#undef HB_ST
            }
        }
        asm volatile("s_waitcnt lgkmcnt(0)" ::: "memory");
        bf16x8 dfr;
        { const int hh = lane & 15, l4 = lane >> 4; const unsigned dv = f2bf(p.in[19][i * 512 + g * 16 + hh]);
#pragma unroll
            for (int e = 0; e < 8; ++e) dfr[e] = (short)((8 * l4 + e == hh) ? dv : 0u); }
        bf16x8 ua[2];
#pragma unroll
        for (int tb = 0; tb < 2; ++tb) ua[tb] = *(const bf16x8*)(proj + (m0 + tb * 32 + r32) * NPROJ + 1536 + g * 16 + (lane >> 5) * 8);
#pragma unroll 1
        for (int cc = 0; cc < nc; ++cc) {
            int ln = lane; asm volatile("" : "+v"(ln));
            const int r32c = ln & 31, hi = ln >> 5, l15 = ln & 15, l4 = ln >> 4;
            const size_t mc = m0 + 64 * cc; const size_t chunk = (size_t)b * 68 + c0 + cc;
            const bf16x8 u0 = ua[0], u1 = ua[1];
            if (cc + 1 < nc) {
#pragma unroll
                for (int tb = 0; tb < 2; ++tb) ua[tb] = *(const bf16x8*)(proj + (mc + 64 + tb * 32 + r32c) * NPROJ + 1536 + g * 16 + hi * 8); }
            f32x4 yacc[4];
            if (OUT) {
                *(bf16x8*)(hs + r32c * 32 + hi * 16) = u0; *(bf16x8*)(hs + (32 + r32c) * 32 + hi * 16) = u1;
                asm volatile("s_waitcnt lgkmcnt(0)" ::: "memory");
#pragma unroll
                for (int t = 0; t < 4; ++t) { bf16x8 xa = (bf16x8){0, 0, 0, 0, 0, 0, 0, 0};
                    if (l4 < 2) xa = *(const bf16x8*)(hs + (t * 16 + l15) * 32 + l4 * 16);
                    yacc[t] = __builtin_amdgcn_mfma_f32_16x16x32_bf16(xa, dfr, (f32x4){0.f, 0.f, 0.f, 0.f}, 0, 0, 0); }
                asm volatile("s_waitcnt lgkmcnt(0)" ::: "memory");
            }
#pragma unroll
            for (int pb = 0; pb < 2; ++pb)
#pragma unroll 1
                for (int d = 0; d < 2; ++d) {
                    const cplx lam_ = ldc((const float*)(lds + S5L_LAM + (d * 64 + pb * 32 + r32c) * 8)); const cplx L64_ = cpow2n(lam_, 6);
                    const bf16x8 bre = *(const bf16x8*)(lds + S5L_BB + (((d * 2 + 0) * 2 + pb) * 64 + ln) * 16), bim = *(const bf16x8*)(lds + S5L_BB + (((d * 2 + 1) * 2 + pb) * 64 + ln) * 16);
                    f32x16 br[2], bi[2];
                    br[0] = __builtin_amdgcn_mfma_f32_32x32x16_bf16(u0, bre, (f32x16){}, 0, 0, 0); bi[0] = __builtin_amdgcn_mfma_f32_32x32x16_bf16(u0, bim, (f32x16){}, 0, 0, 0);
                    br[1] = __builtin_amdgcn_mfma_f32_32x32x16_bf16(u1, bre, (f32x16){}, 0, 0, 0); bi[1] = __builtin_amdgcn_mfma_f32_32x32x16_bf16(u1, bim, (f32x16){}, 0, 0, 0);
                    cplx Hin = {0.f, 0.f}, Hout;
                    if (OUT) { if (d == 0) Hin = Hf[pb]; else Hin = ldc(hb + ((pb * 5 + cc) * 32 + r32c) * 2); }
                    if (d == 0) s5_chunk_scan<false, OUT>(br, bi, lam_, Hin, half, Hout); else s5_chunk_scan<true, OUT>(br, bi, lam_, Hin, half, Hout);
                    if (OUT) {
                        if (d == 0) Hf[pb] = Hout;
#pragma unroll
                        for (int tb = 0; tb < 2; ++tb) {
                            int ob = hi * (4 * 144) + r32c * 4; asm volatile("" : "+v"(ob));
#pragma unroll
                            for (int r = 0; r < 16; ++r) *(unsigned*)(hs + ob + ((r & 3) + 8 * (r >> 2)) * 144) = pk2(br[tb][r], bi[tb][r]);
                            asm volatile("s_waitcnt lgkmcnt(0)" ::: "memory");
#pragma unroll
                            for (int ks = 0; ks < 2; ++ks) { const bf16x8 cf = *(const bf16x8*)(lds + S5L_CM + (((d * 2 + pb) * 2 + ks) * 64 + ln) * 16);
#pragma unroll
                                for (int tq = 0; tq < 2; ++tq) { const bf16x8 af = *(const bf16x8*)(hs + (tq * 16 + l15) * 144 + ks * 64 + l4 * 16);
                                    yacc[tb * 2 + tq] = __builtin_amdgcn_mfma_f32_16x16x32_bf16(af, cf, yacc[tb * 2 + tq], 0, 0, 0); } }
                            asm volatile("s_waitcnt lgkmcnt(0)" ::: "memory");
                        }
                    } else {
                        if (d == 0) SRf[pb] = cfma(L64_, SRf[pb], Hout);
                        else { SRb[pb] = cfma(pwb[pb], Hout, SRb[pb]); pwb[pb] = cmul(pwb[pb], L64_);
                            if (!half) { float2 o; o.x = Hout.r; o.y = Hout.i; *(float2*)(SCB + ((chunk * 32 + g) * 64 + pb * 32 + r32c) * 2) = o; } }
                    }
                }
            if (OUT) {
#pragma unroll
                for (int tq = 0; tq < 4; ++tq)
#pragma unroll
                    for (int e = 0; e < 4; ++e) *(bf16_t*)(hs + (tq * 16 + l4 * 4 + e) * 48 + l15 * 2) = (bf16_t)f2bf(gelu_tanh_f(yacc[tq][e]));
                asm volatile("s_waitcnt lgkmcnt(0)" ::: "memory");
#pragma unroll
                for (int q = 0; q < 2; ++q) { const int id = q * 64 + ln, row = id >> 1, hf = id & 1;
                    *(u32x4*)(yg + (mc + row) * 512 + g * 16 + hf * 8) = *(const u32x4*)(hs + row * 48 + hf * 16); }
                asm volatile("s_waitcnt lgkmcnt(0)" ::: "memory");
            }
        }
        if (!OUT) {
            if (!half) {
#pragma unroll
                for (int pb = 0; pb < 2; ++pb) { float2 o; o.x = SRf[pb].r; o.y = SRf[pb].i; *(float2*)(SR + ((((size_t)(b * 16 + rk) * 32 + g) * 2 + 0) * 64 + pb * 32 + r32) * 2) = o;
                    o.x = SRb[pb].r; o.y = SRb[pb].i; *(float2*)(SR + ((((size_t)(b * 16 + rk) * 32 + g) * 2 + 1) * 64 + pb * 32 + r32) * 2) = o; }
            }
        }
    }
    __syncthreads();
}

__device__ __forceinline__ void phase_headnorm(const Ctx& c, int l) {
    const P& p = *c.p; const int i = l >> 1;
    bf16_t* proj = (bf16_t*)(p.ws + WS_PROJ); const float* rope = (const float*)(p.ws + WS_ROPE);
    for (int it = c.gw; it < MTOK * 10; it += c.ngw) {
        const int m = it / 10, hd = it % 10; const int col0 = hd < 8 ? hd * 128 : 1024 + (hd - 8) * 128;
        const float* g = (hd < 8 ? p.in[24] : p.in[25]) + i * 128;
        const int a = c.lane >> 5, pr = c.lane & 31, i1 = a * 64 + pr, i2 = i1 + 32;
        bf16_t* hp = proj + (size_t)m * NPROJ + col0;
        const float x1 = bf2f(hp[i1]), x2 = bf2f(hp[i2]);
        const float hr = rsqrtf(wave_sum(x1 * x1 + x2 * x2) * (1.f / 128.f) + EPS);
        float y1 = x1 * hr * g[i1], y2 = x2 * hr * g[i2];
        const int t = m % TPB;
        if (t >= NCTX) { const int tl = t - NCTX; const int pos = a == 0 ? tl / 64 : tl % 64; const float cs = rope[2 * (pos * 32 + pr)], sn = rope[2 * (pos * 32 + pr) + 1];
            const float o1 = y1 * cs - y2 * sn, o2 = y1 * sn + y2 * cs; y1 = o1; y2 = o2; }
        hp[i1] = (bf16_t)f2bf(y1); hp[i2] = (bf16_t)f2bf(y2);
    }
}
__device__ __forceinline__ void phase_attn_naive(const Ctx& c, int l) {
    const P& p = *c.p;
    const bf16_t* proj = (const bf16_t*)(p.ws + WS_PROJ); bf16_t* mix = (bf16_t*)(p.ws + WS_MIX);
    float* sc = (float*)c.lds + c.wid * TPB;
    const bool with_ctx = l != DEPTH - 1;
    const int nit = with_ctx ? MTOK : NB * SEQ;
    const float scale = 0.08838834764831845f;
    for (int it = blockIdx.x; it < nit; it += gridDim.x) {
        int m; if (with_ctx) m = it; else { const int b = it / SEQ; m = b * TPB + NCTX + (it - b * SEQ); }
        const int b = m / TPB, t = m - b * TPB; const int nk = t < NCTX ? NCTX : TPB;
        const int hq = c.wid, kv = hq >> 2;
        const bf16_t* qp = proj + (size_t)m * NPROJ + hq * 128;
        float* qs = (float*)(c.lds + 140 * 1024) + c.wid * 128;
        { const unsigned w = *(const unsigned*)(qp + 2 * c.lane); qs[2 * c.lane] = bflo(w); qs[2 * c.lane + 1] = bfhi(w); }
        asm volatile("s_waitcnt lgkmcnt(0)" ::: "memory");
        float mx = -1e30f;
        for (int j0 = 0; j0 < nk; j0 += 64) {
            const bf16_t* kp = proj + (size_t)(b * TPB + j0 + c.lane) * NPROJ + 1024 + kv * 128;
            float s = 0.f;
#pragma unroll 4
            for (int d8 = 0; d8 < 16; ++d8) { const u32x4 w = *(const u32x4*)(kp + d8 * 8); const f32x4 qa = *(const f32x4*)(qs + d8 * 8), qb = *(const f32x4*)(qs + d8 * 8 + 4);
                s += qa.x * bflo(w.x) + qa.y * bfhi(w.x) + qa.z * bflo(w.y) + qa.w * bfhi(w.y) + qb.x * bflo(w.z) + qb.y * bfhi(w.z) + qb.z * bflo(w.w) + qb.w * bfhi(w.w); }
            s *= scale; sc[j0 + c.lane] = s; mx = fmaxf(mx, s);
        }
#pragma unroll
        for (int o = 1; o < 64; o <<= 1) mx = fmaxf(mx, __shfl_xor(mx, o));
        float ls = 0.f;
        for (int j0 = 0; j0 < nk; j0 += 64) { const float e = __expf(sc[j0 + c.lane] - mx); sc[j0 + c.lane] = e; ls += e; }
        ls = wave_sum(ls);
        asm volatile("s_waitcnt lgkmcnt(0)" ::: "memory");
        float o0 = 0.f, o1 = 0.f;
        const bf16_t* vp = proj + (size_t)(b * TPB) * NPROJ + 1280 + kv * 128 + 2 * c.lane;
#pragma unroll 4
        for (int j = 0; j < nk; ++j) { const unsigned w = *(const unsigned*)(vp + (size_t)j * NPROJ); const float pj = sc[j]; o0 += pj * bflo(w); o1 += pj * bfhi(w); }
        const float inv = 1.f / ls;
        const unsigned gw_ = *(const unsigned*)(proj + (size_t)m * NPROJ + 1536 + hq * 128 + 2 * c.lane);
        *(unsigned*)(mix + (size_t)m * DM + hq * 128 + 2 * c.lane) = pk2(o0 * inv * bflo(gw_), o1 * inv * bfhi(gw_));
        asm volatile("s_waitcnt lgkmcnt(0)" ::: "memory");
    }
}


__device__ __forceinline__ void phase_attn(const Ctx& c, int l) {
    const P& p = *c.p;
    const bf16_t* proj = (const bf16_t*)(p.ws + WS_PROJ); bf16_t* mix = (bf16_t*)(p.ws + WS_MIX);
    const int G = gridDim.x, bid = blockIdx.x; const int vcu = (G % 8 == 0) ? (bid % 8) * (G / 8) + bid / 8 : bid;
    const int nu = 512 + (l != DEPTH - 1 ? 32 : 0);
    for (int u = vcu; u < nu; u += G) {
        int b, hq, row0, seq;
        if (u < 512) { const int qb = u & 15, hql = (u >> 4) & 3, kvh = (u >> 6) & 1; b = u >> 7; hq = kvh * 4 + hql; row0 = b * TPB + NCTX + qb * 256; seq = TPB; }
        else { const int v = u - 512; b = v >> 3; hq = v & 7; row0 = b * TPB; seq = NCTX; }
        const int kv = hq >> 2;
        const bf16_t* kvb = proj + (size_t)b * TPB * NPROJ;
        attn::attn_dense_body<bf16_t>(proj + (size_t)row0 * NPROJ + hq * 128, kvb + 1024 + kv * 128, kvb + 1280 + kv * 128,
                                      mix + (size_t)row0 * DM + hq * 128, proj + (size_t)row0 * NPROJ + 1536 + hq * 128, seq, (char*)c.lds, c.tid);
        __syncthreads();
    }
}

__device__ __forceinline__ void phase_final(const Ctx& c) {
    const P& p = *c.p; const float* g = p.in[26];
    for (int m0 = 2 * c.gw; m0 < NB * SEQ; m0 += 2 * c.ngw) {
        f32x4 v[2][4];
#pragma unroll
        for (int rr = 0; rr < 2; ++rr)
#pragma unroll
            for (int j = 0; j < 4; ++j) v[rr][j] = *(const f32x4*)(p.out + (size_t)(m0 + rr) * DM + 4 * c.lane + 256 * j);
#pragma unroll
        for (int rr = 0; rr < 2; ++rr) { float* xr = p.out + (size_t)(m0 + rr) * DM; float ss = 0.f;
#pragma unroll
            for (int j = 0; j < 4; ++j) ss += v[rr][j].x * v[rr][j].x + v[rr][j].y * v[rr][j].y + v[rr][j].z * v[rr][j].z + v[rr][j].w * v[rr][j].w;
            const float rstd = rsqrtf(wave_sum(ss) * (1.f / DM) + EPS);
#pragma unroll
            for (int j = 0; j < 4; ++j) { const f32x4 gv = *(const f32x4*)(g + 4 * c.lane + 256 * j); *(f32x4*)(xr + 4 * c.lane + 256 * j) = v[rr][j] * rstd * gv; } }
    }
}

enum { K_PREP_A, K_PREP_B, K_IN, K_EVENMIX, K_S5COMB, K_GLU, K_OUT, K_XPREP, K_HEADNORM, K_ATTN, K_FINAL };
#ifdef DUP_PH
constexpr int NPH = 20, NPHT = 19;
#else
constexpr int NPH = 19, NPHT = 19;
#endif
__device__ __forceinline__ void phase_decode(int ph, int& kind, int& layer) {
    constexpr int kinds[NPHT] = {K_PREP_A, K_PREP_B,
        K_IN, K_EVENMIX, K_S5COMB, K_GLU, K_OUT,
        K_IN, K_ATTN, K_OUT,
        K_IN, K_EVENMIX, K_S5COMB, K_GLU, K_OUT,
        K_IN, K_ATTN, K_OUT, K_FINAL};
    constexpr int layers[NPHT] = {0, 0, 0, 0, 0, 0, 0, 1, 1, 1, 2, 2, 2, 2, 2, 3, 3, 3, 0};
#ifdef DUP_PH
    if (ph > DUP_PH) --ph;
#endif
    kind = kinds[ph]; layer = layers[ph];
}

template <int ONLY> __device__ __forceinline__ void mega_body(const P& p) {
    extern __shared__ __attribute__((aligned(16))) unsigned char lds[];
    const int wave_u = __builtin_amdgcn_readfirstlane((int)threadIdx.x >> 6);
    if (threadIdx.x == 0) { volatile LAS unsigned long long* tab = (volatile LAS unsigned long long*)((LAS unsigned char*)lds + TAB_OFF);
#pragma unroll
        for (int i = 0; i < 27; ++i) tab[i] = (unsigned long long)p.in[i];
        tab[27] = (unsigned long long)p.out; tab[28] = (unsigned long long)p.ws; }
    if (threadIdx.x < 2) ((volatile LAS unsigned*)((LAS unsigned char*)lds + TAB_OFF + 240))[threadIdx.x] = 0u;
    __syncthreads();
    XcdBarrier bar = xcd_barrier_post((unsigned*)(p.ws + WS_CTL), (volatile LAS unsigned*)((LAS unsigned char*)lds + TAB_OFF + 240));
    for (int ph = p.ph_lo; ph < p.ph_hi; ++ph) {
        int kind, l; phase_decode(ph, kind, l);
        if (ONLY >= 0 && kind != ONLY) continue;
        unsigned z_ = 0u; asm volatile("" : "+v"(z_));
        int tid_ = (wave_u << 6) | (int)__builtin_amdgcn_mbcnt_hi(~0u, __builtin_amdgcn_mbcnt_lo(~0u, z_));
        P q;
        { unsigned tbo = TAB_OFF; asm volatile("" : "+v"(tbo));
          const volatile LAS unsigned* tab = (const volatile LAS unsigned*)((LAS unsigned char*)lds + tbo);
#pragma unroll
          for (int i = 0; i < 27; ++i) { const unsigned lo = __builtin_amdgcn_readfirstlane(tab[2 * i]), hi = __builtin_amdgcn_readfirstlane(tab[2 * i + 1]); q.in[i] = (const float*)(const __attribute__((address_space(1))) float*)(((unsigned long long)hi << 32) | lo); }
          { const unsigned lo = __builtin_amdgcn_readfirstlane(tab[54]), hi = __builtin_amdgcn_readfirstlane(tab[55]); q.out = (float*)(__attribute__((address_space(1))) float*)(((unsigned long long)hi << 32) | lo); }
          { const unsigned lo = __builtin_amdgcn_readfirstlane(tab[56]), hi = __builtin_amdgcn_readfirstlane(tab[57]); q.ws = (unsigned char*)(__attribute__((address_space(1))) unsigned char*)(((unsigned long long)hi << 32) | lo); }
          q.ph_lo = p.ph_lo; q.ph_hi = p.ph_hi; }
        Ctx c; c.p = &q; c.tid = tid_; c.wid = wave_u; c.lane = c.tid & 63; c.gw = blockIdx.x * NWAVES + c.wid; c.ngw = gridDim.x * NWAVES; c.lds = lds;
        switch (kind) {
            case K_PREP_A: phase_prep_a(c); phase_s5prep(c); break;
            case K_PREP_B: phase_bias(c); phase_xprep(c, 0, q.in[0], q.in[2]); phase_transposes(c);
#if defined(DUPX) && DUPX == 4
                phase_bias(c);
#elif defined(DUPX) && DUPX == 5
                phase_xprep(c, 0, q.in[0], q.in[2]);
#elif defined(DUPX) && DUPX == 6
                phase_transposes(c);
#endif
                break;
            case K_IN: phase_in(c, l); break;
#ifdef USE_S5
#ifdef USE_GMLP
            case K_EVENMIX:
                phase_s5_fast<false>(c, l);
#if defined(DUPX) && DUPX == 2
                phase_s5_fast<false>(c, l);
#endif
                break;
#else
            case K_EVENMIX: phase_gmlp(c, l); phase_s5_fast<false>(c, l); break;
#endif
            case K_S5COMB: phase_s5_fast<true>(c, l); break;
#else
#ifdef USE_GMLP
            case K_EVENMIX: phase_gmlp_fast(c, l, 0, (int)gridDim.x); phase_s5_naive(c, l); break;
#else
            case K_EVENMIX: phase_gmlp(c, l); phase_s5_naive(c, l); break;
#endif
            case K_S5COMB: phase_s5comb(c, l); break;
#endif
            case K_GLU: phase_glu(c, l); break;
            case K_OUT: phase_out(c, l); break;
            case K_XPREP: phase_xprep(c, l, q.out, (const float*)(q.ws + WS_CTXRES)); break;
            case K_HEADNORM: phase_headnorm(c, l); break;
#ifdef USE_ATTN
            case K_ATTN: phase_attn(c, l); break;
#else
            case K_ATTN: phase_attn_naive(c, l); break;
#endif
            case K_FINAL: phase_final(c); break;
        }
        if (ph + 1 < p.ph_hi) xcd_barrier(bar);
    }
}

__global__ void __launch_bounds__(NTHREADS) k_mega(P p) { mega_body<-1>(p); }
#ifdef PERKIND
template <int KIND> __global__ void __launch_bounds__(NTHREADS) k_one(P p) { mega_body<KIND>(p); }
template __global__ void k_one<0>(P); template __global__ void k_one<1>(P); template __global__ void k_one<2>(P); template __global__ void k_one<3>(P); template __global__ void k_one<4>(P); template __global__ void k_one<5>(P);
template __global__ void k_one<6>(P); template __global__ void k_one<7>(P); template __global__ void k_one<8>(P); template __global__ void k_one<9>(P); template __global__ void k_one<10>(P);
#endif


extern "C" void kernel_launch(void* const* d_in, const int* in_sizes, int n_in, void* d_out, int out_size, void* d_ws, size_t ws_size, hipStream_t stream) {
    static int grid = 0;
    if (grid == 0) {
        if (n_in != 27 || out_size != NB * SEQ * DM || ws_size < WS_END) { fprintf(stderr, "kernel_launch: unexpected shapes n_in %d out %d ws %zu\n", n_in, out_size, ws_size); grid = -1; return; }
        int dev = 0, cus = 0, per_cu = 0;
        hipGetDevice(&dev); hipDeviceGetAttribute(&cus, hipDeviceAttributeMultiprocessorCount, dev);
        hipFuncSetAttribute((const void*)k_mega, hipFuncAttributeMaxDynamicSharedMemorySize, LDS_BYTES);
        hipOccupancyMaxActiveBlocksPerMultiprocessor(&per_cu, (const void*)k_mega, NTHREADS, LDS_BYTES);
        if (per_cu < 1) { fprintf(stderr, "kernel_launch: occupancy query says %d blocks per CU\n", per_cu); per_cu = 1; }
        grid = cus * 1;
        fprintf(stderr, "kernel_launch: cus %d per_cu %d grid %d\n", cus, per_cu, grid);
    }
    if (grid < 0) return;
    hipMemsetAsync((char*)d_ws + WS_CTL, 0, 16384, stream);
    P p{};
    for (int i = 0; i < 27; ++i) p.in[i] = (const float*)d_in[i];
    p.out = (float*)d_out; p.ws = (unsigned char*)d_ws;
#ifdef ONE_LAUNCH
    p.ph_lo = 0; p.ph_hi = NPH;
    void* args[] = {&p};
    hipError_t e = hipLaunchCooperativeKernel((void*)k_mega, dim3(grid), dim3(NTHREADS), args, LDS_BYTES, stream);
    if (e != hipSuccess) fprintf(stderr, "cooperative launch failed: %s\n", hipGetErrorString(e));
#else
    for (int ph = 0; ph < NPH; ++ph) {
        p.ph_lo = ph; p.ph_hi = ph + 1;
        hipLaunchKernelGGL(k_mega, dim3(grid), dim3(NTHREADS), LDS_BYTES, stream, p);
    }
#endif
}
```

```cpp
#include <hip/hip_runtime.h>
#include <hip/hip_cooperative_groups.h>
#include <cstdio>
#include <cstdint>
namespace cg = cooperative_groups;
#define ONE_LAUNCH 1
#define USE_PG8 1
#define USE_ATTN 1
#define USE_S5 1
#define USE_GMLP 1

constexpr int DM = 1024, NB = 4, SEQ = 4096, NCTX = 256, TPB = NCTX + SEQ, MTOK = NB * TPB;
constexpr int NPROJ = 2560, DEPTH = 4;
constexpr float EPS = 1e-6f;
constexpr int NTHREADS = 512, NWAVES = 8;
constexpr int TAB_OFF = 147456, LDS_BYTES = TAB_OFF + 512;

typedef unsigned short bf16_t;
typedef short bf16x8 __attribute__((ext_vector_type(8)));
typedef float f32x4 __attribute__((ext_vector_type(4)));
typedef unsigned u32x2 __attribute__((ext_vector_type(2)));
typedef unsigned u32x4 __attribute__((ext_vector_type(4)));

constexpr size_t MiB = 1u << 20;
constexpr size_t WS_CTL = 0;
constexpr size_t WS_MODS = 1 * MiB;
constexpr size_t WS_BIAS = 1 * MiB + 512 * 1024;
constexpr size_t WS_RSS = 2 * MiB;
constexpr size_t WS_ROPE = 3 * MiB + 512 * 1024;
constexpr size_t WS_CTXRES = 4 * MiB;
constexpr size_t WS_WIN = 8 * MiB;
constexpr size_t WS_WOUT = 28 * MiB;
constexpr size_t WS_WGLU = 36 * MiB;
constexpr size_t WS_XM = 38 * MiB;
constexpr size_t WS_PROJ = 72 * MiB;
constexpr size_t WS_MIX = 157 * MiB;
constexpr size_t WS_YG = 191 * MiB;
constexpr size_t WS_S5 = 208 * MiB;
constexpr size_t WS_VST = WS_S5 + 14 * MiB;
constexpr size_t WS_XB = 224 * MiB;
constexpr size_t WS_END = 256 * MiB;

struct P {
    const float* in[27];
    float* out;
    unsigned char* ws;
    int ph_lo, ph_hi;
};

__device__ __forceinline__ unsigned f2bf(float f) { unsigned u = __builtin_bit_cast(unsigned, f); return (u + 0x7fffu + ((u >> 16) & 1u)) >> 16; }
typedef float f32x2_t __attribute__((ext_vector_type(2))); typedef __bf16 bf16x2_t __attribute__((ext_vector_type(2)));
__device__ __forceinline__ unsigned pk2(float lo, float hi) { const f32x2_t v = {lo, hi}; const bf16x2_t b = __builtin_convertvector(v, bf16x2_t); return __builtin_bit_cast(unsigned, b); }
__device__ __forceinline__ float bf2f(unsigned short h) { return __builtin_bit_cast(float, (unsigned)h << 16); }
__device__ __forceinline__ float bflo(unsigned w) { return __builtin_bit_cast(float, w << 16); }
__device__ __forceinline__ float bfhi(unsigned w) { return __builtin_bit_cast(float, w & 0xffff0000u); }
__device__ __forceinline__ float wave_sum(float v) {
#pragma unroll
    for (int o = 1; o < 64; o <<= 1) v += __shfl_xor(v, o);
    return v;
}
__device__ __forceinline__ float silu_f(float x) { return x * __builtin_amdgcn_rcpf(1.f + __expf(-x)); }
__device__ __forceinline__ float sigmoid_f(float x) { return __builtin_amdgcn_rcpf(1.f + __expf(-x)); }
__device__ __forceinline__ float gelu_tanh_f(float x) {
    const float u2 = 1.5957691216057308f * (x + 0.044715f * x * x * x);
    return x * __builtin_amdgcn_rcpf(1.f + __expf(-u2));
}
__host__ __device__ __forceinline__ int hd_logical(int h) { return (h & 0x40) | ((h & 0x04) << 3) | ((h & 0x38) >> 1) | (h & 0x03); }
__device__ __forceinline__ int in_col_logical(int l, int n) { return ((l & 1) && n < 1280) ? ((n & ~127) | hd_logical(n & 127)) : n; }
__device__ __forceinline__ int cond_row(int m) { const int b = m / TPB, t = m - b * TPB; return t < NCTX ? 4 : b; }
__device__ __forceinline__ size_t res_off(int m, bool& is_ctx) { const int b = m / TPB, t = m - b * TPB; is_ctx = t < NCTX; return is_ctx ? (size_t)(b * NCTX + t) * DM : (size_t)(b * SEQ + t - NCTX) * DM; }

struct Ctx {
    const P* p; int tid, wid, lane, gw, ngw;
    unsigned char* lds;
};

namespace pg8 {
#define PG8_LAS __attribute__((address_space(3)))
typedef unsigned short bf16_t;
typedef short bf16x8 __attribute__((ext_vector_type(8)));
typedef float f32x4 __attribute__((ext_vector_type(4)));
typedef unsigned u32x4 __attribute__((ext_vector_type(4)));
constexpr int BM = 256, BK = 64, HALF = 128, HTB = HALF * BK * 2  , STAGE_BYTES = 8 * HTB, NXCD = 8, WGM = 8;

__host__ __device__ __forceinline__ int lds_byte(int r, int c) { const int st = (r >> 4) * 2 + (c >> 5), rr = r & 15, cc = c & 31, ob = rr * 64 + cc * 2; return st * 1024 + (ob ^ (((ob >> 9) & 1) << 5)); }
__host__ __device__ __forceinline__ void stage_rc(int b, int& R, int& C) { const int st = b / 1024, sb = b % 1024, swz = sb ^ (((sb >> 9) & 1) << 5); R = (st >> 1) * 16 + swz / 64; C = (st & 1) * 32 + (swz % 64) / 2; }
__host__ __device__ __forceinline__ int perm32(int rho) { const int n = rho >> 4, i = rho & 15; return 8 * (i >> 2) + 4 * n + (i & 3); }

struct Unit { int pm, pn; };
struct Gemm { const bf16_t* A; const bf16_t* Bt; int M, N, K; };

struct StaticOrder {
    int nM, nN, nwg, G, c;
    __host__ __device__ void init(int M, int N, int G_, int c_) { nM = M / BM; nN = N / BM; nwg = nM * nN; G = G_; c = c_; }
    __host__ __device__ bool next(int i, Unit& u) const {
        const long L = (long)i * G + c; if (L >= nwg) return false;
        int wgid = (int)L; { const int q = nwg / NXCD, r = nwg % NXCD, xcd = wgid % NXCD, off = wgid / NXCD; wgid = (xcd < r ? xcd * (q + 1) : r * (q + 1) + (xcd - r) * q) + off; }
        const int nig = WGM * nN, gid = wgid / nig, fm = gid * WGM, gsz = (nM - fm) < WGM ? (nM - fm) : WGM;
        u.pm = fm + ((wgid % nig) % gsz); u.pn = (wgid % nig) / gsz; return true;
    }
    __device__ __forceinline__ void a_ready(const Unit&) const {}
    __device__ __forceinline__ void done(const Unit&) const {}
};

__device__ __forceinline__ unsigned cvt_pk_bf16(float lo, float hi) { unsigned r; asm volatile("v_cvt_pk_bf16_f32 %0, %1, %2" : "=v"(r) : "v"(lo), "v"(hi)); return r; }
template <class Epi, class Sched, bool ALIGN_EPI = false, bool SP2 = false>
__device__ __forceinline__ void gemm_phase(PG8_LAS unsigned char* lds, const Gemm g, const Sched& S, const Epi& E, const int tid) {
    const int wid = __builtin_amdgcn_readfirstlane(tid >> 6), lane = tid & 63, wr = wid >> 2, wc = wid & 3, fr = lane & 15, fq = lane >> 4;
    const int K = g.K, nt = K / BK;
    unsigned voffA[2], voffB[2];
#pragma unroll
    for (int i = 0; i < 2; ++i) { int R, C; stage_rc(tid * 16 + i * 8192, R, C); const int Rb = Epi::PERM ? ((R & ~31) + perm32(R & 31)) : R;
        voffA[i] = (unsigned)(R * K + C) * 2u; voffB[i] = (unsigned)(Rb * K + C) * 2u; }
    const size_t kstep = (size_t)(BK * 2);
    const size_t hstep = (size_t)HALF * K * 2;
    const size_t tstep = 2 * hstep;
    const unsigned ldsw = (unsigned)wid * 1024u;
    const int aoff = lds_byte(wr * 64 + fr, fq * 8), boff = lds_byte(wc * 32 + fr, fq * 8);
#define PG8_SA(b, h) (((b) * 2 + (h)) * HTB)
#define PG8_SB(b, h) ((4 + (b) * 2 + (h)) * HTB)
#define PG8_STAGE(bufoff, gbase, voff) do { _Pragma("unroll") for (int _i = 0; _i < 2; ++_i) \
        __builtin_amdgcn_global_load_lds((const unsigned*)((const char*)(gbase) + (voff)[_i]), (PG8_LAS unsigned*)(lds + (bufoff) + ldsw + _i * 8192), 16, 0, 0); } while (0)
#define PG8_LDA(dst, b, h) do { _Pragma("unroll") for (int m = 0; m < 4; ++m) _Pragma("unroll") for (int k = 0; k < 2; ++k) dst[m][k] = *(const PG8_LAS bf16x8*)(lds + PG8_SA(b, h) + aoff + m * 2048 + k * 1024); } while (0)
#define PG8_LDB(dst, b, h) do { _Pragma("unroll") for (int n = 0; n < 2; ++n) _Pragma("unroll") for (int k = 0; k < 2; ++k) dst[n][k] = *(const PG8_LAS bf16x8*)(lds + PG8_SB(b, h) + boff + n * 2048 + k * 1024); } while (0)
#define PG8_MMA(ai, bj, At, Bt) do { __builtin_amdgcn_s_setprio(1); _Pragma("unroll") for (int m = 0; m < 4; ++m) _Pragma("unroll") for (int n = 0; n < 2; ++n) _Pragma("unroll") for (int k = 0; k < 2; ++k) \
        acc[ai][bj][m][n] = __builtin_amdgcn_mfma_f32_16x16x32_bf16(Bt[n][k], At[m][k], acc[ai][bj][m][n], 0, 0, 0); __builtin_amdgcn_s_setprio(0); } while (0)
#define PG8_WAIT_V(n) asm volatile("s_waitcnt vmcnt(" #n ")" ::: "memory")
#define PG8_WAIT_L(n) asm volatile("s_waitcnt lgkmcnt(" #n ")" ::: "memory")
#define PG8_BAR __builtin_amdgcn_s_barrier()
#define PG8_SCHED __builtin_amdgcn_sched_barrier(0)
    Unit cur, nxt; int ui = 0;
    if (!S.next(0, cur)) return;
    f32x4 acc[2][2][4][2];
#pragma unroll
    for (int a = 0; a < 2; ++a)
#pragma unroll
        for (int b = 0; b < 2; ++b)
#pragma unroll
            for (int m = 0; m < 4; ++m)
#pragma unroll
                for (int n = 0; n < 2; ++n) acc[a][b][m][n] = (f32x4){0.f, 0.f, 0.f, 0.f};
    bf16x8 At[4][2], B0[2][2], B1[2][2];
    const char* cA = (const char*)g.A + (size_t)cur.pm * tstep; const char* cB = (const char*)g.Bt + (size_t)cur.pn * tstep;
    S.a_ready(cur);
    if constexpr (SP2) {
        PG8_STAGE(PG8_SB(0, 0), cB, voffB); PG8_STAGE(PG8_SB(0, 1), cB + hstep, voffB); PG8_STAGE(PG8_SA(0, 0), cA, voffA); PG8_STAGE(PG8_SA(0, 1), cA + hstep, voffA);
        if (wr == 1) PG8_BAR;
        PG8_WAIT_V(2); PG8_BAR;
        PG8_STAGE(PG8_SB(1, 0), cB + kstep, voffB); PG8_STAGE(PG8_SA(1, 0), cA + kstep, voffA); PG8_STAGE(PG8_SB(1, 1), cB + hstep + kstep, voffB);
        PG8_WAIT_V(6); PG8_BAR;
    } else {
        PG8_STAGE(PG8_SB(0, 0), cB, voffB); PG8_STAGE(PG8_SA(0, 0), cA, voffA); PG8_STAGE(PG8_SB(0, 1), cB + hstep, voffB); PG8_STAGE(PG8_SA(0, 1), cA + hstep, voffA);
        if (wr == 1) PG8_BAR;
        PG8_WAIT_V(4); PG8_BAR;
        PG8_STAGE(PG8_SB(1, 0), cB + kstep, voffB); PG8_STAGE(PG8_SA(1, 0), cA + kstep, voffA); PG8_STAGE(PG8_SB(1, 1), cB + hstep + kstep, voffB);
        PG8_WAIT_V(6); PG8_BAR;
    }
    for (;;) {
        const bool has_next = S.next(ui + 1, nxt);
        const char* nA = has_next ? (const char*)g.A + (size_t)nxt.pm * tstep : cA; const char* nB = has_next ? (const char*)g.Bt + (size_t)nxt.pn * tstep : cB;
        for (int t = 0; t < nt; t += 2) {
            const bool last = (t == nt - 2);
            const char* a1 = cA + (size_t)(t + 1) * kstep;
            const char* a2 = last ? nA : cA + (size_t)(t + 2) * kstep; const char* b2 = last ? nB : cB + (size_t)(t + 2) * kstep;
            const char* a3 = a2 + kstep; const char* b3 = b2 + kstep;
            if (last && has_next) S.a_ready(nxt);
            if constexpr (SP2) {
            PG8_LDB(B0, 0, 0); PG8_LDB(B1, 0, 1); PG8_SCHED; PG8_LDA(At, 0, 0); PG8_STAGE(PG8_SA(1, 1), a1 + hstep, voffA);
            PG8_WAIT_V(8); PG8_WAIT_L(0); PG8_BAR; PG8_MMA(0, 0, At, B0); PG8_MMA(0, 1, At, B1); PG8_BAR; PG8_SCHED;
            PG8_LDA(At, 0, 1); PG8_STAGE(PG8_SB(0, 0), b2, voffB); PG8_STAGE(PG8_SB(0, 1), b2 + hstep, voffB); PG8_STAGE(PG8_SA(0, 0), a2, voffA);
            PG8_WAIT_V(8); PG8_WAIT_L(0); PG8_BAR; PG8_MMA(1, 0, At, B0); PG8_MMA(1, 1, At, B1); PG8_BAR; PG8_SCHED;
            PG8_LDB(B0, 1, 0); PG8_LDB(B1, 1, 1); PG8_SCHED; PG8_LDA(At, 1, 0); PG8_STAGE(PG8_SA(0, 1), a2 + hstep, voffA);
            PG8_WAIT_V(8); PG8_WAIT_L(0); PG8_BAR; PG8_MMA(0, 0, At, B0); PG8_MMA(0, 1, At, B1); PG8_BAR; PG8_SCHED;
            PG8_LDA(At, 1, 1); PG8_STAGE(PG8_SB(1, 0), b3, voffB); PG8_STAGE(PG8_SB(1, 1), b3 + hstep, voffB); PG8_STAGE(PG8_SA(1, 0), a3, voffA);
            PG8_WAIT_V(8); PG8_WAIT_L(0); PG8_BAR; PG8_MMA(1, 0, At, B0); PG8_MMA(1, 1, At, B1); PG8_BAR; PG8_SCHED;
            } else {
            PG8_LDB(B0, 0, 0); PG8_SCHED; PG8_LDA(At, 0, 0); PG8_STAGE(PG8_SA(1, 1), a1 + hstep, voffA);
            PG8_WAIT_L(8); PG8_BAR; PG8_WAIT_L(0); PG8_MMA(0, 0, At, B0); PG8_BAR; PG8_SCHED;
            PG8_LDB(B1, 0, 1); PG8_STAGE(PG8_SB(0, 0), b2, voffB);
            PG8_BAR; PG8_WAIT_L(0); PG8_MMA(0, 1, At, B1); PG8_BAR;
            PG8_LDA(At, 0, 1); PG8_STAGE(PG8_SA(0, 0), a2, voffA);
            PG8_BAR; PG8_WAIT_L(0); PG8_MMA(1, 0, At, B0); PG8_BAR; PG8_SCHED;
            PG8_STAGE(PG8_SB(0, 1), b2 + hstep, voffB);
            PG8_WAIT_V(6); PG8_BAR; PG8_MMA(1, 1, At, B1); PG8_BAR;
            PG8_LDB(B0, 1, 0); PG8_SCHED; PG8_LDA(At, 1, 0); PG8_STAGE(PG8_SA(0, 1), a2 + hstep, voffA);
            PG8_WAIT_L(8); PG8_BAR; PG8_WAIT_L(0); PG8_MMA(0, 0, At, B0); PG8_BAR; PG8_SCHED;
            PG8_LDB(B1, 1, 1); PG8_STAGE(PG8_SB(1, 0), b3, voffB);
            PG8_BAR; PG8_WAIT_L(0); PG8_MMA(0, 1, At, B1); PG8_BAR;
            PG8_LDA(At, 1, 1); PG8_STAGE(PG8_SA(1, 0), a3, voffA);
            PG8_BAR; PG8_WAIT_L(0); PG8_MMA(1, 0, At, B0); PG8_BAR; PG8_SCHED;
            PG8_STAGE(PG8_SB(1, 1), b3 + hstep, voffB);
            PG8_WAIT_V(6); PG8_BAR; PG8_MMA(1, 1, At, B1); PG8_BAR;
            }
        }
        if constexpr (ALIGN_EPI) { if (wr == 0) PG8_BAR; }
        if constexpr (!Epi::AFTER_DRAIN) { E(acc, cur, wr, wc, fr, fq); S.done(cur); }
        if (!has_next) break;
#pragma unroll
        for (int a = 0; a < 2; ++a)
#pragma unroll
            for (int b = 0; b < 2; ++b)
#pragma unroll
                for (int m = 0; m < 4; ++m)
#pragma unroll
                    for (int n = 0; n < 2; ++n) acc[a][b][m][n] = (f32x4){0.f, 0.f, 0.f, 0.f};
        cur = nxt; cA = nA; cB = nB; ++ui;
        if constexpr (ALIGN_EPI) { if (wr == 1) PG8_BAR; }
    }
    PG8_WAIT_V(0);
    if constexpr (!ALIGN_EPI) { if (wr == 0) PG8_BAR; }
    PG8_BAR;
    if constexpr (Epi::AFTER_DRAIN) { E.fused(acc, cur, wr, wc, fr, fq, lds, wid, lane); S.done(cur); }
#undef PG8_SA
#undef PG8_SB
#undef PG8_STAGE
#undef PG8_LDA
#undef PG8_LDB
#undef PG8_MMA
#undef PG8_WAIT_V
#undef PG8_WAIT_L
#undef PG8_BAR
#undef PG8_SCHED
}
}

namespace attn {
constexpr int   D = 128, NW = 8, QBLK = 32, KVBLK = 64;
constexpr float SCALE = 0.088388347648318440f;
#ifndef ATTN_THR
#define ATTN_THR 8.f
#endif
constexpr float THR = ATTN_THR;
constexpr int SDEPTH = 2;
constexpr int LDQ = 2560, LDK = 2560, LDO = 1024, LDG = 2560;
constexpr size_t SHM_V = KVBLK * D * 2, SHM_K = KVBLK * D * 2, SHM_ATTN = 2 * SHM_V + 2 * SHM_K + NW * 64 * 4;
using bf16 = unsigned short;
using bf16x8 = __attribute__((ext_vector_type(8))) short;
using s16x4  = __attribute__((ext_vector_type(4))) short;
using f32x16 = __attribute__((ext_vector_type(16))) float;
using f32x8  = __attribute__((ext_vector_type(8))) float;
using u32x4  = __attribute__((ext_vector_type(4))) unsigned;
#define KSWZ(row, colB) ((row) * 256 + ((colB) ^ (((row) & 7) << 4)))
#define SBAR() __builtin_amdgcn_sched_barrier(0)
__device__ __forceinline__ int crow(int r, int hi) { return (r & 3) + 8 * (r >> 2) + 4 * hi; }
__device__ __forceinline__ unsigned cvtpk(float lo, float hi) {
  unsigned r; asm volatile("v_cvt_pk_bf16_f32 %0, %1, %2" : "=v"(r) : "v"(lo), "v"(hi)); return r;
}
template <typename TIn> struct Stage;
template <> struct Stage<bf16>  { using T = bf16x8;
  __device__ static __forceinline__ T ld8(const bf16* p) { return *reinterpret_cast<const bf16x8*>(p); }
  __device__ static __forceinline__ bf16x8 tobf(T x) { return x; } };
template <> struct Stage<float> { using T = f32x8;
  __device__ static __forceinline__ T ld8(const float* p) { return *reinterpret_cast<const f32x8*>(p); }
  __device__ static __forceinline__ bf16x8 tobf(T x) {
    u32x4 w = {cvtpk(x[0], x[1]), cvtpk(x[2], x[3]), cvtpk(x[4], x[5]), cvtpk(x[6], x[7])}; return *reinterpret_cast<bf16x8*>(&w); } };

__device__ __forceinline__ void partialSM(f32x16& p0, f32x16& p1, float& m_reg, float& mn, float& alpha) {
  constexpr float C = SCALE * 1.4426950408889634f;
  float pmax = p0[0]; for (int r = 1; r < 16; ++r) pmax = fmaxf(pmax, p0[r]); for (int r = 0; r < 16; ++r) pmax = fmaxf(pmax, p1[r]);
  { auto rr = __builtin_amdgcn_permlane32_swap(__float_as_uint(pmax), __float_as_uint(pmax), false, false);
    pmax = fmaxf(__uint_as_float(rr[0]), __uint_as_float(rr[1])); }
  if (__builtin_expect(__all(pmax - m_reg <= THR / SCALE), 1)) { mn = m_reg; alpha = 1.f; }
  else { mn = fmaxf(m_reg, pmax); alpha = __builtin_amdgcn_exp2f((m_reg - mn) * C); m_reg = mn; }
  float mnC = -mn * C;
  for (int r = 0; r < 16; ++r) p0[r] = fmaf(p0[r], C, mnC); for (int r = 0; r < 16; ++r) p1[r] = fmaf(p1[r], C, mnC);
  for (int r = 0; r < 16; ++r) p0[r] = __builtin_amdgcn_exp2f(p0[r]);
}
__device__ __forceinline__ void finishSM(f32x16& p0, f32x16& p1, float alpha, float& l_reg, bf16x8& pa0, bf16x8& pa1, bf16x8& pa2, bf16x8& pa3) {
  for (int r = 0; r < 16; ++r) p1[r] = __builtin_amdgcn_exp2f(p1[r]);
  float ps = 0; for (int r = 0; r < 16; ++r) ps += p0[r]; for (int r = 0; r < 16; ++r) ps += p1[r];
  { auto rr = __builtin_amdgcn_permlane32_swap(__float_as_uint(ps), __float_as_uint(ps), false, false);
    ps = __uint_as_float(rr[0]) + __uint_as_float(rr[1]); }
  l_reg = l_reg * alpha + ps;
#define PK4(P, BASE, OUT) do { unsigned a0 = cvtpk(P[BASE + 0], P[BASE + 1]), a1 = cvtpk(P[BASE + 2], P[BASE + 3]);   \
    unsigned b0 = cvtpk(P[BASE + 4], P[BASE + 5]), b1 = cvtpk(P[BASE + 6], P[BASE + 7]);                              \
    auto r0 = __builtin_amdgcn_permlane32_swap(a0, b0, false, false); auto r1 = __builtin_amdgcn_permlane32_swap(a1, b1, false, false); \
    u32x4 w = {r0[0], r1[0], r0[1], r1[1]}; OUT = *reinterpret_cast<bf16x8*>(&w); } while (0)
  PK4(p0, 0, pa0); PK4(p0, 8, pa1); PK4(p1, 0, pa2); PK4(p1, 8, pa3);
#undef PK4
}
__device__ __forceinline__ void qkt(f32x16& p0, f32x16& p1, const bf16* Ks, const bf16x8* qr, int r32, int hi) {
  p0 = f32x16{}; p1 = f32x16{};
  for (int d0 = 0; d0 < 8; ++d0) { int cb = (d0 * 16 + hi * 8) * 2;
    bf16x8 b0 = *reinterpret_cast<const bf16x8*>((const char*)Ks + KSWZ(r32, cb));
    bf16x8 b1 = *reinterpret_cast<const bf16x8*>((const char*)Ks + KSWZ(32 + r32, cb));
    p0 = __builtin_amdgcn_mfma_f32_32x32x16_bf16(b0, qr[d0], p0, 0, 0, 0);
    p1 = __builtin_amdgcn_mfma_f32_32x32x16_bf16(b1, qr[d0], p1, 0, 0, 0); }
}
__device__ __forceinline__ int v_st(int k, int c) { const int kk = (k & ~0xC) | ((k & 4) << 1) | ((k & 8) >> 1); return ((kk >> 3) * 4 + (c >> 5)) * 512 + ((kk & 7) * 32 + (c & 31)) * 2; }
__device__ __forceinline__ int v_rd_base(int lane) { return ((lane & 3) << 3) | (((lane >> 2) & 3) << 6) | (((lane >> 4) & 1) << 5) | (((lane >> 5) & 1) << 8); }
constexpr int v_rd_off(int d0, int ks, int half) { return d0 * 512 + ks * 4096 + half * 2048; }
template <int OFF> __device__ __forceinline__ s16x4 tr_read(int vb) {
  s16x4 r; asm volatile("ds_read_b64_tr_b16 %0, %1 offset:%2" : "=&v"(r) : "v"(vb), "i"(OFF) : "memory"); return r;
}
template <int D0> __device__ __forceinline__ void pv_one(f32x16& od, int vb, bf16x8 pa0, bf16x8 pa1, bf16x8 pa2, bf16x8 pa3) {
  const s16x4 l0 = tr_read<v_rd_off(D0, 0, 0)>(vb), h0 = tr_read<v_rd_off(D0, 0, 1)>(vb), l1 = tr_read<v_rd_off(D0, 1, 0)>(vb), h1 = tr_read<v_rd_off(D0, 1, 1)>(vb);
  const s16x4 l2 = tr_read<v_rd_off(D0, 2, 0)>(vb), h2 = tr_read<v_rd_off(D0, 2, 1)>(vb), l3 = tr_read<v_rd_off(D0, 3, 0)>(vb), h3 = tr_read<v_rd_off(D0, 3, 1)>(vb);
  asm volatile("s_waitcnt lgkmcnt(0)" ::: "memory"); SBAR();
#define PK(L, H) (bf16x8){L[0], L[1], L[2], L[3], H[0], H[1], H[2], H[3]}
  od = __builtin_amdgcn_mfma_f32_32x32x16_bf16(pa0, PK(l0, h0), od, 0, 0, 0);
  od = __builtin_amdgcn_mfma_f32_32x32x16_bf16(pa1, PK(l1, h1), od, 0, 0, 0);
  od = __builtin_amdgcn_mfma_f32_32x32x16_bf16(pa2, PK(l2, h2), od, 0, 0, 0);
  od = __builtin_amdgcn_mfma_f32_32x32x16_bf16(pa3, PK(l3, h3), od, 0, 0, 0);
#undef PK
}
__device__ __forceinline__ void pv_d0(f32x16* o, int vb, bf16x8 pa0, bf16x8 pa1, bf16x8 pa2, bf16x8 pa3) {
  pv_one<0>(o[0], vb, pa0, pa1, pa2, pa3); pv_one<1>(o[1], vb, pa0, pa1, pa2, pa3); pv_one<2>(o[2], vb, pa0, pa1, pa2, pa3); pv_one<3>(o[3], vb, pa0, pa1, pa2, pa3);
}

template <typename TQ>
__device__ __forceinline__ void attn_dense_body(const TQ* __restrict__ Qb, const bf16* __restrict__ Kh, const bf16* __restrict__ Vh,
                                                bf16* __restrict__ Ob, const bf16* __restrict__ Gb, int seq, char* lds, const int tid) {
  using St = Stage<bf16>; using SQ = Stage<TQ>;
  const int wid = __builtin_amdgcn_readfirstlane(tid >> 6), lane = tid & 63, r32 = lane & 31, hi = lane >> 5;
  bf16* V_lds = (bf16*)lds; bf16* K_lds = (bf16*)(lds + 2 * SHM_V);
  float* ws = (float*)(lds + 2 * SHM_V + 2 * SHM_K) + wid * 64; float* li_l = ws; float* al_l = ws + 32;
  float m_reg = -1e30f, l_reg = 0; f32x16 o[4] = {}; bf16x8 qr[8];
  const TQ* Qw = Qb + (long)(wid * QBLK + r32) * LDQ + hi * 8;
#pragma unroll
  for (int d0 = 0; d0 < 8; ++d0) qr[d0] = SQ::tobf(SQ::ld8(Qw + d0 * 16));
  const int sr = tid >> 4, sc = (tid & 15) * 8, vst0 = v_st(sr, sc), vst1 = v_st(32 + sr, sc);
  const int vb0 = (int)(uintptr_t)V_lds + v_rd_base(lane);
  struct { typename St::T vs0, vs1, ks0, ks1; } sr_[SDEPTH];
  const unsigned lo0 = (unsigned)(sr * LDK + sc), lo1 = (unsigned)((32 + sr) * LDK + sc);
#define SLOAD(i, k0) do { const bf16* vt_ = Vh + (long)(k0) * LDK; const bf16* kt_ = Kh + (long)(k0) * LDK; sr_[i].vs0 = St::ld8(vt_ + lo0); sr_[i].vs1 = St::ld8(vt_ + lo1); \
    sr_[i].ks0 = St::ld8(kt_ + lo0); sr_[i].ks1 = St::ld8(kt_ + lo1); } while (0)
#define SWRITE(b, i) do { *(bf16x8*)((char*)V_lds + (b) * SHM_V + vst0) = St::tobf(sr_[i].vs0);          \
    *(bf16x8*)((char*)V_lds + (b) * SHM_V + vst1) = St::tobf(sr_[i].vs1); int kc = sc * 2;               \
    *(bf16x8*)((char*)K_lds + (b) * SHM_K + KSWZ(sr, kc)) = St::tobf(sr_[i].ks0);                       \
    *(bf16x8*)((char*)K_lds + (b) * SHM_K + KSWZ(32 + sr, kc)) = St::tobf(sr_[i].ks1); } while (0)
#define SWAIT() do { if constexpr (SDEPTH == 2) asm volatile("s_waitcnt vmcnt(4)" ::: "memory"); else asm volatile("s_waitcnt vmcnt(0)" ::: "memory"); } while (0)
#define RESC(a) do { if (__any((a) < 1.f)) { if (hi == 0) al_l[r32] = (a); asm volatile("s_waitcnt lgkmcnt(0)" ::: "memory"); \
    for (int d = 0; d < 4; ++d) for (int r = 0; r < 16; ++r) o[d][r] *= al_l[crow(r, hi)]; } } while (0)
  f32x16 pA0, pA1, pB0, pB1; float mnA, mnB, alA, alB; bf16x8 pa0, pa1, pa2, pa3; const int NT = seq / KVBLK;
  constexpr int SE = 0, SO = SDEPTH - 1;
  SLOAD(SE, 0); asm volatile("s_waitcnt vmcnt(0)" ::: "memory"); SWRITE(0, SE); __syncthreads();
  qkt(pA0, pA1, K_lds, qr, r32, hi); partialSM(pA0, pA1, m_reg, mnA, alA);
  SLOAD(SO, KVBLK); if constexpr (SDEPTH == 2) { if (2 < NT) SLOAD(SE, 2 * KVBLK); }
  SWAIT(); SWRITE(1, SO); __syncthreads();
  for (int j = 1; j + 1 < NT; j += 2) {
    SBAR(); qkt(pB0, pB1, (bf16*)((char*)K_lds + SHM_K), qr, r32, hi);
    finishSM(pA0, pA1, alA, l_reg, pa0, pa1, pa2, pa3); SBAR();
    SLOAD(SO, (j + SDEPTH) * KVBLK); SBAR();
    pv_d0(o, vb0, pa0, pa1, pa2, pa3); partialSM(pB0, pB1, m_reg, mnB, alB);
    __syncthreads(); SWAIT(); SWRITE(0, SE);
    RESC(alB); __syncthreads();
    SBAR(); qkt(pA0, pA1, K_lds, qr, r32, hi);
    finishSM(pB0, pB1, alB, l_reg, pa0, pa1, pa2, pa3); SBAR();
    if (SDEPTH == 1 || j + 3 < NT) SLOAD(SE, (j + 1 + SDEPTH) * KVBLK); SBAR();
    pv_d0(o, vb0 + (int)SHM_V, pa0, pa1, pa2, pa3); partialSM(pA0, pA1, m_reg, mnA, alA);
    __syncthreads(); SWAIT(); SWRITE(1, SO);
    RESC(alA); __syncthreads();
  }
  SBAR(); qkt(pB0, pB1, (bf16*)((char*)K_lds + SHM_K), qr, r32, hi);
  finishSM(pA0, pA1, alA, l_reg, pa0, pa1, pa2, pa3); SBAR();
  pv_d0(o, vb0, pa0, pa1, pa2, pa3); partialSM(pB0, pB1, m_reg, mnB, alB);
  __syncthreads(); RESC(alB);
  finishSM(pB0, pB1, alB, l_reg, pa0, pa1, pa2, pa3); SBAR();
  pv_d0(o, vb0 + (int)SHM_V, pa0, pa1, pa2, pa3);
  if (hi == 0) li_l[r32] = l_reg; asm volatile("s_waitcnt lgkmcnt(0)" ::: "memory");
  float rli[16];
#pragma unroll
  for (int r = 0; r < 16; ++r) rli[r] = __builtin_amdgcn_rcpf(li_l[crow(r, hi)]);
  __syncthreads();
  { char* ost = lds + wid * 8704;
    int ob = hi * (4 * 272) + r32 * 2; asm volatile("" : "+v"(ob));
    char* osl = ost + ob;
#pragma unroll
    for (int r = 0; r < 16; ++r) { const int orow0 = (r & 3) + 8 * (r >> 2);
#pragma unroll
      for (int d0 = 0; d0 < 4; ++d0) *(bf16*)(osl + orow0 * 272 + d0 * 64) = (bf16)(cvtpk(o[d0][r] * rli[r], 0.f) & 0xffffu); }
    asm volatile("s_waitcnt lgkmcnt(0)" ::: "memory");
    bf16* Ow = Ob + (long)(wid * QBLK) * LDO; const bf16* Gw = Gb + (long)(wid * QBLK) * LDG;
    int ln = lane; asm volatile("" : "+v"(ln));
#pragma unroll 2
    for (int i = 0; i < 8; ++i) { const int id = i * 64 + ln, row = id >> 4, ch = id & 15;
      const u32x4 ov = *(const u32x4*)(ost + row * 272 + ch * 16); const u32x4 gv = *(const u32x4*)(Gw + (long)row * LDG + ch * 8);
      u32x4 w;
#define GMUL(O, G) cvtpk(__builtin_bit_cast(float, (O) << 16) * __builtin_bit_cast(float, (G) << 16), __builtin_bit_cast(float, (O) & 0xffff0000u) * __builtin_bit_cast(float, (G) & 0xffff0000u))
      w.x = GMUL(ov.x, gv.x); w.y = GMUL(ov.y, gv.y); w.z = GMUL(ov.z, gv.z); w.w = GMUL(ov.w, gv.w);
#undef GMUL
      *(u32x4*)(Ow + (long)row * LDO + ch * 8) = w; }
    asm volatile("s_waitcnt lgkmcnt(0)" ::: "memory");
  }
#undef SLOAD
#undef SWRITE
#undef SWAIT
#undef RESC
}

#undef KSWZ
#undef SBAR
}

#define LAS __attribute__((address_space(3)))
#define XB_TMO      128
#define XB_XCNT(j)  (256  + 64 * (j))
#define XB_XSUB(j)  (1280 + 64 * (j))
#define XB_XGEN(j)  (2304 + 64 * (j))
#define XB_TOP      3328
#define XB_TOPGEN   3392
#define XCD_BAR_WORDS 3456
#define XB_SPIN_CAP (1u << 18)

__device__ __forceinline__ unsigned xb_ld(unsigned* p)              { return __hip_atomic_load(p, __ATOMIC_RELAXED, __HIP_MEMORY_SCOPE_AGENT); }
__device__ __forceinline__ unsigned xb_add(unsigned* p, unsigned v) { return __hip_atomic_fetch_add(p, v, __ATOMIC_RELAXED, __HIP_MEMORY_SCOPE_AGENT); }
__device__ __forceinline__ unsigned xb_xcc_id() { return (unsigned)__builtin_amdgcn_s_getreg((3 << 11) | 20) & 0xFu; }
#define XB_SPIN(cond, bar) do { unsigned _sp = 0; while (cond) { __builtin_amdgcn_s_sleep(1); \
    if ((++_sp & 255u) == 0u) { if (xb_ld(&(bar)[XB_TMO])) break; if (_sp > XB_SPIN_CAP) { atomicAdd(&(bar)[XB_TMO], 1u); break; } } } } while (0)

struct XcdBarrier {
    unsigned* bar; unsigned x;
    volatile LAS unsigned* st;
};

__device__ __forceinline__ XcdBarrier xcd_barrier_post(unsigned* bar, volatile LAS unsigned* st) {
    XcdBarrier b; b.bar = bar; b.x = xb_xcc_id(); b.st = st;
    if (threadIdx.x == 0) (void)xb_add(&bar[XB_XCNT(b.x)], 1u);
    return b;
}
__device__ __forceinline__ void xcd_barrier_complete(unsigned* bar, unsigned x, unsigned& nloc, unsigned& nx) {
    const unsigned G = gridDim.x * gridDim.y * gridDim.z;
    unsigned sum, cnt, mine, sp = 0u;
    for (;;) {
        sum = 0u; cnt = 0u; mine = 0u;
#pragma unroll
        for (unsigned j = 0; j < 16; ++j) { const unsigned c = xb_ld(&bar[XB_XCNT(j)]); sum += c; cnt += (c > 0u) ? 1u : 0u; mine = (j == x) ? c : mine; }
        if (sum == G) break;
        __builtin_amdgcn_s_sleep(1);
        if ((++sp & 255u) == 0u) { if (xb_ld(&bar[XB_TMO])) break; if (sp > XB_SPIN_CAP) { atomicAdd(&bar[XB_TMO], 1u); break; } }
    }
    nloc = mine > 0u ? mine : 1u; nx = cnt > 0u ? cnt : 1u;
}

__device__ __forceinline__ void xcd_barrier(const XcdBarrier& b) {
    asm volatile("s_waitcnt vmcnt(0)" ::: "memory");
    __syncthreads();
    if (threadIdx.x == 0) {
        unsigned* bar = b.bar;
        __builtin_amdgcn_s_waitcnt(0);
        unsigned nloc = b.st[0], nx = b.st[1];
        if (nloc == 0u) { xcd_barrier_complete(bar, b.x, nloc, nx); b.st[0] = nloc; b.st[1] = nx; }
        const unsigned old = xb_add(&bar[XB_XSUB(b.x)], 1u);
        const unsigned gen = old / nloc;
        if (old + 1u == (gen + 1u) * nloc) {
            __builtin_amdgcn_fence(__ATOMIC_RELEASE, "agent");
            asm volatile("s_waitcnt vmcnt(0)" ::: "memory");
            const unsigned og = xb_add(&bar[XB_TOP], 1u);
            const unsigned tg = og / nx;
            if (og + 1u == (tg + 1u) * nx) xb_add(&bar[XB_TOPGEN], 1u);
            else XB_SPIN(xb_ld(&bar[XB_TOPGEN]) == tg, bar);
            __builtin_amdgcn_fence(__ATOMIC_ACQUIRE, "agent");
            xb_add(&bar[XB_XGEN(b.x)], 1u);
            asm volatile("s_waitcnt vmcnt(0)" ::: "memory");
        } else {
            XB_SPIN(xb_ld(&bar[XB_XGEN(b.x)]) == gen, bar);
            __builtin_amdgcn_fence(__ATOMIC_ACQUIRE, "agent");
            asm volatile("s_waitcnt vmcnt(0)" ::: "memory");
        }
    }
    __syncthreads();
}

__device__ __forceinline__ void transpose_pair(const float* W0, const float* W1, int K0, int N0, int K1, int N1, bf16_t* WT0, bf16_t* WT1, int item0, int item1, float* scr, int tid, int pb0, int pb1) {
    const int nblk0 = N0 / 64, kb0 = item0 / nblk0, nb0 = item0 % nblk0, k00 = kb0 * 64, n00 = nb0 * 64;
    int k01 = 0, n01 = 0; if (W1) { const int nblk1 = N1 / 64, kb1 = item1 / nblk1, nb1 = item1 % nblk1; k01 = kb1 * 64; n01 = nb1 * 64; }
    float v0[8], v1[8];
#pragma unroll
    for (int i = 0; i < 8; ++i) { const int kk = (tid >> 6) + 8 * i, nn = tid & 63; v0[i] = W0[(size_t)(k00 + kk) * N0 + n00 + nn]; v1[i] = W1 ? W1[(size_t)(k01 + kk) * N1 + n01 + nn] : 0.f; }
    __syncthreads();
#pragma unroll
    for (int i = 0; i < 8; ++i) { const int kk = (tid >> 6) + 8 * i, nn = tid & 63; scr[kk * 65 + nn] = v0[i]; scr[64 * 65 + kk * 65 + nn] = v1[i]; }
    __syncthreads();
    const int n = tid >> 3, c = tid & 7;
    { const int ns = (n00 + n < pb0) ? (hd_logical((n00 + n) & 127) & 63) : n; const float* s = scr + (8 * c) * 65 + ns;
        u32x4 o; o.x = pk2(s[0], s[65]); o.y = pk2(s[2 * 65], s[3 * 65]); o.z = pk2(s[4 * 65], s[5 * 65]); o.w = pk2(s[6 * 65], s[7 * 65]);
        *(u32x4*)(WT0 + (size_t)(n00 + n) * K0 + k00 + 8 * c) = o; }
    if (W1) { const int ns = (n01 + n < pb1) ? (hd_logical((n01 + n) & 127) & 63) : n; const float* s = scr + 64 * 65 + (8 * c) * 65 + ns;
        u32x4 o; o.x = pk2(s[0], s[65]); o.y = pk2(s[2 * 65], s[3 * 65]); o.z = pk2(s[4 * 65], s[5 * 65]); o.w = pk2(s[6 * 65], s[7 * 65]);
        *(u32x4*)(WT1 + (size_t)(n01 + n) * K1 + k01 + 8 * c) = o; }
}
__device__ __forceinline__ void phase_prep_a(const Ctx& c) {
    const P& p = *c.p;
    float* mods = (float*)(p.ws + WS_MODS);
    {
        float* sl = (float*)(c.lds + 32768);
        float* red = (float*)(c.lds + 32768 + 20480);
        for (int e = c.tid; e < 5 * DM; e += NTHREADS) { const int r = e >> 10, k = e & 1023; sl[e] = silu_f(r < 4 ? p.in[1][r * DM + k] : p.in[3][k]); }
        __syncthreads();
        for (int it = blockIdx.x; it < DEPTH * 48; it += gridDim.x) {
            const int l = it / 48, j = (it % 48) * 64 + c.lane;
            const float* w = p.in[5] + (size_t)l * DM * 3072 + (size_t)(c.wid * 128) * 3072 + j;
            float a0 = 0.f, a1 = 0.f, a2 = 0.f, a3 = 0.f, a4 = 0.f;
#pragma unroll 32
            for (int k = 0; k < 128; ++k) { const float wv = w[(size_t)k * 3072]; const int kk = c.wid * 128 + k;
                a0 += sl[kk] * wv; a1 += sl[DM + kk] * wv; a2 += sl[2 * DM + kk] * wv; a3 += sl[3 * DM + kk] * wv; a4 += sl[4 * DM + kk] * wv; }
            float* rw = red + c.wid * 320 + c.lane; rw[0] = a0; rw[64] = a1; rw[128] = a2; rw[192] = a3; rw[256] = a4;
            __syncthreads();
            if (c.tid < 320) { float sum = 0.f;
#pragma unroll
                for (int w8 = 0; w8 < 8; ++w8) sum += red[w8 * 320 + c.tid];
                const int r = c.tid >> 6, jj = (it % 48) * 64 + (c.tid & 63);
                mods[((size_t)l * 5 + r) * 3072 + jj] = sum + p.in[6][l * 3072 + jj]; }
            __syncthreads();
        }
    }
    if (blockIdx.x == gridDim.x - 1) {
        float* rope = (float*)(p.ws + WS_ROPE);
        for (int e = c.tid; e < 64 * 32; e += NTHREADS) { const int pos = e >> 5, pr = e & 31;
            const float freq = powf(10000.f, -(float)pr / 32.f); const float ang = (float)pos * freq; rope[2 * e] = cosf(ang); rope[2 * e + 1] = sinf(ang); }
    }
}

__device__ __forceinline__ void transpose_resolve(const P& p, int it, const float*& W, int& K, int& N, bf16_t*& WT, int& item, int& pbelow) {
    constexpr int I_IN = 16 * 40, I_OUT = 16 * 16, I_GLU = 8 * 8;
    int r = it; pbelow = 0;
    if (r < 4 * I_IN) { const int l = r / I_IN; W = (l & 1) ? p.in[22] + (size_t)(l >> 1) * DM * NPROJ : p.in[7] + (size_t)(l >> 1) * DM * NPROJ; K = DM; N = NPROJ;
        WT = (bf16_t*)(p.ws + WS_WIN) + (size_t)l * NPROJ * DM; item = r % I_IN; pbelow = (l & 1) ? 1280 : 0; return; }
    r -= 4 * I_IN;
    if (r < 4 * I_OUT) { const int l = r / I_OUT; W = (l & 1) ? p.in[23] + (size_t)(l >> 1) * DM * DM : p.in[8] + (size_t)(l >> 1) * DM * DM; K = DM; N = DM;
        WT = (bf16_t*)(p.ws + WS_WOUT) + (size_t)l * DM * DM; item = r % I_OUT; return; }
    r -= 4 * I_OUT;
    { const int i = r / I_GLU; W = p.in[20] + (size_t)i * 512 * 512; K = 512; N = 512; WT = (bf16_t*)(p.ws + WS_WGLU) + (size_t)i * 512 * 512; item = r % I_GLU; }
}
__device__ __forceinline__ void phase_transposes(const Ctx& c) {
    const P& p = *c.p;
    float* scr = (float*)c.lds;
    constexpr int NIT = 4 * 16 * 40 + 4 * 16 * 16 + 2 * 8 * 8;
    for (int it = 2 * blockIdx.x; it < NIT; it += 2 * gridDim.x) {
        const float* W0; const float* W1 = nullptr; int K0, N0, K1 = 0, N1 = 0, i0, i1 = 0, pb0, pb1 = 0; bf16_t* T0; bf16_t* T1 = nullptr;
        transpose_resolve(p, it, W0, K0, N0, T0, i0, pb0);
        if (it + 1 < NIT) transpose_resolve(p, it + 1, W1, K1, N1, T1, i1, pb1);
        transpose_pair(W0, W1, K0, N0, K1, N1, T0, T1, i0, i1, scr, c.tid, pb0, pb1);
    }
    __syncthreads();
}
__device__ __forceinline__ void phase_bias(const Ctx& c) {
    const P& p = *c.p;
    const float* mods = (const float*)(p.ws + WS_MODS); float* bias = (float*)(p.ws + WS_BIAS);
    float* sl = (float*)(c.lds + 32768);
    float* red = (float*)(c.lds + 32768 + 20480);
    for (int it = blockIdx.x; it < DEPTH * 40; it += gridDim.x) {
        const int l = it / 40, n = (it % 40) * 64 + c.lane;
        __syncthreads();
        for (int e = c.tid; e < 5 * DM; e += NTHREADS) { const int r = e >> 10, k = e & 1023; sl[e] = mods[((size_t)l * 5 + r) * 3072 + k]; }
        __syncthreads();
        const float* W = ((l & 1) ? p.in[22] + (size_t)(l >> 1) * DM * NPROJ : p.in[7] + (size_t)(l >> 1) * DM * NPROJ) + (size_t)(c.wid * 128) * NPROJ + in_col_logical(l, n);
        float a0 = 0.f, a1 = 0.f, a2 = 0.f, a3 = 0.f, a4 = 0.f;
#pragma unroll 32
        for (int k = 0; k < 128; ++k) { const float wv = W[(size_t)k * NPROJ]; const int kk = c.wid * 128 + k;
            a0 += sl[kk] * wv; a1 += sl[DM + kk] * wv; a2 += sl[2 * DM + kk] * wv; a3 += sl[3 * DM + kk] * wv; a4 += sl[4 * DM + kk] * wv; }
        float* rw = red + c.wid * 320 + c.lane; rw[0] = a0; rw[64] = a1; rw[128] = a2; rw[192] = a3; rw[256] = a4;
        __syncthreads();
        if (c.tid < 320) { float sum = 0.f;
#pragma unroll
            for (int w8 = 0; w8 < 8; ++w8) sum += red[w8 * 320 + c.tid];
            const int r = c.tid >> 6, nn = (it % 40) * 64 + (c.tid & 63);
            bias[((size_t)l * 5 + r) * NPROJ + nn] = sum; }
    }
    __syncthreads();
}
__device__ __forceinline__ void phase_xprep(const Ctx& c, int l, const float* xbuf, const float* ctxbuf) {
    const P& p = *c.p;
    const float* mods = (const float*)(p.ws + WS_MODS) + (size_t)l * 5 * 3072;
    const float* g = p.in[4] + l * DM;
    bf16_t* xm = (bf16_t*)(p.ws + WS_XM); float* rss = (float*)(p.ws + WS_RSS);
    for (int m0 = 2 * c.gw; m0 < MTOK; m0 += 2 * c.ngw) {
        f32x4 v[2][4]; const float* scp[2];
#pragma unroll
        for (int rr = 0; rr < 2; ++rr) { const int m = m0 + rr; bool ic; const size_t off = res_off(m, ic); const float* src = (ic ? ctxbuf : xbuf) + off; scp[rr] = mods + cond_row(m) * 3072 + 1024;
#pragma unroll
            for (int j = 0; j < 4; ++j) v[rr][j] = *(const f32x4*)(src + 4 * c.lane + 256 * j); }
#pragma unroll
        for (int rr = 0; rr < 2; ++rr) { const int m = m0 + rr; float ss = 0.f;
#pragma unroll
            for (int j = 0; j < 4; ++j) { const int k = 4 * c.lane + 256 * j; const f32x4 x = v[rr][j]; const f32x4 gv = *(const f32x4*)(g + k), sv = *(const f32x4*)(scp[rr] + k);
                ss += x.x * x.x + x.y * x.y + x.z * x.z + x.w * x.w;
                u32x2 o; o.x = pk2(x.x * gv.x * (1.f + sv.x), x.y * gv.y * (1.f + sv.y)); o.y = pk2(x.z * gv.z * (1.f + sv.z), x.w * gv.w * (1.f + sv.w));
                *(u32x2*)(xm + (size_t)m * DM + k) = o; }
            ss = wave_sum(ss);
            if (c.lane < 16) rss[(size_t)m * 16 + c.lane] = c.lane == 0 ? ss : 0.f; }
    }
}

template <class Epi>
__device__ __forceinline__ void gemm_simple(const Ctx& c, const bf16_t* A, int lda, const bf16_t* Bt, int ldb, int M, int N, int K, const Epi& epi) {
    const int fr = c.lane & 15, fq = c.lane >> 4, wr = c.wid >> 1, wc = c.wid & 1;
    const int tn = N / 128, nt = (M / 128) * tn;
    for (int t = blockIdx.x; t < nt; t += gridDim.x) {
        const int pm = t / tn, pn = t % tn;
        f32x4 acc[2][4];
#pragma unroll
        for (int i = 0; i < 2; ++i)
#pragma unroll
            for (int j = 0; j < 4; ++j) acc[i][j] = (f32x4){0.f, 0.f, 0.f, 0.f};
        const bf16_t* a0 = A + (size_t)(pm * 128 + wr * 32 + fr) * lda + fq * 8;
        const bf16_t* b0 = Bt + (size_t)(pn * 128 + wc * 64 + fr) * ldb + fq * 8;
        for (int k = 0; k < K; k += 32) {
            bf16x8 af[2], bfr[4];
#pragma unroll
            for (int i = 0; i < 2; ++i) af[i] = *(const bf16x8*)(a0 + (size_t)i * 16 * lda + k);
#pragma unroll
            for (int j = 0; j < 4; ++j) bfr[j] = *(const bf16x8*)(b0 + (size_t)j * 16 * ldb + k);
#pragma unroll
            for (int i = 0; i < 2; ++i)
#pragma unroll
                for (int j = 0; j < 4; ++j) acc[i][j] = __builtin_amdgcn_mfma_f32_16x16x32_bf16(bfr[j], af[i], acc[i][j], 0, 0, 0);
        }
#pragma unroll
        for (int i = 0; i < 2; ++i)
#pragma unroll
            for (int j = 0; j < 4; ++j) epi(pm * 128 + wr * 32 + i * 16 + fr, pn * 128 + wc * 64 + j * 16 + 4 * fq, acc[i][j]);
    }
}

struct EpiIn {
    const float* rss; const float* bias; bf16_t* proj; int odd;
    __device__ __forceinline__ void operator()(int row, int col, f32x4 v) const {
        const f32x4* rp = (const f32x4*)(rss + (size_t)row * 16);
        const f32x4 s0 = rp[0], s1 = rp[1], s2 = rp[2], s3 = rp[3];
        const float ss = ((s0.x + s0.y) + (s0.z + s0.w)) + ((s1.x + s1.y) + (s1.z + s1.w)) + ((s2.x + s2.y) + (s2.z + s2.w)) + ((s3.x + s3.y) + (s3.z + s3.w));
        const float rstd = rsqrtf(ss * (1.f / DM) + EPS);
        const f32x4 bv = *(const f32x4*)(bias + (size_t)cond_row(row) * NPROJ + col);
        v = v * rstd + bv;
        const bool act = odd ? (col >= 1536) : ((col >= 1024 && col < 1536) || col >= 2048);
        if (act) { v.x = silu_f(v.x); v.y = silu_f(v.y); v.z = silu_f(v.z); v.w = silu_f(v.w); }
        u32x2 o; o.x = pk2(v.x, v.y); o.y = pk2(v.z, v.w);
        *(u32x2*)(proj + (size_t)row * NPROJ + col) = o;
    }
};
struct EpiOut {
    const float* xold; const float* cold; float* xnew; float* cnew; const float* mods; int skip_ctx;
    __device__ __forceinline__ void operator()(int row, int col, f32x4 v) const {
        bool ic; const size_t off = res_off(row, ic) + col;
        if (ic && skip_ctx) return;
        const f32x4 gt = *(const f32x4*)(mods + (size_t)cond_row(row) * 3072 + 2048 + col);
        const f32x4 o = *(const f32x4*)((ic ? cold : xold) + off);
        *(f32x4*)((ic ? cnew : xnew) + off) = o + gt * v;
    }
};
struct EpiGlu {
    const bf16_t* yg; const bf16_t* proj; const float* bglu; bf16_t* mix;
    __device__ __forceinline__ void operator()(int row, int col, f32x4 v) const {
        const f32x4 b = *(const f32x4*)(bglu + col);
        const u32x2 yw = *(const u32x2*)(yg + (size_t)row * 512 + col), gw = *(const u32x2*)(proj + (size_t)row * NPROJ + 2048 + col);
        const float o0 = bflo(yw.x) * sigmoid_f(v.x + b.x) * bflo(gw.x), o1 = bfhi(yw.x) * sigmoid_f(v.y + b.y) * bfhi(gw.x);
        const float o2 = bflo(yw.y) * sigmoid_f(v.z + b.z) * bflo(gw.y), o3 = bfhi(yw.y) * sigmoid_f(v.w + b.w) * bfhi(gw.y);
        u32x2 o; o.x = pk2(o0, o1); o.y = pk2(o2, o3);
        *(u32x2*)(mix + (size_t)row * DM + 512 + col) = o;
    }
};


template <class E> struct EpiTile {
    static constexpr bool PERM = false, AFTER_DRAIN = false; E e;
    __device__ __forceinline__ void operator()(const pg8::f32x4 (&acc)[2][2][4][2], const pg8::Unit& u, int wr, int wc, int fr, int fq) const {
#pragma unroll
        for (int ai = 0; ai < 2; ++ai)
#pragma unroll
            for (int m = 0; m < 4; ++m) { const int row = u.pm * 256 + ai * 128 + wr * 64 + m * 16 + fr;
#pragma unroll
                for (int bj = 0; bj < 2; ++bj)
#pragma unroll
                    for (int n = 0; n < 2; ++n) e(row, u.pn * 256 + bj * 128 + wc * 32 + n * 16 + 4 * fq, acc[ai][bj][m][n]); }
    }
};
template <class E> __device__ __forceinline__ void gemm_fast(const Ctx& c, const bf16_t* A, const bf16_t* Bt, int M, int N, int K, const E& e) {
    pg8::Gemm g{A, Bt, M, N, K}; pg8::StaticOrder S; S.init(M, N, (int)gridDim.x, (int)blockIdx.x);
    EpiTile<E> E2{e};
    pg8::gemm_phase<EpiTile<E>, pg8::StaticOrder, true, true>((PG8_LAS unsigned char*)c.lds, g, S, E2, c.tid);
    __syncthreads();
}


struct EpiInTile {
    static constexpr bool PERM = true, AFTER_DRAIN = false;
    const float* rss; const float* bias; bf16_t* proj; int odd; const float* qg; const float* kg; const float* rope; float* red; float* vst;
    __device__ __forceinline__ void operator()(const pg8::f32x4 (&acc)[2][2][4][2], const pg8::Unit& u, int wr, int wc, int fr, int fq) const {
        asm volatile("" : "+v"(fr), "+v"(fq));
        const int pmb = u.pm / 17, jt = u.pm - pmb * 17, r = jt == 0 ? 4 : pmb;
        const int colb = u.pn * 256 + wc * 32 + 8 * fq;
        f32x4 bv[2][2];
#pragma unroll
        for (int bj = 0; bj < 2; ++bj)
#pragma unroll
            for (int n = 0; n < 2; ++n) bv[bj][n] = *(const f32x4*)(bias + (size_t)r * NPROJ + colb + bj * 128 + n * 4);
        float rstd[2][4];
        {
            int tl = (wr * 4 + wc) * 64 + fq * 16 + fr; asm volatile("" : "+v"(tl));
            if (tl < 256) { const f32x4* rp = (const f32x4*)(rss + ((size_t)u.pm * 256 + tl) * 16);
                const f32x4 s0 = rp[0], s1 = rp[1], s2 = rp[2], s3 = rp[3];
                const float ss = ((s0.x + s0.y) + (s0.z + s0.w)) + ((s1.x + s1.y) + (s1.z + s1.w)) + ((s2.x + s2.y) + (s2.z + s2.w)) + ((s3.x + s3.y) + (s3.z + s3.w));
                red[2048 + tl] = rsqrtf(ss * (1.f / DM) + EPS); }
            asm volatile("s_waitcnt lgkmcnt(0)" ::: "memory"); __builtin_amdgcn_s_barrier(); asm volatile("" ::: "memory");
#pragma unroll
            for (int ai = 0; ai < 2; ++ai)
#pragma unroll
                for (int m = 0; m < 4; ++m) rstd[ai][m] = red[2048 + ai * 128 + wr * 64 + m * 16 + fr];
        }
        const bool qk = odd && u.pn <= 4;
        if (qk) {
#pragma unroll
            for (int ai = 0; ai < 2; ++ai)
#pragma unroll
                for (int m = 0; m < 4; ++m)
#pragma unroll
                    for (int bj = 0; bj < 2; ++bj) { const f32x4 v0 = acc[ai][bj][m][0] * rstd[ai][m] + bv[bj][0], v1 = acc[ai][bj][m][1] * rstd[ai][m] + bv[bj][1];
                        float s_ = ((v0.x * v0.x + v0.y * v0.y) + (v0.z * v0.z + v0.w * v0.w)) + ((v1.x * v1.x + v1.y * v1.y) + (v1.z * v1.z + v1.w * v1.w));
                        s_ += __shfl_xor(s_, 16); s_ += __shfl_xor(s_, 32);
                        if (fq == 0) red[((ai * 128 + wr * 64 + m * 16 + fr) * 2 + bj) * 4 + wc] = s_; }
            asm volatile("s_waitcnt lgkmcnt(0)" ::: "memory"); __builtin_amdgcn_s_barrier(); asm volatile("" ::: "memory");
        }
        const bool vt = !odd && (u.pn == 2 || u.pn == 3);
        const float* gn = u.pn == 4 ? kg : qg;
        const int a_ = wc >> 1, p0 = (wc & 1) * 16 + fq * 4, d0 = a_ * 64 + p0;
#pragma unroll
        for (int ai = 0; ai < 2; ++ai)
#pragma unroll
            for (int m = 0; m < 4; ++m) { const int rt = ai * 128 + wr * 64 + m * 16 + fr; const int row = u.pm * 256 + rt;
                bf16_t* rowp = proj + (size_t)row * NPROJ + colb; float vs1 = 0.f, vs2 = 0.f;
                f32x4 cs0 = (f32x4){1.f, 0.f, 1.f, 0.f}, cs1 = cs0;
                if (qk && jt != 0) { const int tl = (jt - 1) * 256 + rt; const int pos = a_ == 0 ? (tl >> 6) : (tl & 63); const float* rp = rope + (size_t)(pos * 32 + p0) * 2; cs0 = *(const f32x4*)rp; cs1 = *(const f32x4*)(rp + 4); }
#pragma unroll
                for (int bj = 0; bj < 2; ++bj) { const int c0 = u.pn * 256 + bj * 128;
                    const bool act = odd ? (c0 >= 1536) : ((c0 >= 1024 && c0 < 1536) || c0 >= 2048);
                    f32x4 v0 = acc[ai][bj][m][0] * rstd[ai][m] + bv[bj][0], v1 = acc[ai][bj][m][1] * rstd[ai][m] + bv[bj][1];
                    if (act) { v0.x = silu_f(v0.x); v0.y = silu_f(v0.y); v0.z = silu_f(v0.z); v0.w = silu_f(v0.w); v1.x = silu_f(v1.x); v1.y = silu_f(v1.y); v1.z = silu_f(v1.z); v1.w = silu_f(v1.w); }
                    if (qk) { const f32x4 pr = *(const f32x4*)(red + ((rt) * 2 + bj) * 4);
                        const float hr = rsqrtf(((pr.x + pr.y) + (pr.z + pr.w)) * (1.f / 128.f) + EPS);
                        const f32x4 g1 = *(const f32x4*)(gn + d0), g2 = *(const f32x4*)(gn + d0 + 32);
                        const f32x4 x1 = v0 * hr * g1, x2 = v1 * hr * g2;
                        v0.x = x1.x * cs0.x - x2.x * cs0.y; v1.x = x1.x * cs0.y + x2.x * cs0.x; v0.y = x1.y * cs0.z - x2.y * cs0.w; v1.y = x1.y * cs0.w + x2.y * cs0.z;
                        v0.z = x1.z * cs1.x - x2.z * cs1.y; v1.z = x1.z * cs1.y + x2.z * cs1.x; v0.w = x1.w * cs1.z - x2.w * cs1.w; v1.w = x1.w * cs1.w + x2.w * cs1.z; }
                    if (vt) { vs1 += ((v0.x + v0.y) + (v0.z + v0.w)) + ((v1.x + v1.y) + (v1.z + v1.w)); vs2 += ((v0.x * v0.x + v0.y * v0.y) + (v0.z * v0.z + v0.w * v0.w)) + ((v1.x * v1.x + v1.y * v1.y) + (v1.z * v1.z + v1.w * v1.w)); }
                    u32x4 o; o.x = pk2(v0.x, v0.y); o.y = pk2(v0.z, v0.w); o.z = pk2(v1.x, v1.y); o.w = pk2(v1.z, v1.w); *(u32x4*)(rowp + bj * 128) = o; }
                if (vt) { vs1 += __shfl_xor(vs1, 16); vs1 += __shfl_xor(vs1, 32); vs2 += __shfl_xor(vs2, 16); vs2 += __shfl_xor(vs2, 32);
                    if (fq == 0) { float2 w_; w_.x = vs1; w_.y = vs2; *(float2*)(vst + ((size_t)row * 8 + (u.pn - 2) * 4 + wc) * 2) = w_; } }
            }
    }
};
struct EpiGluTile {
    static constexpr bool PERM = true, AFTER_DRAIN = false;
    const bf16_t* yg; const bf16_t* proj; const float* bglu; bf16_t* mix;
    __device__ __forceinline__ void operator()(const pg8::f32x4 (&acc)[2][2][4][2], const pg8::Unit& u, int wr, int wc, int fr, int fq) const {
        asm volatile("" : "+v"(fr), "+v"(fq));
        const int colb = u.pn * 256 + wc * 32 + 8 * fq;
        f32x4 bv[2][2];
#pragma unroll
        for (int bj = 0; bj < 2; ++bj)
#pragma unroll
            for (int n = 0; n < 2; ++n) bv[bj][n] = *(const f32x4*)(bglu + colb + bj * 128 + n * 4);
#pragma unroll
        for (int ai = 0; ai < 2; ++ai)
#pragma unroll
            for (int m = 0; m < 4; ++m) { const int row = u.pm * 256 + ai * 128 + wr * 64 + m * 16 + fr;
#pragma unroll
                for (int bj = 0; bj < 2; ++bj) { const int col = colb + bj * 128; const f32x4 v0 = acc[ai][bj][m][0] + bv[bj][0], v1 = acc[ai][bj][m][1] + bv[bj][1];
                    const u32x4 yw = *(const u32x4*)(yg + (size_t)row * 512 + col), gw = *(const u32x4*)(proj + (size_t)row * NPROJ + 2048 + col);
                    u32x4 o; o.x = pk2(bflo(yw.x) * sigmoid_f(v0.x) * bflo(gw.x), bfhi(yw.x) * sigmoid_f(v0.y) * bfhi(gw.x)); o.y = pk2(bflo(yw.y) * sigmoid_f(v0.z) * bflo(gw.y), bfhi(yw.y) * sigmoid_f(v0.w) * bfhi(gw.y));
                    o.z = pk2(bflo(yw.z) * sigmoid_f(v1.x) * bflo(gw.z), bfhi(yw.z) * sigmoid_f(v1.y) * bfhi(gw.z)); o.w = pk2(bflo(yw.w) * sigmoid_f(v1.z) * bflo(gw.w), bfhi(yw.w) * sigmoid_f(v1.w) * bfhi(gw.w));
                    *(u32x4*)(mix + (size_t)row * DM + 512 + col) = o; }
                if (m & 1) asm volatile("" ::: "memory"); }
    }
};
template <class ET> __device__ __forceinline__ void gemm_fast_tile(const Ctx& c, const bf16_t* A, const bf16_t* Bt, int M, int N, int K, const ET& e) {
    pg8::Gemm g{A, Bt, M, N, K}; pg8::StaticOrder S; S.init(M, N, (int)gridDim.x, (int)blockIdx.x);
    pg8::gemm_phase<ET, pg8::StaticOrder, true, true>((PG8_LAS unsigned char*)c.lds, g, S, e, c.tid);
    __syncthreads();
}


struct LatentOrder {
    pg8::StaticOrder s;
    __device__ void init(int N, int G_, int c_) { s.init(NB * SEQ, N, G_, c_); }
    __device__ bool next(int i, pg8::Unit& u) const { if (!s.next(i, u)) return false; u.pm = (u.pm >> 4) * 17 + (u.pm & 15) + 1; return true; }
    __device__ __forceinline__ void a_ready(const pg8::Unit&) const {}
    __device__ __forceinline__ void done(const pg8::Unit&) const {}
};
struct EpiOutTile {
    static constexpr bool PERM = true, AFTER_DRAIN = false;
    const float* xold_f; const bf16_t* xold_b; float* xnew_f; bf16_t* xnew_b;
    const float* mods; const float* mods_next; const float* gnext; bf16_t* xm; float* rss;
    __device__ __forceinline__ void operator()(const pg8::f32x4 (&acc)[2][2][4][2], const pg8::Unit& u, int wr, int wc, int fr, int fq) const {
        asm volatile("" : "+v"(fr), "+v"(fq));
        const int b = u.pm / 17, j = u.pm - b * 17;
        const int colb = u.pn * 256 + wc * 32 + 8 * fq;
        const size_t off0 = ((size_t)b * SEQ + (j - 1) * 256 + wr * 64 + fr) * DM + colb;
        const size_t row0 = (size_t)u.pm * 256 + wr * 64 + fr;
        float ss[2][4];
#pragma unroll
        for (int ai = 0; ai < 2; ++ai)
#pragma unroll
            for (int m = 0; m < 4; ++m) ss[ai][m] = 0.f;
#define EPI_OUT_BATCH(BJ, AI0) do { \
            f32x4 xo[4][2]; \
            if (xold_b) { _Pragma("unroll") for (int m = 0; m < 4; ++m) { const u32x4 w_ = *(const u32x4*)(xold_b + off0 + (size_t)((AI0) * 128 + m * 16) * DM + BJ * 128); \
                    xo[m][0] = (f32x4){bflo(w_.x), bfhi(w_.x), bflo(w_.y), bfhi(w_.y)}; xo[m][1] = (f32x4){bflo(w_.z), bfhi(w_.z), bflo(w_.w), bfhi(w_.w)}; } } \
            else { _Pragma("unroll") for (int m = 0; m < 4; ++m) { const float* xp = xold_f + off0 + (size_t)((AI0) * 128 + m * 16) * DM + BJ * 128; xo[m][0] = *(const f32x4*)xp; xo[m][1] = *(const f32x4*)(xp + 4); } } \
            const int col = colb + BJ * 128; \
            const f32x4 gt0 = *(const f32x4*)(mods + (size_t)b * 3072 + 2048 + col), gt1 = *(const f32x4*)(mods + (size_t)b * 3072 + 2048 + col + 4); \
            f32x4 an0 = (f32x4){0.f, 0.f, 0.f, 0.f}, an1 = an0; \
            if (mods_next) { an0 = *(const f32x4*)(gnext + col) * (*(const f32x4*)(mods_next + (size_t)b * 3072 + 1024 + col) + 1.f); an1 = *(const f32x4*)(gnext + col + 4) * (*(const f32x4*)(mods_next + (size_t)b * 3072 + 1024 + col + 4) + 1.f); } \
            _Pragma("unroll") for (int m = 0; m < 4; ++m) { const int ai = AI0; \
                    const f32x4 x0 = xo[m][0] + gt0 * acc[ai][BJ][m][0], x1 = xo[m][1] + gt1 * acc[ai][BJ][m][1]; \
                    const size_t o_ = off0 + (size_t)(ai * 128 + m * 16) * DM + BJ * 128; \
                    if (xnew_b) { u32x4 w; w.x = pk2(x0.x, x0.y); w.y = pk2(x0.z, x0.w); w.z = pk2(x1.x, x1.y); w.w = pk2(x1.z, x1.w); *(u32x4*)(xnew_b + o_) = w; } \
                    else { *(f32x4*)(xnew_f + o_) = x0; *(f32x4*)(xnew_f + o_ + 4) = x1; } \
                    ss[ai][m] += ((x0.x * x0.x + x0.y * x0.y) + (x0.z * x0.z + x0.w * x0.w)) + ((x1.x * x1.x + x1.y * x1.y) + (x1.z * x1.z + x1.w * x1.w)); \
                    if (mods_next) { const f32x4 h0 = x0 * an0, h1 = x1 * an1; u32x4 w; w.x = pk2(h0.x, h0.y); w.y = pk2(h0.z, h0.w); w.z = pk2(h1.x, h1.y); w.w = pk2(h1.z, h1.w); \
                        *(u32x4*)(xm + (row0 + ai * 128 + m * 16) * DM + col) = w; } } \
            asm volatile("" ::: "memory"); } while (0)
        EPI_OUT_BATCH(0, 0); EPI_OUT_BATCH(0, 1); EPI_OUT_BATCH(1, 0); EPI_OUT_BATCH(1, 1);
#undef EPI_OUT_BATCH
        {
#pragma unroll
            for (int ai = 0; ai < 2; ++ai)
#pragma unroll
                for (int m = 0; m < 4; ++m) { float s_ = ss[ai][m]; s_ += __shfl_xor(s_, 16); s_ += __shfl_xor(s_, 32); if (fq == 0) rss[(row0 + ai * 128 + m * 16) * 16 + u.pn * 4 + wc] = s_; }
        }
    }
};
__device__ __forceinline__ void out_ctx_small(const Ctx& c, int l, const float* cold, float* cnew) {
    const P& p = *c.p;
    const bf16_t* mix = (const bf16_t*)(p.ws + WS_MIX); const bf16_t* wt = (const bf16_t*)(p.ws + WS_WOUT) + (size_t)l * DM * DM;
    const float* mods = (const float*)(p.ws + WS_MODS) + (size_t)l * 5 * 3072 + 4 * 3072; const float* modsn = (const float*)(p.ws + WS_MODS) + (size_t)(l + 1) * 5 * 3072 + 4 * 3072;
    const float* gnext = p.in[4] + (l + 1) * DM; bf16_t* xm = (bf16_t*)(p.ws + WS_XM); float* rss = (float*)(p.ws + WS_RSS);
    const int wid = __builtin_amdgcn_readfirstlane(c.wid), fr = c.lane & 15, fq = c.lane >> 4, rg = wid & 3, kh = wid >> 2;
    float* red = (float*)c.lds;
    for (int t = blockIdx.x; t < 256; t += gridDim.x) {
        const int rm = t >> 4, cn = t & 15;
        const int cr = rm * 64 + rg * 16 + fr, b = cr >> 8, ti = cr & 255;
        const size_t m = (size_t)b * TPB + ti;
        f32x4 acc[4];
#pragma unroll
        for (int q = 0; q < 4; ++q) acc[q] = (f32x4){0.f, 0.f, 0.f, 0.f};
        const bf16_t* a0 = mix + m * DM + kh * 512 + fq * 8; const bf16_t* b0 = wt + (size_t)(cn * 64 + fr) * DM + kh * 512 + fq * 8;
#pragma unroll 4
        for (int k = 0; k < 512; k += 32) { const bf16x8 af = *(const bf16x8*)(a0 + k);
#pragma unroll
            for (int q = 0; q < 4; ++q) { const bf16x8 bf = *(const bf16x8*)(b0 + (size_t)q * 16 * DM + k); acc[q] = __builtin_amdgcn_mfma_f32_16x16x32_bf16(bf, af, acc[q], 0, 0, 0); } }
        __syncthreads();
        if (kh == 1) {
#pragma unroll
            for (int q = 0; q < 4; ++q) *(f32x4*)(red + ((rg * 64 + c.lane) * 4 + q) * 4) = acc[q]; }
        __syncthreads();
        if (kh == 0) {
            float ss = 0.f; const size_t off = ((size_t)b * NCTX + ti) * DM;
#pragma unroll
            for (int q = 0; q < 4; ++q) { const int col = cn * 64 + q * 16 + 4 * fq;
                const f32x4 a2 = acc[q] + *(const f32x4*)(red + ((rg * 64 + c.lane) * 4 + q) * 4);
                const f32x4 gt = *(const f32x4*)(mods + 2048 + col), sc = *(const f32x4*)(modsn + 1024 + col), gv = *(const f32x4*)(gnext + col);
                const f32x4 o = *(const f32x4*)(cold + off + col); const f32x4 xn = o + gt * a2;
                *(f32x4*)(cnew + off + col) = xn; ss += (xn.x * xn.x + xn.y * xn.y) + (xn.z * xn.z + xn.w * xn.w);
                const f32x4 h = xn * gv * (sc + 1.f); u32x2 w; w.x = pk2(h.x, h.y); w.y = pk2(h.z, h.w); *(u32x2*)(xm + m * DM + col) = w; }
            ss += __shfl_xor(ss, 16); ss += __shfl_xor(ss, 32); if (fq == 0) rss[m * 16 + cn] = ss;
        }
    }
    __syncthreads();
}

__device__ __forceinline__ void phase_in(const Ctx& c, int l) {
    const P& p = *c.p;
    EpiIn e{(const float*)(p.ws + WS_RSS), (const float*)(p.ws + WS_BIAS) + (size_t)l * 5 * NPROJ, (bf16_t*)(p.ws + WS_PROJ), l & 1};
    #ifdef USE_PG8
    { const int i_ = l >> 1; EpiInTile et{e.rss, e.bias, e.proj, e.odd, p.in[24] + i_ * 128, p.in[25] + i_ * 128, (const float*)(p.ws + WS_ROPE), (float*)(c.lds + 131072), (float*)(p.ws + WS_VST)}; gemm_fast_tile(c, (const bf16_t*)(p.ws + WS_XM), (const bf16_t*)(p.ws + WS_WIN) + (size_t)l * NPROJ * DM, MTOK, NPROJ, DM, et); }
#else
    gemm_simple(c, (const bf16_t*)(p.ws + WS_XM), DM, (const bf16_t*)(p.ws + WS_WIN) + (size_t)l * NPROJ * DM, DM, MTOK, NPROJ, DM, e);
#endif
}
__device__ __forceinline__ void phase_out(const Ctx& c, int l) {
    const P& p = *c.p;
    float* cres = (float*)(p.ws + WS_CTXRES);
    const bool last = l == DEPTH - 1;
    bf16_t* xb = (bf16_t*)(p.ws + WS_XB);
    EpiOutTile e{l == 0 ? p.in[0] : nullptr, l == 0 ? nullptr : xb, nullptr, xb, (const float*)(p.ws + WS_MODS) + (size_t)l * 5 * 3072, last ? nullptr : (const float*)(p.ws + WS_MODS) + (size_t)(l + 1) * 5 * 3072,
                 last ? nullptr : p.in[4] + (l + 1) * DM, (bf16_t*)(p.ws + WS_XM), (float*)(p.ws + WS_RSS)};
    pg8::Gemm g{(const bf16_t*)(p.ws + WS_MIX), (const bf16_t*)(p.ws + WS_WOUT) + (size_t)l * DM * DM, MTOK, DM, DM};
    LatentOrder S; S.init(DM, (int)gridDim.x, (int)blockIdx.x);
    pg8::gemm_phase<EpiOutTile, LatentOrder, true, true>((PG8_LAS unsigned char*)c.lds, g, S, e, c.tid);
    __syncthreads();
    if (!last) out_ctx_small(c, l, l == 0 ? p.in[2] : cres, cres);
#if defined(DUPX) && DUPX == 3
    if (l == 0) out_ctx_small(c, l, p.in[2], cres);
#endif
}
__device__ __forceinline__ void phase_gmlp_fast(const Ctx& c, int l, int blk0, int nblk);
__device__ __forceinline__ void phase_glu(const Ctx& c, int l) {
    const P& p = *c.p; const int i = l >> 1;
    const int G = gridDim.x, ng = G >= 200 ? 136 : G;
    if ((int)blockIdx.x < ng) {
        EpiGluTile et{(const bf16_t*)(p.ws + WS_YG), (const bf16_t*)(p.ws + WS_PROJ), p.in[21] + i * 512, (bf16_t*)(p.ws + WS_MIX)};
        pg8::Gemm g{(const bf16_t*)(p.ws + WS_YG), (const bf16_t*)(p.ws + WS_WGLU) + (size_t)i * 512 * 512, MTOK, 512, 512}; pg8::StaticOrder S; S.init(MTOK, 512, ng, (int)blockIdx.x);
        pg8::gemm_phase<EpiGluTile, pg8::StaticOrder, true, true>((PG8_LAS unsigned char*)c.lds, g, S, et, c.tid);
        __syncthreads();
        if (ng == G) phase_gmlp_fast(c, l, 0, G);
    } else phase_gmlp_fast(c, l, ng, G - ng);
}

__device__ __forceinline__ void phase_gmlp(const Ctx& c, int l) {
    const P& p = *c.p; const int i = l >> 1;
    const bf16_t* proj = (const bf16_t*)(p.ws + WS_PROJ); bf16_t* mix = (bf16_t*)(p.ws + WS_MIX);
    const float* vg = p.in[9] + i * 512; const float* ws_ = p.in[10] + (size_t)i * 4 * 128 * 128; const float* bs = p.in[11] + i * 4 * 128;
    float* vn = (float*)c.lds;
    for (int it = blockIdx.x; it < 136 * 4; it += gridDim.x) {
        const int ch = it >> 2, g = it & 3;
        __syncthreads();
        for (int q = c.wid; q < 128; q += NWAVES) {
            const size_t row = (size_t)ch * 128 + q;
            const u32x4 w = *(const u32x4*)(proj + row * NPROJ + 512 + c.lane * 8);
            float v[8] = {bflo(w.x), bfhi(w.x), bflo(w.y), bfhi(w.y), bflo(w.z), bfhi(w.z), bflo(w.w), bfhi(w.w)};
            float s = 0.f;
#pragma unroll
            for (int e = 0; e < 8; ++e) s += v[e];
            const float mu = wave_sum(s) * (1.f / 512.f); float s2 = 0.f;
#pragma unroll
            for (int e = 0; e < 8; ++e) { v[e] -= mu; s2 += v[e] * v[e]; }
            const float rstd = rsqrtf(wave_sum(s2) * (1.f / 512.f) + EPS);
            if ((c.lane >> 4) == g) {
#pragma unroll
                for (int e = 0; e < 8; ++e) { const int cc = (c.lane & 15) * 8 + e; vn[q * 129 + cc] = v[e] * rstd * vg[g * 128 + cc]; }
            }
        }
        __syncthreads();
        const int cc = c.tid & 127, pq = c.tid >> 7;
        for (int pp = pq * 32; pp < pq * 32 + 32; ++pp) {
            const float* wrow = ws_ + ((size_t)g * 128 + pp) * 128;
            float acc = 0.f;
#pragma unroll 8
            for (int q = 0; q < 128; ++q) acc += wrow[q] * vn[q * 129 + cc];
            const float mixed = acc + bs[g * 128 + pp];
            const size_t row = (size_t)ch * 128 + pp;
            const float u = bf2f(proj[row * NPROJ + g * 128 + cc]), ga = bf2f(proj[row * NPROJ + 1024 + g * 128 + cc]);
            mix[row * DM + g * 128 + cc] = (bf16_t)f2bf(u * mixed * ga);
        }
    }
}

__device__ __forceinline__ void phase_s5_naive(const Ctx& c, int l) {
    const P& p = *c.p; const int i = l >> 1;
    const bf16_t* proj = (const bf16_t*)(p.ws + WS_PROJ);
    float* red = (float*)(c.lds + 80 * 1024) + c.wid * 1024;
    for (int it = c.gw; it < NB * 32 * 2; it += c.ngw) {
        const int dir = it & 1, g = (it >> 1) & 31, b = it >> 6, pl = c.lane;
        float* Y = (float*)(p.ws + (dir ? WS_XM : WS_S5));
        const size_t dg = ((size_t)(i * 2 + dir) * 32 + g);
        const float dt = expf(p.in[14][dg]);
        const float lr = p.in[12][dg * 64 + pl], li = p.in[13][dg * 64 + pl];
        const float mag = expf(lr * dt), lbr = mag * cosf(li * dt), lbi = mag * sinf(li * dt);
        const float den = lr * lr + li * li, nre = lbr - 1.f, nim = lbi;
        const float fre = (nre * lr + nim * li) / den, fim = (nim * lr - nre * li) / den;
        float bbr[16], bbi[16], cr[16], ci[16];
#pragma unroll
        for (int h = 0; h < 16; ++h) { const float br = p.in[15][(dg * 64 + pl) * 16 + h], bi = p.in[16][(dg * 64 + pl) * 16 + h];
            bbr[h] = fre * br - fim * bi; bbi[h] = fre * bi + fim * br;
            cr[h] = p.in[17][(dg * 16 + h) * 64 + pl]; ci[h] = p.in[18][(dg * 16 + h) * 64 + pl]; }
        float hr = 0.f, hi = 0.f;
        for (int s0 = 0; s0 < TPB; s0 += 4) {
            u32x4 uw[4][2];
#pragma unroll
            for (int j = 0; j < 4; ++j) { const int s = s0 + j; const int t = dir == 0 ? s : (s < NCTX ? NCTX - 1 - s : NCTX + SEQ - 1 - (s - NCTX));
                const bf16_t* up = proj + (size_t)(b * TPB + t) * NPROJ + 1536 + g * 16; uw[j][0] = *(const u32x4*)up; uw[j][1] = *(const u32x4*)(up + 8); }
#pragma unroll
            for (int j = 0; j < 4; ++j) { const int s = s0 + j; const int t = dir == 0 ? s : (s < NCTX ? NCTX - 1 - s : NCTX + SEQ - 1 - (s - NCTX));
                float u[16];
#pragma unroll
                for (int q = 0; q < 2; ++q) { u[8 * q + 0] = bflo(uw[j][q].x); u[8 * q + 1] = bfhi(uw[j][q].x); u[8 * q + 2] = bflo(uw[j][q].y); u[8 * q + 3] = bfhi(uw[j][q].y);
                    u[8 * q + 4] = bflo(uw[j][q].z); u[8 * q + 5] = bfhi(uw[j][q].z); u[8 * q + 6] = bflo(uw[j][q].w); u[8 * q + 7] = bfhi(uw[j][q].w); }
                float bur = 0.f, bui = 0.f;
#pragma unroll
                for (int h = 0; h < 16; ++h) { bur += bbr[h] * u[h]; bui += bbi[h] * u[h]; }
                const float nhr = lbr * hr - lbi * hi + bur, nhi = lbr * hi + lbi * hr + bui; hr = nhr; hi = nhi;
#pragma unroll
                for (int h = 0; h < 16; ++h) red[h * 64 + pl] = cr[h] * hr - ci[h] * hi;
                asm volatile("s_waitcnt lgkmcnt(0)" ::: "memory");
                const int hh = pl & 15, part = pl >> 4; float sum = 0.f;
#pragma unroll
                for (int q = 0; q < 16; ++q) sum += red[hh * 64 + part * 16 + q];
                sum += __shfl_xor(sum, 16); sum += __shfl_xor(sum, 32);
                if (pl < 16) Y[(size_t)(b * TPB + t) * 512 + g * 16 + pl] = sum;
                asm volatile("s_waitcnt lgkmcnt(0)" ::: "memory");
            }
        }
    }
}
__device__ __forceinline__ void phase_s5comb(const Ctx& c, int l) {
    const P& p = *c.p; const int i = l >> 1;
    const float* Yf = (const float*)(p.ws + WS_S5); const float* Yb = (const float*)(p.ws + WS_XM); const bf16_t* proj = (const bf16_t*)(p.ws + WS_PROJ);
    bf16_t* yg = (bf16_t*)(p.ws + WS_YG); const float* d = p.in[19] + i * 512;
    const size_t n4 = (size_t)MTOK * 512 / 4;
    for (size_t e = (size_t)blockIdx.x * NTHREADS + c.tid; e < n4; e += (size_t)gridDim.x * NTHREADS) {
        const size_t row = e / 128; const int col = (int)(e % 128) * 4;
        const f32x4 a = *(const f32x4*)(Yf + row * 512 + col), b = *(const f32x4*)(Yb + row * 512 + col), dv = *(const f32x4*)(d + col);
        const u32x2 xw = *(const u32x2*)(proj + row * NPROJ + 1536 + col);
        const float y0 = a.x + b.x + dv.x * bflo(xw.x), y1 = a.y + b.y + dv.y * bfhi(xw.x), y2 = a.z + b.z + dv.z * bflo(xw.y), y3 = a.w + b.w + dv.w * bfhi(xw.y);
        u32x2 o; o.x = pk2(gelu_tanh_f(y0), gelu_tanh_f(y1)); o.y = pk2(gelu_tanh_f(y2), gelu_tanh_f(y3));
        *(u32x2*)(yg + row * 512 + col) = o;
    }
}


constexpr size_t S5T_LAM = 0, S5T_BBT = 64 * 1024, S5T_CMT = 320 * 1024;
constexpr size_t WS_WST = WS_S5 + 2 * MiB;
constexpr size_t WS_SCB = WS_S5 + 5 * MiB;
constexpr size_t WS_SR = WS_S5 + 10 * MiB;
typedef float f32x16 __attribute__((ext_vector_type(16)));

__device__ __forceinline__ void phase_s5prep(const Ctx& c) {
    const P& p = *c.p;
    for (int it = c.gw; it < 2 * 2 * 32; it += c.ngw) {
        const int i = it >> 6, dir = (it >> 5) & 1, g = it & 31, pl = c.lane;
        unsigned char* tb = p.ws + WS_S5 + (size_t)i * MiB;
        const size_t dg = ((size_t)(i * 2 + dir) * 32 + g);
        const float dt = expf(p.in[14][dg]);
        const float lr = p.in[12][dg * 64 + pl], li = p.in[13][dg * 64 + pl];
        const float mag = expf(lr * dt), lbr = mag * cosf(li * dt), lbi = mag * sinf(li * dt);
        const float den = lr * lr + li * li, nre = lbr - 1.f, nim = lbi;
        const float fre = (nre * lr + nim * li) / den, fim = (nim * lr - nre * li) / den;
        float* lam = (float*)(tb + S5T_LAM) + ((size_t)(dir * 32 + g) * 64 + pl) * 2; lam[0] = lbr; lam[1] = lbi;
        bf16_t* bbt = (bf16_t*)(tb + S5T_BBT) + (size_t)(dir * 32 + g) * 2 * 64 * 16; bf16_t* cmt = (bf16_t*)(tb + S5T_CMT) + (size_t)(dir * 32 + g) * 16 * 128;
#pragma unroll
        for (int h = 0; h < 16; ++h) { const float br = p.in[15][(dg * 64 + pl) * 16 + h], bi = p.in[16][(dg * 64 + pl) * 16 + h];
            bbt[(0 * 64 + pl) * 16 + h] = (bf16_t)f2bf(fre * br - fim * bi); bbt[(1 * 64 + pl) * 16 + h] = (bf16_t)f2bf(fre * bi + fim * br);
            cmt[h * 128 + 2 * pl] = (bf16_t)f2bf(p.in[17][(dg * 16 + h) * 64 + pl]); cmt[h * 128 + 2 * pl + 1] = (bf16_t)f2bf(-p.in[18][(dg * 16 + h) * 64 + pl]); }
    }
    bf16_t* wst = (bf16_t*)(p.ws + WS_WST);
    for (size_t e = (size_t)blockIdx.x * NTHREADS + c.tid; e < (size_t)2 * 4 * 128 * 128 / 4; e += (size_t)gridDim.x * NTHREADS) {
        const f32x4 v = *(const f32x4*)(p.in[10] + e * 4); u32x2 o; o.x = pk2(v.x, v.y); o.y = pk2(v.z, v.w); *(u32x2*)(wst + e * 4) = o; }
}

__device__ __forceinline__ void phase_gmlp_fast(const Ctx& c, int l, int blk0, int nblk) {
    const P& p = *c.p; const int i = l >> 1;
    const bf16_t* proj = (const bf16_t*)(p.ws + WS_PROJ); bf16_t* mix = (bf16_t*)(p.ws + WS_MIX);
    const float* vg = p.in[9] + i * 512; const float* bs = p.in[11] + i * 4 * 128;
    const bf16_t* wst = (const bf16_t*)(p.ws + WS_WST) + (size_t)i * 4 * 128 * 128;
    char* lds = (char*)c.lds;
    float* st = (float*)(lds + 32768);
    const int wid = __builtin_amdgcn_readfirstlane(c.wid), lane = c.lane, r32 = lane & 31, hi = lane >> 5;
    char* ost = lds + 36864 + wid * 4608;
    for (int it = (int)blockIdx.x - blk0; it < 136 * 4; it += nblk) {
        const int ch = it >> 2, g = it & 3;
        __syncthreads();
        if (c.tid < 128) {
            const f32x4* vp = (const f32x4*)((const float*)(p.ws + WS_VST) + ((size_t)ch * 128 + c.tid) * 16);
            const f32x4 a0 = vp[0], a1 = vp[1], a2 = vp[2], a3 = vp[3];
            const float s1 = ((a0.x + a0.z) + (a1.x + a1.z)) + ((a2.x + a2.z) + (a3.x + a3.z)), s2 = ((a0.y + a0.w) + (a1.y + a1.w)) + ((a2.y + a2.w) + (a3.y + a3.w));
            const float mu = s1 * (1.f / 512.f); const float var = fmaxf(s2 * (1.f / 512.f) - mu * mu, 0.f);
            st[2 * c.tid] = mu; st[2 * c.tid + 1] = rsqrtf(var + EPS);
        }
        __syncthreads();
        { const int sr = c.tid >> 4, sc = (c.tid & 15) * 8;
            float gv[8];
#pragma unroll
            for (int e = 0; e < 8; ++e) gv[e] = vg[g * 128 + sc + e];
#pragma unroll
            for (int t = 0; t < 2; ++t)
#pragma unroll
                for (int hh = 0; hh < 2; ++hh) { const int q = t * 64 + hh * 32 + sr;
                    const u32x4 w = *(const u32x4*)(proj + ((size_t)ch * 128 + q) * NPROJ + 512 + g * 128 + sc);
                    const float mu = st[2 * q], rs = st[2 * q + 1];
                    u32x4 o; o.x = pk2((bflo(w.x) - mu) * rs * gv[0], (bfhi(w.x) - mu) * rs * gv[1]); o.y = pk2((bflo(w.y) - mu) * rs * gv[2], (bfhi(w.y) - mu) * rs * gv[3]);
                    o.z = pk2((bflo(w.z) - mu) * rs * gv[4], (bfhi(w.z) - mu) * rs * gv[5]); o.w = pk2((bflo(w.w) - mu) * rs * gv[6], (bfhi(w.w) - mu) * rs * gv[7]);
                    *(u32x4*)(lds + t * 16384 + attn::v_st(hh * 32 + sr, sc)) = o; }
        }
        __syncthreads();
        const int pw = wid & 3, cw = wid >> 2;
        f32x16 o0 = {}, o1 = {};
        const int vb = (int)(uintptr_t)lds + attn::v_rd_base(lane);
        const bf16_t* wrow = wst + ((size_t)g * 128 + pw * 32 + r32) * 128 + hi * 8;
#pragma unroll
        for (int t = 0; t < 2; ++t) {
            const bf16x8 pa0 = *(const bf16x8*)(wrow + t * 64), pa1 = *(const bf16x8*)(wrow + t * 64 + 16), pa2 = *(const bf16x8*)(wrow + t * 64 + 32), pa3 = *(const bf16x8*)(wrow + t * 64 + 48);
            if (cw == 0) { attn::pv_one<0>(o0, vb + t * 16384, pa0, pa1, pa2, pa3); attn::pv_one<1>(o1, vb + t * 16384, pa0, pa1, pa2, pa3); }
            else         { attn::pv_one<2>(o0, vb + t * 16384, pa0, pa1, pa2, pa3); attn::pv_one<3>(o1, vb + t * 16384, pa0, pa1, pa2, pa3); }
        }
        {
            int ob = hi * (4 * 144) + r32 * 2; asm volatile("" : "+v"(ob));
#pragma unroll
            for (int r = 0; r < 16; ++r) { const int prow0 = (r & 3) + 8 * (r >> 2); const float b = bs[g * 128 + pw * 32 + prow0 + 4 * hi];
                *(bf16_t*)(ost + ob + prow0 * 144) = (bf16_t)f2bf(o0[r] + b); *(bf16_t*)(ost + ob + prow0 * 144 + 64) = (bf16_t)f2bf(o1[r] + b); }
            asm volatile("s_waitcnt lgkmcnt(0)" ::: "memory");
#pragma unroll
            for (int k = 0; k < 4; ++k) { const int id = k * 64 + lane, row = id >> 3, chk = id & 7;
                const u32x4 mv = *(const u32x4*)(ost + row * 144 + chk * 16);
                const size_t grow = (size_t)ch * 128 + pw * 32 + row; const int col = g * 128 + cw * 64 + chk * 8;
                const u32x4 uv = *(const u32x4*)(proj + grow * NPROJ + col), gvv = *(const u32x4*)(proj + grow * NPROJ + 1024 + col);
                u32x4 w; w.x = pk2(bflo(uv.x) * bflo(mv.x) * bflo(gvv.x), bfhi(uv.x) * bfhi(mv.x) * bfhi(gvv.x)); w.y = pk2(bflo(uv.y) * bflo(mv.y) * bflo(gvv.y), bfhi(uv.y) * bfhi(mv.y) * bfhi(gvv.y));
                w.z = pk2(bflo(uv.z) * bflo(mv.z) * bflo(gvv.z), bfhi(uv.z) * bfhi(mv.z) * bfhi(gvv.z)); w.w = pk2(bflo(uv.w) * bflo(mv.w) * bflo(gvv.w), bfhi(uv.w) * bfhi(mv.w) * bfhi(gvv.w));
                *(u32x4*)(mix + grow * DM + col) = w; }
            asm volatile("s_waitcnt lgkmcnt(0)" ::: "memory");
        }
    }
}

struct cplx { float r, i; };
__device__ __forceinline__ cplx cmul(cplx a, cplx b) { return {a.r * b.r - a.i * b.i, a.r * b.i + a.i * b.r}; }
__device__ __forceinline__ cplx cfma(cplx a, cplx x, cplx b) { return {fmaf(a.r, x.r, fmaf(-a.i, x.i, b.r)), fmaf(a.r, x.i, fmaf(a.i, x.r, b.i))}; }
__device__ __forceinline__ cplx csel(bool s, cplx a, cplx b) { return {s ? a.r : b.r, s ? a.i : b.i}; }
template <bool BWD, bool FINAL>
__device__ __forceinline__ void s5_chunk_scan(f32x16 (&br)[2], f32x16 (&bi)[2], const cplx lam, const cplx Hin, const bool half, cplx& Hout) {
    const cplx lam2 = cmul(lam, lam), lam3 = cmul(lam2, lam), lam4 = cmul(lam2, lam2);
    cplx E[2][4];
#pragma unroll
    for (int tb = 0; tb < 2; ++tb)
#pragma unroll
        for (int q = 0; q < 4; ++q) {
            if (!BWD) { cplx w = {br[tb][4 * q], bi[tb][4 * q]};
#pragma unroll
                for (int j = 1; j < 4; ++j) { w = cfma(lam, w, (cplx){br[tb][4 * q + j], bi[tb][4 * q + j]}); br[tb][4 * q + j] = w.r; bi[tb][4 * q + j] = w.i; }
                E[tb][q] = w; }
            else { cplx w = {br[tb][4 * q + 3], bi[tb][4 * q + 3]};
#pragma unroll
                for (int j = 2; j >= 0; --j) { w = cfma(lam, w, (cplx){br[tb][4 * q + j], bi[tb][4 * q + j]}); br[tb][4 * q + j] = w.r; bi[tb][4 * q + j] = w.i; }
                E[tb][q] = w; }
        }
    cplx Eev[2][4], Eod[2][4];
#pragma unroll
    for (int tb = 0; tb < 2; ++tb)
#pragma unroll
        for (int q = 0; q < 4; ++q) {
            const auto rr = __builtin_amdgcn_permlane32_swap(__float_as_uint(E[tb][q].r), __float_as_uint(E[tb][q].r), false, false);
            const auto ri = __builtin_amdgcn_permlane32_swap(__float_as_uint(E[tb][q].i), __float_as_uint(E[tb][q].i), false, false);
            Eev[tb][q] = {__uint_as_float(rr[0]), __uint_as_float(ri[0])}; Eod[tb][q] = {__uint_as_float(rr[1]), __uint_as_float(ri[1])}; }
    cplx H = Hin; cplx Hg[2][4];
    if (!BWD) {
#pragma unroll
        for (int tb = 0; tb < 2; ++tb)
#pragma unroll
            for (int q = 0; q < 4; ++q) { const cplx He = H; H = cfma(lam4, H, Eev[tb][q]); const cplx Ho = H; H = cfma(lam4, H, Eod[tb][q]); Hg[tb][q] = csel(half, Ho, He); }
    } else {
#pragma unroll
        for (int tb = 1; tb >= 0; --tb)
#pragma unroll
            for (int q = 3; q >= 0; --q) { const cplx Ho = H; H = cfma(lam4, H, Eod[tb][q]); const cplx He = H; H = cfma(lam4, H, Eev[tb][q]); Hg[tb][q] = csel(half, Ho, He); }
    }
    Hout = H;
    if (FINAL) {
#pragma unroll
        for (int tb = 0; tb < 2; ++tb)
#pragma unroll
            for (int q = 0; q < 4; ++q)
#pragma unroll
                for (int j = 0; j < 4; ++j) { const int e = BWD ? 3 - j : j; const cplx pw = e == 0 ? lam : (e == 1 ? lam2 : (e == 2 ? lam3 : lam4));
                    const cplx h = cfma(pw, Hg[tb][q], (cplx){br[tb][4 * q + j], bi[tb][4 * q + j]}); br[tb][4 * q + j] = h.r; bi[tb][4 * q + j] = h.i; }
    }
}
__device__ __forceinline__ cplx cpow2n(cplx a, int n) { for (int k = 0; k < n; ++k) a = cmul(a, a); return a; }
__device__ __forceinline__ cplx ldc(const float* p) { const float2 v = *(const float2*)p; return {v.x, v.y}; }

__device__ __forceinline__ int s5_rs(int rk) { return rk == 0 ? 0 : (rk <= 4 ? 4 + 5 * (rk - 1) : 24 + 4 * (rk - 5)); }
__device__ __forceinline__ int s5_rl(int rk) { return (rk >= 1 && rk <= 4) ? 5 : 4; }
constexpr int S5L_LAM = 0, S5L_BB = 1024, S5L_CM = 1024 + 8192, S5L_HS = 1024 + 16384, S5L_HB = S5L_HS + 8 * 4608, S5L_END = S5L_HB + 8 * 2560;
template <bool OUT>
__device__ __forceinline__ void phase_s5_fast(const Ctx& c, int l) {
    const P& p = *c.p; const int i = l >> 1;
    const bf16_t* proj = (const bf16_t*)(p.ws + WS_PROJ);
    const unsigned char* tb_ = p.ws + WS_S5 + (size_t)i * MiB;
    float* SCB = (float*)(p.ws + WS_SCB); float* SR = (float*)(p.ws + WS_SR); bf16_t* yg = (bf16_t*)(p.ws + WS_YG);
    const int wid = __builtin_amdgcn_readfirstlane(c.wid);
    char* lds = (char*)c.lds;
    const int G = gridDim.x, nsub = G >> 5;
    if ((int)blockIdx.x >= nsub * 32) return;
    const int g = blockIdx.x & 31, sub = blockIdx.x >> 5;
    __syncthreads();
    {
        const float* LAM = (const float*)(tb_ + S5T_LAM); const bf16_t* BBT = (const bf16_t*)(tb_ + S5T_BBT); const bf16_t* CMT = (const bf16_t*)(tb_ + S5T_CMT);
        const int ln = c.lane, r32 = ln & 31, hi = ln >> 5;
        if (c.tid < 128) { const int d = c.tid >> 6, ps = c.tid & 63; *(float2*)(lds + S5L_LAM + (d * 64 + ps) * 8) = *(const float2*)(LAM + ((size_t)(d * 32 + g) * 64 + ps) * 2); }
        { const int d = wid >> 2, ri = (wid >> 1) & 1, pb = wid & 1;
            *(u32x4*)(lds + S5L_BB + (wid * 64 + ln) * 16) = *(const u32x4*)(BBT + (((size_t)(d * 32 + g) * 2 + ri) * 64 + pb * 32 + r32) * 16 + hi * 8); }
        { const int d = wid >> 2, pb = (wid >> 1) & 1, ks = wid & 1;
            *(u32x4*)(lds + S5L_CM + (wid * 64 + ln) * 16) = *(const u32x4*)(CMT + ((size_t)(d * 32 + g) * 16 + (ln & 15)) * 128 + pb * 64 + ks * 32 + (ln >> 4) * 8); }
    }
    __syncthreads();
    char* hs = lds + S5L_HS + wid * 4608;
#pragma unroll 1
    for (int j = sub * 8 + wid; j < 64; j += nsub * 8) {
        int lane = c.lane; asm volatile("" : "+v"(lane));
        const int r32 = lane & 31; const bool half = lane >= 32;
        const int b = j >> 4, rk = j & 15, c0 = s5_rs(rk), nc = s5_rl(rk);
        const size_t m0 = (size_t)b * TPB + 64 * c0;
        cplx Hf[2];
        float* hb = (float*)(lds + S5L_HB + wid * 2560);
        cplx SRf[2], SRb[2], pwb[2];
#pragma unroll
        for (int pb = 0; pb < 2; ++pb) { Hf[pb] = {0.f, 0.f}; SRf[pb] = {0.f, 0.f}; SRb[pb] = {0.f, 0.f}; pwb[pb] = {1.f, 0.f};
}
        if (OUT) {
            constexpr size_t KS = 32 * 2 * 64 * 2, CS = 32 * 64 * 2;
            cplx vf[2][15], vb[2][16], sv[2][5];
#pragma unroll
            for (int pb = 0; pb < 2; ++pb) { const int ps = pb * 32 + r32;
                const float* srb = SR + (((size_t)(b * 16) * 32 + g) * 2 * 64 + ps) * 2;
                const float* scb = SCB + ((((size_t)b * 68 + c0) * 32 + g) * 64 + ps) * 2;
#pragma unroll
                for (int kk = 0; kk < 15; ++kk) vf[pb][kk] = ldc(srb + kk * KS);
#pragma unroll
                for (int kk = 0; kk < 16; ++kk) vb[pb][kk] = ldc(srb + kk * KS + 128);
#pragma unroll
                for (int q = 1; q < 5; ++q) sv[pb][q] = (q < nc) ? ldc(scb + q * CS) : (cplx){0.f, 0.f}; }
#pragma unroll
            for (int pb = 0; pb < 2; ++pb) { const int ps = pb * 32 + r32;
                { const cplx L64 = cpow2n(ldc((const float*)(lds + S5L_LAM + (0 * 64 + ps) * 8)), 6), L256 = cpow2n(L64, 2), L320 = cmul(L256, L64);
                    cplx H = {0.f, 0.f};
#pragma unroll
                    for (int kk = 0; kk < 15; ++kk) if (kk < rk) H = cfma((kk >= 1 && kk <= 4) ? L320 : L256, H, vf[pb][kk]);
                    Hf[pb] = H; }
                { const cplx L64 = cpow2n(ldc((const float*)(lds + S5L_LAM + (1 * 64 + ps) * 8)), 6), L256 = cpow2n(L64, 2), L320 = cmul(L256, L64);
                    cplx H = {0.f, 0.f};
                    if (rk >= 1) { H = vb[pb][0];
#pragma unroll
                        for (int kk = 15; kk >= 2; --kk) if (kk > rk) H = cfma((kk >= 1 && kk <= 4) ? L320 : L256, H, vb[pb][kk]); }
#define HB_ST(q, Hv) do { if (!half) { float2 o_; o_.x = (Hv).r; o_.y = (Hv).i; *(float2*)(hb + ((pb * 5 + (q)) * 32 + r32) * 2) = o_; } } while (0)
                    if (nc == 5) { HB_ST(4, H); H = cfma(L64, H, sv[pb][4]); }
                    HB_ST(3, H); H = cfma(L64, H, sv[pb][3]); HB_ST(2, H); H = cfma(L64, H, sv[pb][2]); HB_ST(1, H); H = cfma(L64, H, sv[pb][1]); HB_ST(0, H); }
#undef HB_ST
            }
        }
        asm volatile("s_waitcnt lgkmcnt(0)" ::: "memory");
        bf16x8 dfr;
        { const int hh = lane & 15, l4 = lane >> 4; const unsigned dv = f2bf(p.in[19][i * 512 + g * 16 + hh]);
#pragma unroll
            for (int e = 0; e < 8; ++e) dfr[e] = (short)((8 * l4 + e == hh) ? dv : 0u); }
        bf16x8 ua[2];
#pragma unroll
        for (int tb = 0; tb < 2; ++tb) ua[tb] = *(const bf16x8*)(proj + (m0 + tb * 32 + r32) * NPROJ + 1536 + g * 16 + (lane >> 5) * 8);
#pragma unroll 1
        for (int cc = 0; cc < nc; ++cc) {
            int ln = lane; asm volatile("" : "+v"(ln));
            const int r32c = ln & 31, hi = ln >> 5, l15 = ln & 15, l4 = ln >> 4;
            const size_t mc = m0 + 64 * cc; const size_t chunk = (size_t)b * 68 + c0 + cc;
            const bf16x8 u0 = ua[0], u1 = ua[1];
            if (cc + 1 < nc) {
#pragma unroll
                for (int tb = 0; tb < 2; ++tb) ua[tb] = *(const bf16x8*)(proj + (mc + 64 + tb * 32 + r32c) * NPROJ + 1536 + g * 16 + hi * 8); }
            f32x4 yacc[4];
            if (OUT) {
                *(bf16x8*)(hs + r32c * 32 + hi * 16) = u0; *(bf16x8*)(hs + (32 + r32c) * 32 + hi * 16) = u1;
                asm volatile("s_waitcnt lgkmcnt(0)" ::: "memory");
#pragma unroll
                for (int t = 0; t < 4; ++t) { bf16x8 xa = (bf16x8){0, 0, 0, 0, 0, 0, 0, 0};
                    if (l4 < 2) xa = *(const bf16x8*)(hs + (t * 16 + l15) * 32 + l4 * 16);
                    yacc[t] = __builtin_amdgcn_mfma_f32_16x16x32_bf16(xa, dfr, (f32x4){0.f, 0.f, 0.f, 0.f}, 0, 0, 0); }
                asm volatile("s_waitcnt lgkmcnt(0)" ::: "memory");
            }
#pragma unroll
            for (int pb = 0; pb < 2; ++pb)
#pragma unroll 1
                for (int d = 0; d < 2; ++d) {
                    const cplx lam_ = ldc((const float*)(lds + S5L_LAM + (d * 64 + pb * 32 + r32c) * 8)); const cplx L64_ = cpow2n(lam_, 6);
                    const bf16x8 bre = *(const bf16x8*)(lds + S5L_BB + (((d * 2 + 0) * 2 + pb) * 64 + ln) * 16), bim = *(const bf16x8*)(lds + S5L_BB + (((d * 2 + 1) * 2 + pb) * 64 + ln) * 16);
                    f32x16 br[2], bi[2];
                    br[0] = __builtin_amdgcn_mfma_f32_32x32x16_bf16(u0, bre, (f32x16){}, 0, 0, 0); bi[0] = __builtin_amdgcn_mfma_f32_32x32x16_bf16(u0, bim, (f32x16){}, 0, 0, 0);
                    br[1] = __builtin_amdgcn_mfma_f32_32x32x16_bf16(u1, bre, (f32x16){}, 0, 0, 0); bi[1] = __builtin_amdgcn_mfma_f32_32x32x16_bf16(u1, bim, (f32x16){}, 0, 0, 0);
                    cplx Hin = {0.f, 0.f}, Hout;
                    if (OUT) { if (d == 0) Hin = Hf[pb]; else Hin = ldc(hb + ((pb * 5 + cc) * 32 + r32c) * 2); }
                    if (d == 0) s5_chunk_scan<false, OUT>(br, bi, lam_, Hin, half, Hout); else s5_chunk_scan<true, OUT>(br, bi, lam_, Hin, half, Hout);
                    if (OUT) {
                        if (d == 0) Hf[pb] = Hout;
#pragma unroll
                        for (int tb = 0; tb < 2; ++tb) {
                            int ob = hi * (4 * 144) + r32c * 4; asm volatile("" : "+v"(ob));
#pragma unroll
                            for (int r = 0; r < 16; ++r) *(unsigned*)(hs + ob + ((r & 3) + 8 * (r >> 2)) * 144) = pk2(br[tb][r], bi[tb][r]);
                            asm volatile("s_waitcnt lgkmcnt(0)" ::: "memory");
#pragma unroll
                            for (int ks = 0; ks < 2; ++ks) { const bf16x8 cf = *(const bf16x8*)(lds + S5L_CM + (((d * 2 + pb) * 2 + ks) * 64 + ln) * 16);
#pragma unroll
                                for (int tq = 0; tq < 2; ++tq) { const bf16x8 af = *(const bf16x8*)(hs + (tq * 16 + l15) * 144 + ks * 64 + l4 * 16);
                                    yacc[tb * 2 + tq] = __builtin_amdgcn_mfma_f32_16x16x32_bf16(af, cf, yacc[tb * 2 + tq], 0, 0, 0); } }
                            asm volatile("s_waitcnt lgkmcnt(0)" ::: "memory");
                        }
                    } else {
                        if (d == 0) SRf[pb] = cfma(L64_, SRf[pb], Hout);
                        else { SRb[pb] = cfma(pwb[pb], Hout, SRb[pb]); pwb[pb] = cmul(pwb[pb], L64_);
                            if (!half) { float2 o; o.x = Hout.r; o.y = Hout.i; *(float2*)(SCB + ((chunk * 32 + g) * 64 + pb * 32 + r32c) * 2) = o; } }
                    }
                }
            if (OUT) {
#pragma unroll
                for (int tq = 0; tq < 4; ++tq)
#pragma unroll
                    for (int e = 0; e < 4; ++e) *(bf16_t*)(hs + (tq * 16 + l4 * 4 + e) * 48 + l15 * 2) = (bf16_t)f2bf(gelu_tanh_f(yacc[tq][e]));
                asm volatile("s_waitcnt lgkmcnt(0)" ::: "memory");
#pragma unroll
                for (int q = 0; q < 2; ++q) { const int id = q * 64 + ln, row = id >> 1, hf = id & 1;
                    *(u32x4*)(yg + (mc + row) * 512 + g * 16 + hf * 8) = *(const u32x4*)(hs + row * 48 + hf * 16); }
                asm volatile("s_waitcnt lgkmcnt(0)" ::: "memory");
            }
        }
        if (!OUT) {
            if (!half) {
#pragma unroll
                for (int pb = 0; pb < 2; ++pb) { float2 o; o.x = SRf[pb].r; o.y = SRf[pb].i; *(float2*)(SR + ((((size_t)(b * 16 + rk) * 32 + g) * 2 + 0) * 64 + pb * 32 + r32) * 2) = o;
                    o.x = SRb[pb].r; o.y = SRb[pb].i; *(float2*)(SR + ((((size_t)(b * 16 + rk) * 32 + g) * 2 + 1) * 64 + pb * 32 + r32) * 2) = o; }
            }
        }
    }
    __syncthreads();
}

__device__ __forceinline__ void phase_headnorm(const Ctx& c, int l) {
    const P& p = *c.p; const int i = l >> 1;
    bf16_t* proj = (bf16_t*)(p.ws + WS_PROJ); const float* rope = (const float*)(p.ws + WS_ROPE);
    for (int it = c.gw; it < MTOK * 10; it += c.ngw) {
        const int m = it / 10, hd = it % 10; const int col0 = hd < 8 ? hd * 128 : 1024 + (hd - 8) * 128;
        const float* g = (hd < 8 ? p.in[24] : p.in[25]) + i * 128;
        const int a = c.lane >> 5, pr = c.lane & 31, i1 = a * 64 + pr, i2 = i1 + 32;
        bf16_t* hp = proj + (size_t)m * NPROJ + col0;
        const float x1 = bf2f(hp[i1]), x2 = bf2f(hp[i2]);
        const float hr = rsqrtf(wave_sum(x1 * x1 + x2 * x2) * (1.f / 128.f) + EPS);
        float y1 = x1 * hr * g[i1], y2 = x2 * hr * g[i2];
        const int t = m % TPB;
        if (t >= NCTX) { const int tl = t - NCTX; const int pos = a == 0 ? tl / 64 : tl % 64; const float cs = rope[2 * (pos * 32 + pr)], sn = rope[2 * (pos * 32 + pr) + 1];
            const float o1 = y1 * cs - y2 * sn, o2 = y1 * sn + y2 * cs; y1 = o1; y2 = o2; }
        hp[i1] = (bf16_t)f2bf(y1); hp[i2] = (bf16_t)f2bf(y2);
    }
}
__device__ __forceinline__ void phase_attn_naive(const Ctx& c, int l) {
    const P& p = *c.p;
    const bf16_t* proj = (const bf16_t*)(p.ws + WS_PROJ); bf16_t* mix = (bf16_t*)(p.ws + WS_MIX);
    float* sc = (float*)c.lds + c.wid * TPB;
    const bool with_ctx = l != DEPTH - 1;
    const int nit = with_ctx ? MTOK : NB * SEQ;
    const float scale = 0.08838834764831845f;
    for (int it = blockIdx.x; it < nit; it += gridDim.x) {
        int m; if (with_ctx) m = it; else { const int b = it / SEQ; m = b * TPB + NCTX + (it - b * SEQ); }
        const int b = m / TPB, t = m - b * TPB; const int nk = t < NCTX ? NCTX : TPB;
        const int hq = c.wid, kv = hq >> 2;
        const bf16_t* qp = proj + (size_t)m * NPROJ + hq * 128;
        float* qs = (float*)(c.lds + 140 * 1024) + c.wid * 128;
        { const unsigned w = *(const unsigned*)(qp + 2 * c.lane); qs[2 * c.lane] = bflo(w); qs[2 * c.lane + 1] = bfhi(w); }
        asm volatile("s_waitcnt lgkmcnt(0)" ::: "memory");
        float mx = -1e30f;
        for (int j0 = 0; j0 < nk; j0 += 64) {
            const bf16_t* kp = proj + (size_t)(b * TPB + j0 + c.lane) * NPROJ + 1024 + kv * 128;
            float s = 0.f;
#pragma unroll 4
            for (int d8 = 0; d8 < 16; ++d8) { const u32x4 w = *(const u32x4*)(kp + d8 * 8); const f32x4 qa = *(const f32x4*)(qs + d8 * 8), qb = *(const f32x4*)(qs + d8 * 8 + 4);
                s += qa.x * bflo(w.x) + qa.y * bfhi(w.x) + qa.z * bflo(w.y) + qa.w * bfhi(w.y) + qb.x * bflo(w.z) + qb.y * bfhi(w.z) + qb.z * bflo(w.w) + qb.w * bfhi(w.w); }
            s *= scale; sc[j0 + c.lane] = s; mx = fmaxf(mx, s);
        }
#pragma unroll
        for (int o = 1; o < 64; o <<= 1) mx = fmaxf(mx, __shfl_xor(mx, o));
        float ls = 0.f;
        for (int j0 = 0; j0 < nk; j0 += 64) { const float e = __expf(sc[j0 + c.lane] - mx); sc[j0 + c.lane] = e; ls += e; }
        ls = wave_sum(ls);
        asm volatile("s_waitcnt lgkmcnt(0)" ::: "memory");
        float o0 = 0.f, o1 = 0.f;
        const bf16_t* vp = proj + (size_t)(b * TPB) * NPROJ + 1280 + kv * 128 + 2 * c.lane;
#pragma unroll 4
        for (int j = 0; j < nk; ++j) { const unsigned w = *(const unsigned*)(vp + (size_t)j * NPROJ); const float pj = sc[j]; o0 += pj * bflo(w); o1 += pj * bfhi(w); }
        const float inv = 1.f / ls;
        const unsigned gw_ = *(const unsigned*)(proj + (size_t)m * NPROJ + 1536 + hq * 128 + 2 * c.lane);
        *(unsigned*)(mix + (size_t)m * DM + hq * 128 + 2 * c.lane) = pk2(o0 * inv * bflo(gw_), o1 * inv * bfhi(gw_));
        asm volatile("s_waitcnt lgkmcnt(0)" ::: "memory");
    }
}


__device__ __forceinline__ void phase_attn(const Ctx& c, int l) {
    const P& p = *c.p;
    const bf16_t* proj = (const bf16_t*)(p.ws + WS_PROJ); bf16_t* mix = (bf16_t*)(p.ws + WS_MIX);
    const int G = gridDim.x, bid = blockIdx.x; const int vcu = (G % 8 == 0) ? (bid % 8) * (G / 8) + bid / 8 : bid;
    const int nu = 512 + (l != DEPTH - 1 ? 32 : 0);
    for (int u = vcu; u < nu; u += G) {
        int b, hq, row0, seq;
        if (u < 512) { const int qb = u & 15, hql = (u >> 4) & 3, kvh = (u >> 6) & 1; b = u >> 7; hq = kvh * 4 + hql; row0 = b * TPB + NCTX + qb * 256; seq = TPB; }
        else { const int v = u - 512; b = v >> 3; hq = v & 7; row0 = b * TPB; seq = NCTX; }
        const int kv = hq >> 2;
        const bf16_t* kvb = proj + (size_t)b * TPB * NPROJ;
        attn::attn_dense_body<bf16_t>(proj + (size_t)row0 * NPROJ + hq * 128, kvb + 1024 + kv * 128, kvb + 1280 + kv * 128,
                                      mix + (size_t)row0 * DM + hq * 128, proj + (size_t)row0 * NPROJ + 1536 + hq * 128, seq, (char*)c.lds, c.tid);
        __syncthreads();
    }
}

__device__ __forceinline__ void phase_final(const Ctx& c) {
    const P& p = *c.p; const float* g = p.in[26]; const bf16_t* xb = (const bf16_t*)(p.ws + WS_XB); const float* rss = (const float*)(p.ws + WS_RSS);
    for (int m0 = 4 * c.gw; m0 < NB * SEQ; m0 += 4 * c.ngw) {
        u32x4 w[4][2]; float rs[4];
#pragma unroll
        for (int rr = 0; rr < 4; ++rr) { const int m = m0 + rr; const int b = m / SEQ, t = m - b * SEQ; const size_t grow = (size_t)b * TPB + NCTX + t;
#pragma unroll
            for (int hh = 0; hh < 2; ++hh) w[rr][hh] = *(const u32x4*)(xb + (size_t)m * DM + hh * 512 + c.lane * 8);
            const f32x4* rp = (const f32x4*)(rss + grow * 16); const f32x4 s0 = rp[0], s1 = rp[1], s2 = rp[2], s3 = rp[3];
            rs[rr] = rsqrtf((((s0.x + s0.y) + (s0.z + s0.w)) + ((s1.x + s1.y) + (s1.z + s1.w)) + ((s2.x + s2.y) + (s2.z + s2.w)) + ((s3.x + s3.y) + (s3.z + s3.w))) * (1.f / DM) + EPS); }
#pragma unroll
        for (int rr = 0; rr < 4; ++rr)
#pragma unroll
            for (int hh = 0; hh < 2; ++hh) { const int col = hh * 512 + c.lane * 8; const f32x4 g0 = *(const f32x4*)(g + col), g1 = *(const f32x4*)(g + col + 4); const u32x4 v = w[rr][hh]; const float r_ = rs[rr];
                float* o = p.out + (size_t)(m0 + rr) * DM + col;
                *(f32x4*)o = (f32x4){bflo(v.x) * r_ * g0.x, bfhi(v.x) * r_ * g0.y, bflo(v.y) * r_ * g0.z, bfhi(v.y) * r_ * g0.w};
                *(f32x4*)(o + 4) = (f32x4){bflo(v.z) * r_ * g1.x, bfhi(v.z) * r_ * g1.y, bflo(v.w) * r_ * g1.z, bfhi(v.w) * r_ * g1.w}; }
    }
}

enum { K_PREP_A, K_PREP_B, K_IN, K_EVENMIX, K_S5COMB, K_GLU, K_OUT, K_XPREP, K_HEADNORM, K_ATTN, K_FINAL };
#ifdef DUP_PH
constexpr int NPH = 20, NPHT = 19;
#else
constexpr int NPH = 19, NPHT = 19;
#endif
__device__ __forceinline__ void phase_decode(int ph, int& kind, int& layer) {
    constexpr int kinds[NPHT] = {K_PREP_A, K_PREP_B,
        K_IN, K_EVENMIX, K_S5COMB, K_GLU, K_OUT,
        K_IN, K_ATTN, K_OUT,
        K_IN, K_EVENMIX, K_S5COMB, K_GLU, K_OUT,
        K_IN, K_ATTN, K_OUT, K_FINAL};
    constexpr int layers[NPHT] = {0, 0, 0, 0, 0, 0, 0, 1, 1, 1, 2, 2, 2, 2, 2, 3, 3, 3, 0};
#ifdef DUP_PH
    if (ph > DUP_PH) --ph;
#endif
    kind = kinds[ph]; layer = layers[ph];
}

template <int ONLY> __device__ __forceinline__ void mega_body(const P& p) {
    extern __shared__ __attribute__((aligned(16))) unsigned char lds[];
    const int wave_u = __builtin_amdgcn_readfirstlane((int)threadIdx.x >> 6);
    if (threadIdx.x == 0) { volatile LAS unsigned long long* tab = (volatile LAS unsigned long long*)((LAS unsigned char*)lds + TAB_OFF);
#pragma unroll
        for (int i = 0; i < 27; ++i) tab[i] = (unsigned long long)p.in[i];
        tab[27] = (unsigned long long)p.out; tab[28] = (unsigned long long)p.ws; }
    if (threadIdx.x < 2) ((volatile LAS unsigned*)((LAS unsigned char*)lds + TAB_OFF + 240))[threadIdx.x] = 0u;
    __syncthreads();
    XcdBarrier bar = xcd_barrier_post((unsigned*)(p.ws + WS_CTL), (volatile LAS unsigned*)((LAS unsigned char*)lds + TAB_OFF + 240));
    for (int ph = p.ph_lo; ph < p.ph_hi; ++ph) {
        int kind, l; phase_decode(ph, kind, l);
        if (ONLY >= 0 && kind != ONLY) continue;
        unsigned z_ = 0u; asm volatile("" : "+v"(z_));
        int tid_ = (wave_u << 6) | (int)__builtin_amdgcn_mbcnt_hi(~0u, __builtin_amdgcn_mbcnt_lo(~0u, z_));
        P q;
        { unsigned tbo = TAB_OFF; asm volatile("" : "+v"(tbo));
          const volatile LAS unsigned* tab = (const volatile LAS unsigned*)((LAS unsigned char*)lds + tbo);
#pragma unroll
          for (int i = 0; i < 27; ++i) { const unsigned lo = __builtin_amdgcn_readfirstlane(tab[2 * i]), hi = __builtin_amdgcn_readfirstlane(tab[2 * i + 1]); q.in[i] = (const float*)(const __attribute__((address_space(1))) float*)(((unsigned long long)hi << 32) | lo); }
          { const unsigned lo = __builtin_amdgcn_readfirstlane(tab[54]), hi = __builtin_amdgcn_readfirstlane(tab[55]); q.out = (float*)(__attribute__((address_space(1))) float*)(((unsigned long long)hi << 32) | lo); }
          { const unsigned lo = __builtin_amdgcn_readfirstlane(tab[56]), hi = __builtin_amdgcn_readfirstlane(tab[57]); q.ws = (unsigned char*)(__attribute__((address_space(1))) unsigned char*)(((unsigned long long)hi << 32) | lo); }
          q.ph_lo = p.ph_lo; q.ph_hi = p.ph_hi; }
        Ctx c; c.p = &q; c.tid = tid_; c.wid = wave_u; c.lane = c.tid & 63; c.gw = blockIdx.x * NWAVES + c.wid; c.ngw = gridDim.x * NWAVES; c.lds = lds;
        switch (kind) {
            case K_PREP_A: phase_prep_a(c); phase_s5prep(c); phase_transposes(c); break;
            case K_PREP_B: phase_bias(c); phase_xprep(c, 0, q.in[0], q.in[2]);
#if defined(DUPX) && DUPX == 4
                phase_bias(c);
#elif defined(DUPX) && DUPX == 5
                phase_xprep(c, 0, q.in[0], q.in[2]);
#elif defined(DUPX) && DUPX == 6
                phase_transposes(c);
#endif
                break;
            case K_IN: phase_in(c, l); break;
#ifdef USE_S5
#ifdef USE_GMLP
            case K_EVENMIX:
                phase_s5_fast<false>(c, l);
#if defined(DUPX) && DUPX == 2
                phase_s5_fast<false>(c, l);
#endif
                break;
#else
            case K_EVENMIX: phase_gmlp(c, l); phase_s5_fast<false>(c, l); break;
#endif
            case K_S5COMB: phase_s5_fast<true>(c, l); break;
#else
#ifdef USE_GMLP
            case K_EVENMIX: phase_gmlp_fast(c, l, 0, (int)gridDim.x); phase_s5_naive(c, l); break;
#else
            case K_EVENMIX: phase_gmlp(c, l); phase_s5_naive(c, l); break;
#endif
            case K_S5COMB: phase_s5comb(c, l); break;
#endif
            case K_GLU: phase_glu(c, l); break;
            case K_OUT: phase_out(c, l); break;
            case K_XPREP: phase_xprep(c, l, q.out, (const float*)(q.ws + WS_CTXRES)); break;
            case K_HEADNORM: phase_headnorm(c, l); break;
#ifdef USE_ATTN
            case K_ATTN: phase_attn(c, l); break;
#else
            case K_ATTN: phase_attn_naive(c, l); break;
#endif
            case K_FINAL: phase_final(c); break;
        }
        if (ph + 1 < p.ph_hi) xcd_barrier(bar);
    }
}

__global__ void __launch_bounds__(NTHREADS) k_mega(P p) { mega_body<-1>(p); }
#ifdef PERKIND
template <int KIND> __global__ void __launch_bounds__(NTHREADS) k_one(P p) { mega_body<KIND>(p); }
template __global__ void k_one<0>(P); template __global__ void k_one<1>(P); template __global__ void k_one<2>(P); template __global__ void k_one<3>(P); template __global__ void k_one<4>(P); template __global__ void k_one<5>(P);
template __global__ void k_one<6>(P); template __global__ void k_one<7>(P); template __global__ void k_one<8>(P); template __global__ void k_one<9>(P); template __global__ void k_one<10>(P);
#endif


extern "C" void kernel_launch(void* const* d_in, const int* in_sizes, int n_in, void* d_out, int out_size, void* d_ws, size_t ws_size, hipStream_t stream) {
    static int grid = 0;
    if (grid == 0) {
        if (n_in != 27 || out_size != NB * SEQ * DM || ws_size < WS_END) { fprintf(stderr, "kernel_launch: unexpected shapes n_in %d out %d ws %zu\n", n_in, out_size, ws_size); grid = -1; return; }
        int dev = 0, cus = 0, per_cu = 0;
        hipGetDevice(&dev); hipDeviceGetAttribute(&cus, hipDeviceAttributeMultiprocessorCount, dev);
        hipFuncSetAttribute((const void*)k_mega, hipFuncAttributeMaxDynamicSharedMemorySize, LDS_BYTES);
        hipOccupancyMaxActiveBlocksPerMultiprocessor(&per_cu, (const void*)k_mega, NTHREADS, LDS_BYTES);
        if (per_cu < 1) { fprintf(stderr, "kernel_launch: occupancy query says %d blocks per CU\n", per_cu); per_cu = 1; }
        grid = cus * 1;
        fprintf(stderr, "kernel_launch: cus %d per_cu %d grid %d\n", cus, per_cu, grid);
    }
    if (grid < 0) return;
    hipMemsetAsync((char*)d_ws + WS_CTL, 0, 16384, stream);
    P p{};
    for (int i = 0; i < 27; ++i) p.in[i] = (const float*)d_in[i];
    p.out = (float*)d_out; p.ws = (unsigned char*)d_ws;
#ifdef ONE_LAUNCH
    p.ph_lo = 0; p.ph_hi = NPH;
    void* args[] = {&p};
    hipError_t e = hipLaunchCooperativeKernel((void*)k_mega, dim3(grid), dim3(NTHREADS), args, LDS_BYTES, stream);
    if (e != hipSuccess) fprintf(stderr, "cooperative launch failed: %s\n", hipGetErrorString(e));
#else
    for (int ph = 0; ph < NPH; ++ph) {
        p.ph_lo = ph; p.ph_hi = ph + 1;
        hipLaunchKernelGGL(k_mega, dim3(grid), dim3(NTHREADS), LDS_BYTES, stream, p);
    }
#endif
}
```

```cpp
#include <hip/hip_runtime.h>
#include <hip/hip_cooperative_groups.h>
#include <cstdio>
#include <cstdint>
namespace cg = cooperative_groups;
#define ONE_LAUNCH 1
#define USE_PG8 1
#define USE_ATTN 1
#define USE_S5 1
#define USE_GMLP 1

constexpr int DM = 1024, NB = 4, SEQ = 4096, NCTX = 256, TPB = NCTX + SEQ, MTOK = NB * TPB;
constexpr int NPROJ = 2560, DEPTH = 4;
constexpr float EPS = 1e-6f;
constexpr int NTHREADS = 512, NWAVES = 8;
constexpr int TAB_OFF = 147456, LDS_BYTES = TAB_OFF + 512;

typedef unsigned short bf16_t;
typedef short bf16x8 __attribute__((ext_vector_type(8)));
typedef float f32x4 __attribute__((ext_vector_type(4)));
typedef unsigned u32x2 __attribute__((ext_vector_type(2)));
typedef unsigned u32x4 __attribute__((ext_vector_type(4)));

constexpr size_t MiB = 1u << 20;
constexpr size_t WS_CTL = 0;
constexpr size_t WS_MODS = 1 * MiB;
constexpr size_t WS_BIAS = 1 * MiB + 512 * 1024;
constexpr size_t WS_RSS = 2 * MiB;
constexpr size_t WS_ROPE = 3 * MiB + 512 * 1024;
constexpr size_t WS_CTXRES = 4 * MiB;
constexpr size_t WS_WIN = 8 * MiB;
constexpr size_t WS_WOUT = 28 * MiB;
constexpr size_t WS_WGLU = 36 * MiB;
constexpr size_t WS_XM = 38 * MiB;
constexpr size_t WS_PROJ = 72 * MiB;
constexpr size_t WS_MIX = 157 * MiB;
constexpr size_t WS_YG = 191 * MiB;
constexpr size_t WS_S5 = 208 * MiB;
constexpr size_t WS_VST = WS_S5 + 14 * MiB;
constexpr size_t WS_XB = 224 * MiB;
constexpr size_t WS_END = 256 * MiB;

struct P {
    const float* in[27];
    float* out;
    unsigned char* ws;
    int ph_lo, ph_hi;
};

__device__ __forceinline__ unsigned f2bf(float f) { unsigned u = __builtin_bit_cast(unsigned, f); return (u + 0x7fffu + ((u >> 16) & 1u)) >> 16; }
typedef float f32x2_t __attribute__((ext_vector_type(2))); typedef __bf16 bf16x2_t __attribute__((ext_vector_type(2)));
__device__ __forceinline__ unsigned pk2(float lo, float hi) { const f32x2_t v = {lo, hi}; const bf16x2_t b = __builtin_convertvector(v, bf16x2_t); return __builtin_bit_cast(unsigned, b); }
__device__ __forceinline__ float bf2f(unsigned short h) { return __builtin_bit_cast(float, (unsigned)h << 16); }
__device__ __forceinline__ float bflo(unsigned w) { return __builtin_bit_cast(float, w << 16); }
__device__ __forceinline__ float bfhi(unsigned w) { return __builtin_bit_cast(float, w & 0xffff0000u); }
__device__ __forceinline__ float wave_sum(float v) {
#pragma unroll
    for (int o = 1; o < 64; o <<= 1) v += __shfl_xor(v, o);
    return v;
}
__device__ __forceinline__ float quad16_sum(float x) {
    const auto a = __builtin_amdgcn_permlane32_swap(__float_as_uint(x), __float_as_uint(x), false, false);
    const float y = __uint_as_float(a[0]) + __uint_as_float(a[1]);
    const auto b = __builtin_amdgcn_permlane16_swap(__float_as_uint(y), __float_as_uint(y), false, false);
    return __uint_as_float(b[0]) + __uint_as_float(b[1]);
}
__device__ __forceinline__ float silu_f(float x) { return x * __builtin_amdgcn_rcpf(1.f + __expf(-x)); }
__device__ __forceinline__ float sigmoid_f(float x) { return __builtin_amdgcn_rcpf(1.f + __expf(-x)); }
__device__ __forceinline__ float gelu_tanh_f(float x) {
    const float u2 = 1.5957691216057308f * (x + 0.044715f * x * x * x);
    return x * __builtin_amdgcn_rcpf(1.f + __expf(-u2));
}
__host__ __device__ __forceinline__ int hd_logical(int h) { return (h & 0x40) | ((h & 0x04) << 3) | ((h & 0x38) >> 1) | (h & 0x03); }
__device__ __forceinline__ int in_col_logical(int l, int n) { return ((l & 1) && n < 1280) ? ((n & ~127) | hd_logical(n & 127)) : n; }
__device__ __forceinline__ int cond_row(int m) { const int b = m / TPB, t = m - b * TPB; return t < NCTX ? 4 : b; }
__device__ __forceinline__ size_t res_off(int m, bool& is_ctx) { const int b = m / TPB, t = m - b * TPB; is_ctx = t < NCTX; return is_ctx ? (size_t)(b * NCTX + t) * DM : (size_t)(b * SEQ + t - NCTX) * DM; }

struct Ctx {
    const P* p; int tid, wid, lane, gw, ngw;
    unsigned char* lds;
};

namespace pg8 {
#define PG8_LAS __attribute__((address_space(3)))
typedef unsigned short bf16_t;
typedef short bf16x8 __attribute__((ext_vector_type(8)));
typedef float f32x4 __attribute__((ext_vector_type(4)));
typedef unsigned u32x4 __attribute__((ext_vector_type(4)));
constexpr int BM = 256, BK = 64, HALF = 128, HTB = HALF * BK * 2  , STAGE_BYTES = 8 * HTB, NXCD = 8, WGM = 8;

__host__ __device__ __forceinline__ int lds_byte(int r, int c) { const int st = (r >> 4) * 2 + (c >> 5), rr = r & 15, cc = c & 31, ob = rr * 64 + cc * 2; return st * 1024 + (ob ^ (((ob >> 9) & 1) << 5)); }
__host__ __device__ __forceinline__ void stage_rc(int b, int& R, int& C) { const int st = b / 1024, sb = b % 1024, swz = sb ^ (((sb >> 9) & 1) << 5); R = (st >> 1) * 16 + swz / 64; C = (st & 1) * 32 + (swz % 64) / 2; }
__host__ __device__ __forceinline__ int perm32(int rho) { const int n = rho >> 4, i = rho & 15; return 8 * (i >> 2) + 4 * n + (i & 3); }

struct Unit { int pm, pn; };
struct Gemm { const bf16_t* A; const bf16_t* Bt; int M, N, K; };

struct StaticOrder {
    int nM, nN, nwg, G, c;
    __host__ __device__ void init(int M, int N, int G_, int c_) { nM = M / BM; nN = N / BM; nwg = nM * nN; G = G_; c = c_; }
    __host__ __device__ bool next(int i, Unit& u) const {
        const long L = (long)i * G + c; if (L >= nwg) return false;
        int wgid = (int)L; { const int q = nwg / NXCD, r = nwg % NXCD, xcd = wgid % NXCD, off = wgid / NXCD; wgid = (xcd < r ? xcd * (q + 1) : r * (q + 1) + (xcd - r) * q) + off; }
        const int nig = WGM * nN, gid = wgid / nig, fm = gid * WGM, gsz = (nM - fm) < WGM ? (nM - fm) : WGM;
        u.pm = fm + ((wgid % nig) % gsz); u.pn = (wgid % nig) / gsz; return true;
    }
    __device__ __forceinline__ void a_ready(const Unit&) const {}
    __device__ __forceinline__ void done(const Unit&) const {}
};

__device__ __forceinline__ unsigned cvt_pk_bf16(float lo, float hi) { unsigned r; asm volatile("v_cvt_pk_bf16_f32 %0, %1, %2" : "=v"(r) : "v"(lo), "v"(hi)); return r; }
template <class Epi, class Sched, bool ALIGN_EPI = false, bool SP2 = false>
__device__ __forceinline__ void gemm_phase(PG8_LAS unsigned char* lds, const Gemm g, const Sched& S, const Epi& E, const int tid) {
    const int wid = __builtin_amdgcn_readfirstlane(tid >> 6), lane = tid & 63, wr = wid >> 2, wc = wid & 3, fr = lane & 15, fq = lane >> 4;
    const int K = g.K, nt = K / BK;
    unsigned voffA[2], voffB[2];
#pragma unroll
    for (int i = 0; i < 2; ++i) { int R, C; stage_rc(tid * 16 + i * 8192, R, C); const int Rb = Epi::PERM ? ((R & ~31) + perm32(R & 31)) : R;
        voffA[i] = (unsigned)(R * K + C) * 2u; voffB[i] = (unsigned)(Rb * K + C) * 2u; }
    const size_t kstep = (size_t)(BK * 2);
    const size_t hstep = (size_t)HALF * K * 2;
    const size_t tstep = 2 * hstep;
    const unsigned ldsw = (unsigned)wid * 1024u;
    const int aoff = lds_byte(wr * 64 + fr, fq * 8), boff = lds_byte(wc * 32 + fr, fq * 8);
#define PG8_SA(b, h) (((b) * 2 + (h)) * HTB)
#define PG8_SB(b, h) ((4 + (b) * 2 + (h)) * HTB)
#define PG8_STAGE(bufoff, gbase, voff) do { _Pragma("unroll") for (int _i = 0; _i < 2; ++_i) \
        __builtin_amdgcn_global_load_lds((const unsigned*)((const char*)(gbase) + (voff)[_i]), (PG8_LAS unsigned*)(lds + (bufoff) + ldsw + _i * 8192), 16, 0, 0); } while (0)
#define PG8_LDA(dst, b, h) do { _Pragma("unroll") for (int m = 0; m < 4; ++m) _Pragma("unroll") for (int k = 0; k < 2; ++k) dst[m][k] = *(const PG8_LAS bf16x8*)(lds + PG8_SA(b, h) + aoff + m * 2048 + k * 1024); } while (0)
#define PG8_LDB(dst, b, h) do { _Pragma("unroll") for (int n = 0; n < 2; ++n) _Pragma("unroll") for (int k = 0; k < 2; ++k) dst[n][k] = *(const PG8_LAS bf16x8*)(lds + PG8_SB(b, h) + boff + n * 2048 + k * 1024); } while (0)
#define PG8_MMA(ai, bj, At, Bt) do { __builtin_amdgcn_s_setprio(1); _Pragma("unroll") for (int m = 0; m < 4; ++m) _Pragma("unroll") for (int n = 0; n < 2; ++n) _Pragma("unroll") for (int k = 0; k < 2; ++k) \
        acc[ai][bj][m][n] = __builtin_amdgcn_mfma_f32_16x16x32_bf16(Bt[n][k], At[m][k], acc[ai][bj][m][n], 0, 0, 0); __builtin_amdgcn_s_setprio(0); } while (0)
#define PG8_WAIT_V(n) asm volatile("s_waitcnt vmcnt(" #n ")" ::: "memory")
#define PG8_WAIT_L(n) asm volatile("s_waitcnt lgkmcnt(" #n ")" ::: "memory")
#define PG8_BAR __builtin_amdgcn_s_barrier()
#define PG8_SCHED __builtin_amdgcn_sched_barrier(0)
    Unit cur, nxt; int ui = 0;
    if (!S.next(0, cur)) return;
    f32x4 acc[2][2][4][2];
#pragma unroll
    for (int a = 0; a < 2; ++a)
#pragma unroll
        for (int b = 0; b < 2; ++b)
#pragma unroll
            for (int m = 0; m < 4; ++m)
#pragma unroll
                for (int n = 0; n < 2; ++n) acc[a][b][m][n] = (f32x4){0.f, 0.f, 0.f, 0.f};
    bf16x8 At[4][2], B0[2][2], B1[2][2];
    const char* cA = (const char*)g.A + (size_t)cur.pm * tstep; const char* cB = (const char*)g.Bt + (size_t)cur.pn * tstep;
    S.a_ready(cur);
    if constexpr (SP2) {
        PG8_STAGE(PG8_SB(0, 0), cB, voffB); PG8_STAGE(PG8_SB(0, 1), cB + hstep, voffB); PG8_STAGE(PG8_SA(0, 0), cA, voffA); PG8_STAGE(PG8_SA(0, 1), cA + hstep, voffA);
        if (wr == 1) PG8_BAR;
        PG8_WAIT_V(2); PG8_BAR;
        PG8_STAGE(PG8_SB(1, 0), cB + kstep, voffB); PG8_STAGE(PG8_SA(1, 0), cA + kstep, voffA); PG8_STAGE(PG8_SB(1, 1), cB + hstep + kstep, voffB);
        PG8_WAIT_V(6); PG8_BAR;
    } else {
        PG8_STAGE(PG8_SB(0, 0), cB, voffB); PG8_STAGE(PG8_SA(0, 0), cA, voffA); PG8_STAGE(PG8_SB(0, 1), cB + hstep, voffB); PG8_STAGE(PG8_SA(0, 1), cA + hstep, voffA);
        if (wr == 1) PG8_BAR;
        PG8_WAIT_V(4); PG8_BAR;
        PG8_STAGE(PG8_SB(1, 0), cB + kstep, voffB); PG8_STAGE(PG8_SA(1, 0), cA + kstep, voffA); PG8_STAGE(PG8_SB(1, 1), cB + hstep + kstep, voffB);
        PG8_WAIT_V(6); PG8_BAR;
    }
    for (;;) {
        const bool has_next = S.next(ui + 1, nxt);
        const char* nA = has_next ? (const char*)g.A + (size_t)nxt.pm * tstep : cA; const char* nB = has_next ? (const char*)g.Bt + (size_t)nxt.pn * tstep : cB;
        for (int t = 0; t < nt; t += 2) {
            const bool last = (t == nt - 2);
            const char* a1 = cA + (size_t)(t + 1) * kstep;
            const char* a2 = last ? nA : cA + (size_t)(t + 2) * kstep; const char* b2 = last ? nB : cB + (size_t)(t + 2) * kstep;
            const char* a3 = a2 + kstep; const char* b3 = b2 + kstep;
            if (last && has_next) S.a_ready(nxt);
            if constexpr (SP2) {
            PG8_LDB(B0, 0, 0); PG8_LDB(B1, 0, 1); PG8_SCHED; PG8_LDA(At, 0, 0); PG8_STAGE(PG8_SA(1, 1), a1 + hstep, voffA);
            PG8_WAIT_V(8); PG8_WAIT_L(0); PG8_BAR; PG8_MMA(0, 0, At, B0); PG8_MMA(0, 1, At, B1); PG8_BAR; PG8_SCHED;
            PG8_LDA(At, 0, 1); PG8_STAGE(PG8_SB(0, 0), b2, voffB); PG8_STAGE(PG8_SB(0, 1), b2 + hstep, voffB); PG8_STAGE(PG8_SA(0, 0), a2, voffA);
            PG8_WAIT_V(8); PG8_WAIT_L(0); PG8_BAR; PG8_MMA(1, 0, At, B0); PG8_MMA(1, 1, At, B1); PG8_BAR; PG8_SCHED;
            PG8_LDB(B0, 1, 0); PG8_LDB(B1, 1, 1); PG8_SCHED; PG8_LDA(At, 1, 0); PG8_STAGE(PG8_SA(0, 1), a2 + hstep, voffA);
            PG8_WAIT_V(8); PG8_WAIT_L(0); PG8_BAR; PG8_MMA(0, 0, At, B0); PG8_MMA(0, 1, At, B1); PG8_BAR; PG8_SCHED;
            PG8_LDA(At, 1, 1); PG8_STAGE(PG8_SB(1, 0), b3, voffB); PG8_STAGE(PG8_SB(1, 1), b3 + hstep, voffB); PG8_STAGE(PG8_SA(1, 0), a3, voffA);
            PG8_WAIT_V(8); PG8_WAIT_L(0); PG8_BAR; PG8_MMA(1, 0, At, B0); PG8_MMA(1, 1, At, B1); PG8_BAR; PG8_SCHED;
            } else {
            PG8_LDB(B0, 0, 0); PG8_SCHED; PG8_LDA(At, 0, 0); PG8_STAGE(PG8_SA(1, 1), a1 + hstep, voffA);
            PG8_WAIT_L(8); PG8_BAR; PG8_WAIT_L(0); PG8_MMA(0, 0, At, B0); PG8_BAR; PG8_SCHED;
            PG8_LDB(B1, 0, 1); PG8_STAGE(PG8_SB(0, 0), b2, voffB);
            PG8_BAR; PG8_WAIT_L(0); PG8_MMA(0, 1, At, B1); PG8_BAR;
            PG8_LDA(At, 0, 1); PG8_STAGE(PG8_SA(0, 0), a2, voffA);
            PG8_BAR; PG8_WAIT_L(0); PG8_MMA(1, 0, At, B0); PG8_BAR; PG8_SCHED;
            PG8_STAGE(PG8_SB(0, 1), b2 + hstep, voffB);
            PG8_WAIT_V(6); PG8_BAR; PG8_MMA(1, 1, At, B1); PG8_BAR;
            PG8_LDB(B0, 1, 0); PG8_SCHED; PG8_LDA(At, 1, 0); PG8_STAGE(PG8_SA(0, 1), a2 + hstep, voffA);
            PG8_WAIT_L(8); PG8_BAR; PG8_WAIT_L(0); PG8_MMA(0, 0, At, B0); PG8_BAR; PG8_SCHED;
            PG8_LDB(B1, 1, 1); PG8_STAGE(PG8_SB(1, 0), b3, voffB);
            PG8_BAR; PG8_WAIT_L(0); PG8_MMA(0, 1, At, B1); PG8_BAR;
            PG8_LDA(At, 1, 1); PG8_STAGE(PG8_SA(1, 0), a3, voffA);
            PG8_BAR; PG8_WAIT_L(0); PG8_MMA(1, 0, At, B0); PG8_BAR; PG8_SCHED;
            PG8_STAGE(PG8_SB(1, 1), b3 + hstep, voffB);
            PG8_WAIT_V(6); PG8_BAR; PG8_MMA(1, 1, At, B1); PG8_BAR;
            }
        }
        if constexpr (ALIGN_EPI) { if (wr == 0) PG8_BAR; }
        if constexpr (!Epi::AFTER_DRAIN) { E(acc, cur, wr, wc, fr, fq); S.done(cur); }
        if (!has_next) break;
#pragma unroll
        for (int a = 0; a < 2; ++a)
#pragma unroll
            for (int b = 0; b < 2; ++b)
#pragma unroll
                for (int m = 0; m < 4; ++m)
#pragma unroll
                    for (int n = 0; n < 2; ++n) acc[a][b][m][n] = (f32x4){0.f, 0.f, 0.f, 0.f};
        cur = nxt; cA = nA; cB = nB; ++ui;
        if constexpr (ALIGN_EPI) { if (wr == 1) PG8_BAR; }
    }
    PG8_WAIT_V(0);
    if constexpr (!ALIGN_EPI) { if (wr == 0) PG8_BAR; }
    PG8_BAR;
    if constexpr (Epi::AFTER_DRAIN) { E.fused(acc, cur, wr, wc, fr, fq, lds, wid, lane); S.done(cur); }
#undef PG8_SA
#undef PG8_SB
#undef PG8_STAGE
#undef PG8_LDA
#undef PG8_LDB
#undef PG8_MMA
#undef PG8_WAIT_V
#undef PG8_WAIT_L
#undef PG8_BAR
#undef PG8_SCHED
}
}

namespace attn {
constexpr int   D = 128, NW = 8, QBLK = 32, KVBLK = 64;
constexpr float SCALE = 0.088388347648318440f;
#ifndef ATTN_THR
#define ATTN_THR 8.f
#endif
constexpr float THR = ATTN_THR;
constexpr int SDEPTH = 2;
constexpr int LDQ = 2560, LDK = 2560, LDO = 1024, LDG = 2560;
constexpr size_t SHM_V = KVBLK * D * 2, SHM_K = KVBLK * D * 2, SHM_ATTN = 2 * SHM_V + 2 * SHM_K + NW * 64 * 4;
using bf16 = unsigned short;
using bf16x8 = __attribute__((ext_vector_type(8))) short;
using s16x4  = __attribute__((ext_vector_type(4))) short;
using f32x16 = __attribute__((ext_vector_type(16))) float;
using f32x8  = __attribute__((ext_vector_type(8))) float;
using u32x4  = __attribute__((ext_vector_type(4))) unsigned;
#define KSWZ(row, colB) ((row) * 256 + ((colB) ^ (((row) & 7) << 4)))
#define SBAR() __builtin_amdgcn_sched_barrier(0)
__device__ __forceinline__ int crow(int r, int hi) { return (r & 3) + 8 * (r >> 2) + 4 * hi; }
__device__ __forceinline__ unsigned cvtpk(float lo, float hi) {
  unsigned r; asm volatile("v_cvt_pk_bf16_f32 %0, %1, %2" : "=v"(r) : "v"(lo), "v"(hi)); return r;
}
template <typename TIn> struct Stage;
template <> struct Stage<bf16>  { using T = bf16x8;
  __device__ static __forceinline__ T ld8(const bf16* p) { return *reinterpret_cast<const bf16x8*>(p); }
  __device__ static __forceinline__ bf16x8 tobf(T x) { return x; } };
template <> struct Stage<float> { using T = f32x8;
  __device__ static __forceinline__ T ld8(const float* p) { return *reinterpret_cast<const f32x8*>(p); }
  __device__ static __forceinline__ bf16x8 tobf(T x) {
    u32x4 w = {cvtpk(x[0], x[1]), cvtpk(x[2], x[3]), cvtpk(x[4], x[5]), cvtpk(x[6], x[7])}; return *reinterpret_cast<bf16x8*>(&w); } };

__device__ __forceinline__ void partialSM(f32x16& p0, f32x16& p1, float& m_reg, float& mn, float& alpha) {
  constexpr float C = SCALE * 1.4426950408889634f;
  float pmax = p0[0]; for (int r = 1; r < 16; ++r) pmax = fmaxf(pmax, p0[r]); for (int r = 0; r < 16; ++r) pmax = fmaxf(pmax, p1[r]);
  { auto rr = __builtin_amdgcn_permlane32_swap(__float_as_uint(pmax), __float_as_uint(pmax), false, false);
    pmax = fmaxf(__uint_as_float(rr[0]), __uint_as_float(rr[1])); }
  if (__builtin_expect(__all(pmax - m_reg <= THR / SCALE), 1)) { mn = m_reg; alpha = 1.f; }
  else { mn = fmaxf(m_reg, pmax); alpha = __builtin_amdgcn_exp2f((m_reg - mn) * C); m_reg = mn; }
  float mnC = -mn * C;
  for (int r = 0; r < 16; ++r) p0[r] = fmaf(p0[r], C, mnC); for (int r = 0; r < 16; ++r) p1[r] = fmaf(p1[r], C, mnC);
  for (int r = 0; r < 16; ++r) p0[r] = __builtin_amdgcn_exp2f(p0[r]);
}
__device__ __forceinline__ void finishSM(f32x16& p0, f32x16& p1, float alpha, float& l_reg, bf16x8& pa0, bf16x8& pa1, bf16x8& pa2, bf16x8& pa3) {
  for (int r = 0; r < 16; ++r) p1[r] = __builtin_amdgcn_exp2f(p1[r]);
  float ps = 0; for (int r = 0; r < 16; ++r) ps += p0[r]; for (int r = 0; r < 16; ++r) ps += p1[r];
  { auto rr = __builtin_amdgcn_permlane32_swap(__float_as_uint(ps), __float_as_uint(ps), false, false);
    ps = __uint_as_float(rr[0]) + __uint_as_float(rr[1]); }
  l_reg = l_reg * alpha + ps;
#define PK4(P, BASE, OUT) do { unsigned a0 = cvtpk(P[BASE + 0], P[BASE + 1]), a1 = cvtpk(P[BASE + 2], P[BASE + 3]);   \
    unsigned b0 = cvtpk(P[BASE + 4], P[BASE + 5]), b1 = cvtpk(P[BASE + 6], P[BASE + 7]);                              \
    auto r0 = __builtin_amdgcn_permlane32_swap(a0, b0, false, false); auto r1 = __builtin_amdgcn_permlane32_swap(a1, b1, false, false); \
    u32x4 w = {r0[0], r1[0], r0[1], r1[1]}; OUT = *reinterpret_cast<bf16x8*>(&w); } while (0)
  PK4(p0, 0, pa0); PK4(p0, 8, pa1); PK4(p1, 0, pa2); PK4(p1, 8, pa3);
#undef PK4
}
__device__ __forceinline__ void qkt(f32x16& p0, f32x16& p1, const bf16* Ks, const bf16x8* qr, int r32, int hi) {
  p0 = f32x16{}; p1 = f32x16{};
  for (int d0 = 0; d0 < 8; ++d0) { int cb = (d0 * 16 + hi * 8) * 2;
    bf16x8 b0 = *reinterpret_cast<const bf16x8*>((const char*)Ks + KSWZ(r32, cb));
    bf16x8 b1 = *reinterpret_cast<const bf16x8*>((const char*)Ks + KSWZ(32 + r32, cb));
    p0 = __builtin_amdgcn_mfma_f32_32x32x16_bf16(b0, qr[d0], p0, 0, 0, 0);
    p1 = __builtin_amdgcn_mfma_f32_32x32x16_bf16(b1, qr[d0], p1, 0, 0, 0); }
}
__device__ __forceinline__ int v_st(int k, int c) { const int kk = (k & ~0xC) | ((k & 4) << 1) | ((k & 8) >> 1); return ((kk >> 3) * 4 + (c >> 5)) * 512 + ((kk & 7) * 32 + (c & 31)) * 2; }
__device__ __forceinline__ int v_rd_base(int lane) { return ((lane & 3) << 3) | (((lane >> 2) & 3) << 6) | (((lane >> 4) & 1) << 5) | (((lane >> 5) & 1) << 8); }
constexpr int v_rd_off(int d0, int ks, int half) { return d0 * 512 + ks * 4096 + half * 2048; }
template <int OFF> __device__ __forceinline__ s16x4 tr_read(int vb) {
  s16x4 r; asm volatile("ds_read_b64_tr_b16 %0, %1 offset:%2" : "=&v"(r) : "v"(vb), "i"(OFF) : "memory"); return r;
}
template <int D0> __device__ __forceinline__ void pv_one(f32x16& od, int vb, bf16x8 pa0, bf16x8 pa1, bf16x8 pa2, bf16x8 pa3) {
  const s16x4 l0 = tr_read<v_rd_off(D0, 0, 0)>(vb), h0 = tr_read<v_rd_off(D0, 0, 1)>(vb), l1 = tr_read<v_rd_off(D0, 1, 0)>(vb), h1 = tr_read<v_rd_off(D0, 1, 1)>(vb);
  const s16x4 l2 = tr_read<v_rd_off(D0, 2, 0)>(vb), h2 = tr_read<v_rd_off(D0, 2, 1)>(vb), l3 = tr_read<v_rd_off(D0, 3, 0)>(vb), h3 = tr_read<v_rd_off(D0, 3, 1)>(vb);
  asm volatile("s_waitcnt lgkmcnt(0)" ::: "memory"); SBAR();
#define PK(L, H) (bf16x8){L[0], L[1], L[2], L[3], H[0], H[1], H[2], H[3]}
  od = __builtin_amdgcn_mfma_f32_32x32x16_bf16(pa0, PK(l0, h0), od, 0, 0, 0);
  od = __builtin_amdgcn_mfma_f32_32x32x16_bf16(pa1, PK(l1, h1), od, 0, 0, 0);
  od = __builtin_amdgcn_mfma_f32_32x32x16_bf16(pa2, PK(l2, h2), od, 0, 0, 0);
  od = __builtin_amdgcn_mfma_f32_32x32x16_bf16(pa3, PK(l3, h3), od, 0, 0, 0);
#undef PK
}
__device__ __forceinline__ void pv_d0(f32x16* o, int vb, bf16x8 pa0, bf16x8 pa1, bf16x8 pa2, bf16x8 pa3) {
  pv_one<0>(o[0], vb, pa0, pa1, pa2, pa3); pv_one<1>(o[1], vb, pa0, pa1, pa2, pa3); pv_one<2>(o[2], vb, pa0, pa1, pa2, pa3); pv_one<3>(o[3], vb, pa0, pa1, pa2, pa3);
}

template <typename TQ>
__device__ __forceinline__ void attn_dense_body(const TQ* __restrict__ Qb, const bf16* __restrict__ Kh, const bf16* __restrict__ Vh,
                                                bf16* __restrict__ Ob, const bf16* __restrict__ Gb, int seq, char* lds, const int tid) {
  using St = Stage<bf16>; using SQ = Stage<TQ>;
  const int wid = __builtin_amdgcn_readfirstlane(tid >> 6), lane = tid & 63, r32 = lane & 31, hi = lane >> 5;
  bf16* V_lds = (bf16*)lds; bf16* K_lds = (bf16*)(lds + 2 * SHM_V);
  float* ws = (float*)(lds + 2 * SHM_V + 2 * SHM_K) + wid * 64; float* li_l = ws; float* al_l = ws + 32;
  float m_reg = -1e30f, l_reg = 0; f32x16 o[4] = {}; bf16x8 qr[8];
  const TQ* Qw = Qb + (long)(wid * QBLK + r32) * LDQ + hi * 8;
#pragma unroll
  for (int d0 = 0; d0 < 8; ++d0) qr[d0] = SQ::tobf(SQ::ld8(Qw + d0 * 16));
  const int sr = tid >> 4, sc = (tid & 15) * 8, vst0 = v_st(sr, sc), vst1 = v_st(32 + sr, sc);
  const int vb0 = (int)(uintptr_t)V_lds + v_rd_base(lane);
  struct { typename St::T vs0, vs1, ks0, ks1; } sr_[SDEPTH];
  const unsigned lo0 = (unsigned)(sr * LDK + sc), lo1 = (unsigned)((32 + sr) * LDK + sc);
#define SLOAD(i, k0) do { const bf16* vt_ = Vh + (long)(k0) * LDK; const bf16* kt_ = Kh + (long)(k0) * LDK; sr_[i].vs0 = St::ld8(vt_ + lo0); sr_[i].vs1 = St::ld8(vt_ + lo1); \
    sr_[i].ks0 = St::ld8(kt_ + lo0); sr_[i].ks1 = St::ld8(kt_ + lo1); } while (0)
#define SWRITE(b, i) do { *(bf16x8*)((char*)V_lds + (b) * SHM_V + vst0) = St::tobf(sr_[i].vs0);          \
    *(bf16x8*)((char*)V_lds + (b) * SHM_V + vst1) = St::tobf(sr_[i].vs1); int kc = sc * 2;               \
    *(bf16x8*)((char*)K_lds + (b) * SHM_K + KSWZ(sr, kc)) = St::tobf(sr_[i].ks0);                       \
    *(bf16x8*)((char*)K_lds + (b) * SHM_K + KSWZ(32 + sr, kc)) = St::tobf(sr_[i].ks1); } while (0)
#define SWAIT() do { if constexpr (SDEPTH == 2) asm volatile("s_waitcnt vmcnt(4)" ::: "memory"); else asm volatile("s_waitcnt vmcnt(0)" ::: "memory"); } while (0)
#define RESC(a) do { if (__any((a) < 1.f)) { if (hi == 0) al_l[r32] = (a); asm volatile("s_waitcnt lgkmcnt(0)" ::: "memory"); \
    for (int d = 0; d < 4; ++d) for (int r = 0; r < 16; ++r) o[d][r] *= al_l[crow(r, hi)]; } } while (0)
  f32x16 pA0, pA1, pB0, pB1; float mnA, mnB, alA, alB; bf16x8 pa0, pa1, pa2, pa3; const int NT = seq / KVBLK;
  constexpr int SE = 0, SO = SDEPTH - 1;
  SLOAD(SE, 0); asm volatile("s_waitcnt vmcnt(0)" ::: "memory"); SWRITE(0, SE); __syncthreads();
  qkt(pA0, pA1, K_lds, qr, r32, hi); partialSM(pA0, pA1, m_reg, mnA, alA);
  SLOAD(SO, KVBLK); if constexpr (SDEPTH == 2) { if (2 < NT) SLOAD(SE, 2 * KVBLK); }
  SWAIT(); SWRITE(1, SO); __syncthreads();
  for (int j = 1; j + 1 < NT; j += 2) {
    SBAR(); qkt(pB0, pB1, (bf16*)((char*)K_lds + SHM_K), qr, r32, hi);
    finishSM(pA0, pA1, alA, l_reg, pa0, pa1, pa2, pa3); SBAR();
    SLOAD(SO, (j + SDEPTH) * KVBLK); SBAR();
    pv_d0(o, vb0, pa0, pa1, pa2, pa3); partialSM(pB0, pB1, m_reg, mnB, alB);
    __syncthreads(); SWAIT(); SWRITE(0, SE);
    RESC(alB); __syncthreads();
    SBAR(); qkt(pA0, pA1, K_lds, qr, r32, hi);
    finishSM(pB0, pB1, alB, l_reg, pa0, pa1, pa2, pa3); SBAR();
    if (SDEPTH == 1 || j + 3 < NT) SLOAD(SE, (j + 1 + SDEPTH) * KVBLK); SBAR();
    pv_d0(o, vb0 + (int)SHM_V, pa0, pa1, pa2, pa3); partialSM(pA0, pA1, m_reg, mnA, alA);
    __syncthreads(); SWAIT(); SWRITE(1, SO);
    RESC(alA); __syncthreads();
  }
  SBAR(); qkt(pB0, pB1, (bf16*)((char*)K_lds + SHM_K), qr, r32, hi);
  finishSM(pA0, pA1, alA, l_reg, pa0, pa1, pa2, pa3); SBAR();
  pv_d0(o, vb0, pa0, pa1, pa2, pa3); partialSM(pB0, pB1, m_reg, mnB, alB);
  __syncthreads(); RESC(alB);
  finishSM(pB0, pB1, alB, l_reg, pa0, pa1, pa2, pa3); SBAR();
  pv_d0(o, vb0 + (int)SHM_V, pa0, pa1, pa2, pa3);
  if (hi == 0) li_l[r32] = l_reg; asm volatile("s_waitcnt lgkmcnt(0)" ::: "memory");
  float rli[16];
#pragma unroll
  for (int r = 0; r < 16; ++r) rli[r] = __builtin_amdgcn_rcpf(li_l[crow(r, hi)]);
  __syncthreads();
  { char* ost = lds + wid * 8704;
    int ob = hi * (4 * 272) + r32 * 2; asm volatile("" : "+v"(ob));
    char* osl = ost + ob;
#pragma unroll
    for (int r = 0; r < 16; ++r) { const int orow0 = (r & 3) + 8 * (r >> 2);
#pragma unroll
      for (int d0 = 0; d0 < 4; ++d0) *(bf16*)(osl + orow0 * 272 + d0 * 64) = (bf16)(cvtpk(o[d0][r] * rli[r], 0.f) & 0xffffu); }
    asm volatile("s_waitcnt lgkmcnt(0)" ::: "memory");
    bf16* Ow = Ob + (long)(wid * QBLK) * LDO; const bf16* Gw = Gb + (long)(wid * QBLK) * LDG;
    int ln = lane; asm volatile("" : "+v"(ln));
#pragma unroll 2
    for (int i = 0; i < 8; ++i) { const int id = i * 64 + ln, row = id >> 4, ch = id & 15;
      const u32x4 ov = *(const u32x4*)(ost + row * 272 + ch * 16); const u32x4 gv = *(const u32x4*)(Gw + (long)row * LDG + ch * 8);
      u32x4 w;
#define GMUL(O, G) cvtpk(__builtin_bit_cast(float, (O) << 16) * __builtin_bit_cast(float, (G) << 16), __builtin_bit_cast(float, (O) & 0xffff0000u) * __builtin_bit_cast(float, (G) & 0xffff0000u))
      w.x = GMUL(ov.x, gv.x); w.y = GMUL(ov.y, gv.y); w.z = GMUL(ov.z, gv.z); w.w = GMUL(ov.w, gv.w);
#undef GMUL
      *(u32x4*)(Ow + (long)row * LDO + ch * 8) = w; }
    asm volatile("s_waitcnt lgkmcnt(0)" ::: "memory");
  }
#undef SLOAD
#undef SWRITE
#undef SWAIT
#undef RESC
}

#undef KSWZ
#undef SBAR
}

#define LAS __attribute__((address_space(3)))
#define XB_TMO      128
#define XB_XCNT(j)  (256  + 64 * (j))
#define XB_XSUB(j)  (1280 + 64 * (j))
#define XB_XGEN(j)  (2304 + 64 * (j))
#define XB_TOP      3328
#define XB_TOPGEN   3392
#define XCD_BAR_WORDS 3456
#define XB_SPIN_CAP (1u << 18)

__device__ __forceinline__ unsigned xb_ld(unsigned* p)              { return __hip_atomic_load(p, __ATOMIC_RELAXED, __HIP_MEMORY_SCOPE_AGENT); }
__device__ __forceinline__ unsigned xb_add(unsigned* p, unsigned v) { return __hip_atomic_fetch_add(p, v, __ATOMIC_RELAXED, __HIP_MEMORY_SCOPE_AGENT); }
__device__ __forceinline__ unsigned xb_xcc_id() { return (unsigned)__builtin_amdgcn_s_getreg((3 << 11) | 20) & 0xFu; }
#define XB_SPIN(cond, bar) do { unsigned _sp = 0; while (cond) { __builtin_amdgcn_s_sleep(1); \
    if ((++_sp & 255u) == 0u) { if (xb_ld(&(bar)[XB_TMO])) break; if (_sp > XB_SPIN_CAP) { atomicAdd(&(bar)[XB_TMO], 1u); break; } } } } while (0)

struct XcdBarrier {
    unsigned* bar; unsigned x;
    volatile LAS unsigned* st;
};

__device__ __forceinline__ XcdBarrier xcd_barrier_post(unsigned* bar, volatile LAS unsigned* st) {
    XcdBarrier b; b.bar = bar; b.x = xb_xcc_id(); b.st = st;
    if (threadIdx.x == 0) (void)xb_add(&bar[XB_XCNT(b.x)], 1u);
    return b;
}
__device__ __forceinline__ void xcd_barrier_complete(unsigned* bar, unsigned x, unsigned& nloc, unsigned& nx) {
    const unsigned G = gridDim.x * gridDim.y * gridDim.z;
    unsigned sum, cnt, mine, sp = 0u;
    for (;;) {
        sum = 0u; cnt = 0u; mine = 0u;
#pragma unroll
        for (unsigned j = 0; j < 16; ++j) { const unsigned c = xb_ld(&bar[XB_XCNT(j)]); sum += c; cnt += (c > 0u) ? 1u : 0u; mine = (j == x) ? c : mine; }
        if (sum == G) break;
        __builtin_amdgcn_s_sleep(1);
        if ((++sp & 255u) == 0u) { if (xb_ld(&bar[XB_TMO])) break; if (sp > XB_SPIN_CAP) { atomicAdd(&bar[XB_TMO], 1u); break; } }
    }
    nloc = mine > 0u ? mine : 1u; nx = cnt > 0u ? cnt : 1u;
}

__device__ __forceinline__ void xcd_barrier(const XcdBarrier& b) {
    asm volatile("s_waitcnt vmcnt(0)" ::: "memory");
    __syncthreads();
    if (threadIdx.x == 0) {
        unsigned* bar = b.bar;
        __builtin_amdgcn_s_waitcnt(0);
        unsigned nloc = b.st[0], nx = b.st[1];
        if (nloc == 0u) { xcd_barrier_complete(bar, b.x, nloc, nx); b.st[0] = nloc; b.st[1] = nx; }
        const unsigned old = xb_add(&bar[XB_XSUB(b.x)], 1u);
        const unsigned gen = old / nloc;
        if (old + 1u == (gen + 1u) * nloc) {
            __builtin_amdgcn_fence(__ATOMIC_RELEASE, "agent");
            asm volatile("s_waitcnt vmcnt(0)" ::: "memory");
            const unsigned og = xb_add(&bar[XB_TOP], 1u);
            const unsigned tg = og / nx;
            if (og + 1u == (tg + 1u) * nx) xb_add(&bar[XB_TOPGEN], 1u);
            else XB_SPIN(xb_ld(&bar[XB_TOPGEN]) == tg, bar);
            __builtin_amdgcn_fence(__ATOMIC_ACQUIRE, "agent");
            xb_add(&bar[XB_XGEN(b.x)], 1u);
            asm volatile("s_waitcnt vmcnt(0)" ::: "memory");
        } else {
            XB_SPIN(xb_ld(&bar[XB_XGEN(b.x)]) == gen, bar);
            __builtin_amdgcn_fence(__ATOMIC_ACQUIRE, "agent");
            asm volatile("s_waitcnt vmcnt(0)" ::: "memory");
        }
    }
    __syncthreads();
}

__device__ __forceinline__ void transpose_pair(const float* W0, const float* W1, int K0, int N0, int K1, int N1, bf16_t* WT0, bf16_t* WT1, int item0, int item1, float* scr, int tid, int pb0, int pb1) {
    const int nblk0 = N0 / 64, kb0 = item0 / nblk0, nb0 = item0 % nblk0, k00 = kb0 * 64, n00 = nb0 * 64;
    int k01 = 0, n01 = 0; if (W1) { const int nblk1 = N1 / 64, kb1 = item1 / nblk1, nb1 = item1 % nblk1; k01 = kb1 * 64; n01 = nb1 * 64; }
    float v0[8], v1[8];
#pragma unroll
    for (int i = 0; i < 8; ++i) { const int kk = (tid >> 6) + 8 * i, nn = tid & 63; v0[i] = W0[(size_t)(k00 + kk) * N0 + n00 + nn]; v1[i] = W1 ? W1[(size_t)(k01 + kk) * N1 + n01 + nn] : 0.f; }
    __syncthreads();
#pragma unroll
    for (int i = 0; i < 8; ++i) { const int kk = (tid >> 6) + 8 * i, nn = tid & 63; scr[kk * 65 + nn] = v0[i]; scr[64 * 65 + kk * 65 + nn] = v1[i]; }
    __syncthreads();
    const int n = tid >> 3, c = tid & 7;
    { const int ns = (n00 + n < pb0) ? (hd_logical((n00 + n) & 127) & 63) : n; const float* s = scr + (8 * c) * 65 + ns;
        u32x4 o; o.x = pk2(s[0], s[65]); o.y = pk2(s[2 * 65], s[3 * 65]); o.z = pk2(s[4 * 65], s[5 * 65]); o.w = pk2(s[6 * 65], s[7 * 65]);
        *(u32x4*)(WT0 + (size_t)(n00 + n) * K0 + k00 + 8 * c) = o; }
    if (W1) { const int ns = (n01 + n < pb1) ? (hd_logical((n01 + n) & 127) & 63) : n; const float* s = scr + 64 * 65 + (8 * c) * 65 + ns;
        u32x4 o; o.x = pk2(s[0], s[65]); o.y = pk2(s[2 * 65], s[3 * 65]); o.z = pk2(s[4 * 65], s[5 * 65]); o.w = pk2(s[6 * 65], s[7 * 65]);
        *(u32x4*)(WT1 + (size_t)(n01 + n) * K1 + k01 + 8 * c) = o; }
}
__device__ __forceinline__ void phase_prep_a(const Ctx& c) {
    const P& p = *c.p;
    float* mods = (float*)(p.ws + WS_MODS);
    {
        float* sl = (float*)(c.lds + 32768);
        float* red = (float*)(c.lds + 32768 + 20480);
        for (int e = c.tid; e < 5 * DM; e += NTHREADS) { const int r = e >> 10, k = e & 1023; sl[e] = silu_f(r < 4 ? p.in[1][r * DM + k] : p.in[3][k]); }
        __syncthreads();
        for (int it = blockIdx.x; it < DEPTH * 48; it += gridDim.x) {
            const int l = it / 48, j = (it % 48) * 64 + c.lane;
            const float* w = p.in[5] + (size_t)l * DM * 3072 + (size_t)(c.wid * 128) * 3072 + j;
            float a0 = 0.f, a1 = 0.f, a2 = 0.f, a3 = 0.f, a4 = 0.f;
#pragma unroll 32
            for (int k = 0; k < 128; ++k) { const float wv = w[(size_t)k * 3072]; const int kk = c.wid * 128 + k;
                a0 += sl[kk] * wv; a1 += sl[DM + kk] * wv; a2 += sl[2 * DM + kk] * wv; a3 += sl[3 * DM + kk] * wv; a4 += sl[4 * DM + kk] * wv; }
            float* rw = red + c.wid * 320 + c.lane; rw[0] = a0; rw[64] = a1; rw[128] = a2; rw[192] = a3; rw[256] = a4;
            __syncthreads();
            if (c.tid < 320) { float sum = 0.f;
#pragma unroll
                for (int w8 = 0; w8 < 8; ++w8) sum += red[w8 * 320 + c.tid];
                const int r = c.tid >> 6, jj = (it % 48) * 64 + (c.tid & 63);
                mods[((size_t)l * 5 + r) * 3072 + jj] = sum + p.in[6][l * 3072 + jj]; }
            __syncthreads();
        }
    }
    if (blockIdx.x == gridDim.x - 1) {
        float* rope = (float*)(p.ws + WS_ROPE);
        for (int e = c.tid; e < 64 * 32; e += NTHREADS) { const int pos = e >> 5, pr = e & 31;
            const float freq = powf(10000.f, -(float)pr / 32.f); const float ang = (float)pos * freq; rope[2 * e] = cosf(ang); rope[2 * e + 1] = sinf(ang); }
    }
}

__device__ __forceinline__ void transpose_resolve(const P& p, int it, const float*& W, int& K, int& N, bf16_t*& WT, int& item, int& pbelow) {
    constexpr int I_IN = 16 * 40, I_OUT = 16 * 16, I_GLU = 8 * 8;
    int r = it; pbelow = 0;
    if (r < 4 * I_IN) { const int l = r / I_IN; W = (l & 1) ? p.in[22] + (size_t)(l >> 1) * DM * NPROJ : p.in[7] + (size_t)(l >> 1) * DM * NPROJ; K = DM; N = NPROJ;
        WT = (bf16_t*)(p.ws + WS_WIN) + (size_t)l * NPROJ * DM; item = r % I_IN; pbelow = (l & 1) ? 1280 : 0; return; }
    r -= 4 * I_IN;
    if (r < 4 * I_OUT) { const int l = r / I_OUT; W = (l & 1) ? p.in[23] + (size_t)(l >> 1) * DM * DM : p.in[8] + (size_t)(l >> 1) * DM * DM; K = DM; N = DM;
        WT = (bf16_t*)(p.ws + WS_WOUT) + (size_t)l * DM * DM; item = r % I_OUT; return; }
    r -= 4 * I_OUT;
    { const int i = r / I_GLU; W = p.in[20] + (size_t)i * 512 * 512; K = 512; N = 512; WT = (bf16_t*)(p.ws + WS_WGLU) + (size_t)i * 512 * 512; item = r % I_GLU; }
}
__device__ __forceinline__ void phase_transposes(const Ctx& c) {
    const P& p = *c.p;
    float* scr = (float*)c.lds;
    constexpr int NIT = 4 * 16 * 40 + 4 * 16 * 16 + 2 * 8 * 8;
    for (int it = 2 * blockIdx.x; it < NIT; it += 2 * gridDim.x) {
        const float* W0; const float* W1 = nullptr; int K0, N0, K1 = 0, N1 = 0, i0, i1 = 0, pb0, pb1 = 0; bf16_t* T0; bf16_t* T1 = nullptr;
        transpose_resolve(p, it, W0, K0, N0, T0, i0, pb0);
        if (it + 1 < NIT) transpose_resolve(p, it + 1, W1, K1, N1, T1, i1, pb1);
        transpose_pair(W0, W1, K0, N0, K1, N1, T0, T1, i0, i1, scr, c.tid, pb0, pb1);
    }
    __syncthreads();
}
__device__ __forceinline__ void phase_bias(const Ctx& c) {
    const P& p = *c.p;
    const float* mods = (const float*)(p.ws + WS_MODS); float* bias = (float*)(p.ws + WS_BIAS); const bf16_t* wint = (const bf16_t*)(p.ws + WS_WIN);
    constexpr int R = DEPTH * NPROJ;
    const int rpw = (R + c.ngw - 1) / c.ngw, r0 = c.gw * rpw, r1 = (r0 + rpw < R) ? r0 + rpw : R;
    int cur_l = -1; float shv[5][16];
    for (int r = r0; r < r1; ++r) {
        const int l = r / NPROJ, n = r - l * NPROJ;
        if (l != cur_l) { cur_l = l;
#pragma unroll
            for (int rr = 0; rr < 5; ++rr) { const float* sp = mods + ((size_t)l * 5 + rr) * 3072;
                const f32x4 a0 = *(const f32x4*)(sp + c.lane * 8), a1 = *(const f32x4*)(sp + c.lane * 8 + 4), a2 = *(const f32x4*)(sp + 512 + c.lane * 8), a3 = *(const f32x4*)(sp + 512 + c.lane * 8 + 4);
                shv[rr][0] = a0.x; shv[rr][1] = a0.y; shv[rr][2] = a0.z; shv[rr][3] = a0.w; shv[rr][4] = a1.x; shv[rr][5] = a1.y; shv[rr][6] = a1.z; shv[rr][7] = a1.w;
                shv[rr][8] = a2.x; shv[rr][9] = a2.y; shv[rr][10] = a2.z; shv[rr][11] = a2.w; shv[rr][12] = a3.x; shv[rr][13] = a3.y; shv[rr][14] = a3.z; shv[rr][15] = a3.w; } }
        const bf16_t* wr_ = wint + ((size_t)l * NPROJ + n) * DM;
        const u32x4 w0 = *(const u32x4*)(wr_ + c.lane * 8), w1 = *(const u32x4*)(wr_ + 512 + c.lane * 8);
        const float wv[16] = {bflo(w0.x), bfhi(w0.x), bflo(w0.y), bfhi(w0.y), bflo(w0.z), bfhi(w0.z), bflo(w0.w), bfhi(w0.w), bflo(w1.x), bfhi(w1.x), bflo(w1.y), bfhi(w1.y), bflo(w1.z), bfhi(w1.z), bflo(w1.w), bfhi(w1.w)};
#pragma unroll
        for (int rr = 0; rr < 5; ++rr) { float a_ = 0.f;
#pragma unroll
            for (int e = 0; e < 16; ++e) a_ += shv[rr][e] * wv[e];
            a_ = wave_sum(a_);
            if (c.lane == 0) bias[((size_t)l * 5 + rr) * NPROJ + n] = a_; }
    }
}
__device__ __forceinline__ void phase_xprep(const Ctx& c, int l, const float* xbuf, const float* ctxbuf) {
    const P& p = *c.p;
    const float* mods = (const float*)(p.ws + WS_MODS) + (size_t)l * 5 * 3072;
    const float* g = p.in[4] + l * DM;
    bf16_t* xm = (bf16_t*)(p.ws + WS_XM); float* rss = (float*)(p.ws + WS_RSS); bf16_t* xbw = l == 0 ? (bf16_t*)(p.ws + WS_XB) : nullptr;
    for (int m0 = 2 * c.gw; m0 < MTOK; m0 += 2 * c.ngw) {
        f32x4 v[2][4]; const float* scp[2]; bool icr[2]; size_t offr[2];
#pragma unroll
        for (int rr = 0; rr < 2; ++rr) { const int m = m0 + rr; bool ic; const size_t off = res_off(m, ic); icr[rr] = ic; offr[rr] = off; const float* src = (ic ? ctxbuf : xbuf) + off; scp[rr] = mods + cond_row(m) * 3072 + 1024;
#pragma unroll
            for (int j = 0; j < 4; ++j) v[rr][j] = *(const f32x4*)(src + 4 * c.lane + 256 * j); }
#pragma unroll
        for (int rr = 0; rr < 2; ++rr) { const int m = m0 + rr; float ss = 0.f;
#pragma unroll
            for (int j = 0; j < 4; ++j) { const int k = 4 * c.lane + 256 * j; const f32x4 x = v[rr][j]; const f32x4 gv = *(const f32x4*)(g + k), sv = *(const f32x4*)(scp[rr] + k);
                ss += x.x * x.x + x.y * x.y + x.z * x.z + x.w * x.w;
                u32x2 o; o.x = pk2(x.x * gv.x * (1.f + sv.x), x.y * gv.y * (1.f + sv.y)); o.y = pk2(x.z * gv.z * (1.f + sv.z), x.w * gv.w * (1.f + sv.w));
                *(u32x2*)(xm + (size_t)m * DM + k) = o;
                if (xbw && !icr[rr]) { u32x2 ob; ob.x = pk2(x.x, x.y); ob.y = pk2(x.z, x.w); *(u32x2*)(xbw + offr[rr] + k) = ob; } }
            ss = wave_sum(ss);
            if (c.lane < 16) rss[(size_t)m * 16 + c.lane] = c.lane == 0 ? ss : 0.f; }
    }
}

template <class Epi>
__device__ __forceinline__ void gemm_simple(const Ctx& c, const bf16_t* A, int lda, const bf16_t* Bt, int ldb, int M, int N, int K, const Epi& epi) {
    const int fr = c.lane & 15, fq = c.lane >> 4, wr = c.wid >> 1, wc = c.wid & 1;
    const int tn = N / 128, nt = (M / 128) * tn;
    for (int t = blockIdx.x; t < nt; t += gridDim.x) {
        const int pm = t / tn, pn = t % tn;
        f32x4 acc[2][4];
#pragma unroll
        for (int i = 0; i < 2; ++i)
#pragma unroll
            for (int j = 0; j < 4; ++j) acc[i][j] = (f32x4){0.f, 0.f, 0.f, 0.f};
        const bf16_t* a0 = A + (size_t)(pm * 128 + wr * 32 + fr) * lda + fq * 8;
        const bf16_t* b0 = Bt + (size_t)(pn * 128 + wc * 64 + fr) * ldb + fq * 8;
        for (int k = 0; k < K; k += 32) {
            bf16x8 af[2], bfr[4];
#pragma unroll
            for (int i = 0; i < 2; ++i) af[i] = *(const bf16x8*)(a0 + (size_t)i * 16 * lda + k);
#pragma unroll
            for (int j = 0; j < 4; ++j) bfr[j] = *(const bf16x8*)(b0 + (size_t)j * 16 * ldb + k);
#pragma unroll
            for (int i = 0; i < 2; ++i)
#pragma unroll
                for (int j = 0; j < 4; ++j) acc[i][j] = __builtin_amdgcn_mfma_f32_16x16x32_bf16(bfr[j], af[i], acc[i][j], 0, 0, 0);
        }
#pragma unroll
        for (int i = 0; i < 2; ++i)
#pragma unroll
            for (int j = 0; j < 4; ++j) epi(pm * 128 + wr * 32 + i * 16 + fr, pn * 128 + wc * 64 + j * 16 + 4 * fq, acc[i][j]);
    }
}

struct EpiIn {
    const float* rss; const float* bias; bf16_t* proj; int odd;
    __device__ __forceinline__ void operator()(int row, int col, f32x4 v) const {
        const f32x4* rp = (const f32x4*)(rss + (size_t)row * 16);
        const f32x4 s0 = rp[0], s1 = rp[1], s2 = rp[2], s3 = rp[3];
        const float ss = ((s0.x + s0.y) + (s0.z + s0.w)) + ((s1.x + s1.y) + (s1.z + s1.w)) + ((s2.x + s2.y) + (s2.z + s2.w)) + ((s3.x + s3.y) + (s3.z + s3.w));
        const float rstd = rsqrtf(ss * (1.f / DM) + EPS);
        const f32x4 bv = *(const f32x4*)(bias + (size_t)cond_row(row) * NPROJ + col);
        v = v * rstd + bv;
        const bool act = odd ? (col >= 1536) : ((col >= 1024 && col < 1536) || col >= 2048);
        if (act) { v.x = silu_f(v.x); v.y = silu_f(v.y); v.z = silu_f(v.z); v.w = silu_f(v.w); }
        u32x2 o; o.x = pk2(v.x, v.y); o.y = pk2(v.z, v.w);
        *(u32x2*)(proj + (size_t)row * NPROJ + col) = o;
    }
};
struct EpiOut {
    const float* xold; const float* cold; float* xnew; float* cnew; const float* mods; int skip_ctx;
    __device__ __forceinline__ void operator()(int row, int col, f32x4 v) const {
        bool ic; const size_t off = res_off(row, ic) + col;
        if (ic && skip_ctx) return;
        const f32x4 gt = *(const f32x4*)(mods + (size_t)cond_row(row) * 3072 + 2048 + col);
        const f32x4 o = *(const f32x4*)((ic ? cold : xold) + off);
        *(f32x4*)((ic ? cnew : xnew) + off) = o + gt * v;
    }
};
struct EpiGlu {
    const bf16_t* yg; const bf16_t* proj; const float* bglu; bf16_t* mix;
    __device__ __forceinline__ void operator()(int row, int col, f32x4 v) const {
        const f32x4 b = *(const f32x4*)(bglu + col);
        const u32x2 yw = *(const u32x2*)(yg + (size_t)row * 512 + col), gw = *(const u32x2*)(proj + (size_t)row * NPROJ + 2048 + col);
        const float o0 = bflo(yw.x) * sigmoid_f(v.x + b.x) * bflo(gw.x), o1 = bfhi(yw.x) * sigmoid_f(v.y + b.y) * bfhi(gw.x);
        const float o2 = bflo(yw.y) * sigmoid_f(v.z + b.z) * bflo(gw.y), o3 = bfhi(yw.y) * sigmoid_f(v.w + b.w) * bfhi(gw.y);
        u32x2 o; o.x = pk2(o0, o1); o.y = pk2(o2, o3);
        *(u32x2*)(mix + (size_t)row * DM + 512 + col) = o;
    }
};


template <class E> struct EpiTile {
    static constexpr bool PERM = false, AFTER_DRAIN = false; E e;
    __device__ __forceinline__ void operator()(const pg8::f32x4 (&acc)[2][2][4][2], const pg8::Unit& u, int wr, int wc, int fr, int fq) const {
#pragma unroll
        for (int ai = 0; ai < 2; ++ai)
#pragma unroll
            for (int m = 0; m < 4; ++m) { const int row = u.pm * 256 + ai * 128 + wr * 64 + m * 16 + fr;
#pragma unroll
                for (int bj = 0; bj < 2; ++bj)
#pragma unroll
                    for (int n = 0; n < 2; ++n) e(row, u.pn * 256 + bj * 128 + wc * 32 + n * 16 + 4 * fq, acc[ai][bj][m][n]); }
    }
};
template <class E> __device__ __forceinline__ void gemm_fast(const Ctx& c, const bf16_t* A, const bf16_t* Bt, int M, int N, int K, const E& e) {
    pg8::Gemm g{A, Bt, M, N, K}; pg8::StaticOrder S; S.init(M, N, (int)gridDim.x, (int)blockIdx.x);
    EpiTile<E> E2{e};
    pg8::gemm_phase<EpiTile<E>, pg8::StaticOrder, true, true>((PG8_LAS unsigned char*)c.lds, g, S, E2, c.tid);
    __syncthreads();
}


struct EpiInTile {
    static constexpr bool PERM = true, AFTER_DRAIN = false;
    const float* rss; const float* bias; bf16_t* proj; int odd; const float* qg; const float* kg; const float* rope; float* red; float* vst;
    __device__ __forceinline__ void operator()(const pg8::f32x4 (&acc)[2][2][4][2], const pg8::Unit& u, int wr, int wc, int fr, int fq) const {
        asm volatile("" : "+v"(fr), "+v"(fq));
        const int pmb = u.pm / 17, jt = u.pm - pmb * 17, r = jt == 0 ? 4 : pmb;
        const int colb = u.pn * 256 + wc * 32 + 8 * fq;
        f32x4 bv[2][2];
#pragma unroll
        for (int bj = 0; bj < 2; ++bj)
#pragma unroll
            for (int n = 0; n < 2; ++n) bv[bj][n] = *(const f32x4*)(bias + (size_t)r * NPROJ + colb + bj * 128 + n * 4);
        float rstd[2][4];
        {
            int tl = (wr * 4 + wc) * 64 + fq * 16 + fr; asm volatile("" : "+v"(tl));
            if (tl < 256) { const f32x4* rp = (const f32x4*)(rss + ((size_t)u.pm * 256 + tl) * 16);
                const f32x4 s0 = rp[0], s1 = rp[1], s2 = rp[2], s3 = rp[3];
                const float ss = ((s0.x + s0.y) + (s0.z + s0.w)) + ((s1.x + s1.y) + (s1.z + s1.w)) + ((s2.x + s2.y) + (s2.z + s2.w)) + ((s3.x + s3.y) + (s3.z + s3.w));
                red[2048 + tl] = rsqrtf(ss * (1.f / DM) + EPS); }
            asm volatile("s_waitcnt lgkmcnt(0)" ::: "memory"); __builtin_amdgcn_s_barrier(); asm volatile("" ::: "memory");
#pragma unroll
            for (int ai = 0; ai < 2; ++ai)
#pragma unroll
                for (int m = 0; m < 4; ++m) rstd[ai][m] = red[2048 + ai * 128 + wr * 64 + m * 16 + fr];
        }
        const bool qk = odd && u.pn <= 4;
        if (qk) {
#pragma unroll
            for (int ai = 0; ai < 2; ++ai)
#pragma unroll
                for (int m = 0; m < 4; ++m)
#pragma unroll
                    for (int bj = 0; bj < 2; ++bj) { const f32x4 v0 = acc[ai][bj][m][0] * rstd[ai][m] + bv[bj][0], v1 = acc[ai][bj][m][1] * rstd[ai][m] + bv[bj][1];
                        float s_ = ((v0.x * v0.x + v0.y * v0.y) + (v0.z * v0.z + v0.w * v0.w)) + ((v1.x * v1.x + v1.y * v1.y) + (v1.z * v1.z + v1.w * v1.w));
                        s_ = quad16_sum(s_);
                        if (fq == 0) red[((ai * 128 + wr * 64 + m * 16 + fr) * 2 + bj) * 4 + wc] = s_; }
            asm volatile("s_waitcnt lgkmcnt(0)" ::: "memory"); __builtin_amdgcn_s_barrier(); asm volatile("" ::: "memory");
        }
        const bool vt = !odd && (u.pn == 2 || u.pn == 3);
        const float* gn = u.pn == 4 ? kg : qg;
        const int a_ = wc >> 1, p0 = (wc & 1) * 16 + fq * 4, d0 = a_ * 64 + p0;
        f32x4 csT[4][2];
#pragma unroll
        for (int e = 0; e < 4; ++e) { csT[e][0] = (f32x4){1.f, 0.f, 1.f, 0.f}; csT[e][1] = csT[e][0]; }
        if (qk && jt != 0) {
#pragma unroll
            for (int e = 0; e < 4; ++e) { const int pos = a_ == 0 ? ((jt - 1) * 4 + (e & 1) * 2 + wr) : (e * 16 + fr); const float* rp = rope + (size_t)(pos * 32 + p0) * 2; csT[e][0] = *(const f32x4*)rp; csT[e][1] = *(const f32x4*)(rp + 4); }
        }
#pragma unroll
        for (int ai = 0; ai < 2; ++ai)
#pragma unroll
            for (int m = 0; m < 4; ++m) { const int rt = ai * 128 + wr * 64 + m * 16 + fr; const int row = u.pm * 256 + rt;
                bf16_t* rowp = proj + (size_t)row * NPROJ + colb; float vs1 = 0.f, vs2 = 0.f;
                const f32x4 cs0 = a_ == 0 ? csT[ai][0] : csT[m][0], cs1 = a_ == 0 ? csT[ai][1] : csT[m][1];
#pragma unroll
                for (int bj = 0; bj < 2; ++bj) { const int c0 = u.pn * 256 + bj * 128;
                    const bool act = odd ? (c0 >= 1536) : ((c0 >= 1024 && c0 < 1536) || c0 >= 2048);
                    f32x4 v0 = acc[ai][bj][m][0] * rstd[ai][m] + bv[bj][0], v1 = acc[ai][bj][m][1] * rstd[ai][m] + bv[bj][1];
                    if (act) { v0.x = silu_f(v0.x); v0.y = silu_f(v0.y); v0.z = silu_f(v0.z); v0.w = silu_f(v0.w); v1.x = silu_f(v1.x); v1.y = silu_f(v1.y); v1.z = silu_f(v1.z); v1.w = silu_f(v1.w); }
                    if (qk) { const f32x4 pr = *(const f32x4*)(red + ((rt) * 2 + bj) * 4);
                        const float hr = rsqrtf(((pr.x + pr.y) + (pr.z + pr.w)) * (1.f / 128.f) + EPS);
                        const f32x4 g1 = *(const f32x4*)(gn + d0), g2 = *(const f32x4*)(gn + d0 + 32);
                        const f32x4 x1 = v0 * hr * g1, x2 = v1 * hr * g2;
                        v0.x = x1.x * cs0.x - x2.x * cs0.y; v1.x = x1.x * cs0.y + x2.x * cs0.x; v0.y = x1.y * cs0.z - x2.y * cs0.w; v1.y = x1.y * cs0.w + x2.y * cs0.z;
                        v0.z = x1.z * cs1.x - x2.z * cs1.y; v1.z = x1.z * cs1.y + x2.z * cs1.x; v0.w = x1.w * cs1.z - x2.w * cs1.w; v1.w = x1.w * cs1.w + x2.w * cs1.z; }
                    if (vt) { vs1 += ((v0.x + v0.y) + (v0.z + v0.w)) + ((v1.x + v1.y) + (v1.z + v1.w)); vs2 += ((v0.x * v0.x + v0.y * v0.y) + (v0.z * v0.z + v0.w * v0.w)) + ((v1.x * v1.x + v1.y * v1.y) + (v1.z * v1.z + v1.w * v1.w)); }
                    u32x4 o; o.x = pk2(v0.x, v0.y); o.y = pk2(v0.z, v0.w); o.z = pk2(v1.x, v1.y); o.w = pk2(v1.z, v1.w); *(u32x4*)(rowp + bj * 128) = o; }
                if (vt) { vs1 = quad16_sum(vs1); vs2 = quad16_sum(vs2);
                    if (fq == 0) { float2 w_; w_.x = vs1; w_.y = vs2; *(float2*)(vst + ((size_t)row * 8 + (u.pn - 2) * 4 + wc) * 2) = w_; } }
            }
    }
};
struct EpiGluTile {
    static constexpr bool PERM = true, AFTER_DRAIN = false;
    const bf16_t* yg; const bf16_t* proj; const float* bglu; bf16_t* mix;
    __device__ __forceinline__ void operator()(const pg8::f32x4 (&acc)[2][2][4][2], const pg8::Unit& u, int wr, int wc, int fr, int fq) const {
        asm volatile("" : "+v"(fr), "+v"(fq));
        const int colb = u.pn * 256 + wc * 32 + 8 * fq;
        f32x4 bv[2][2];
#pragma unroll
        for (int bj = 0; bj < 2; ++bj)
#pragma unroll
            for (int n = 0; n < 2; ++n) bv[bj][n] = *(const f32x4*)(bglu + colb + bj * 128 + n * 4);
#pragma unroll
        for (int ai = 0; ai < 2; ++ai)
#pragma unroll
            for (int m = 0; m < 4; ++m) { const int row = u.pm * 256 + ai * 128 + wr * 64 + m * 16 + fr;
#pragma unroll
                for (int bj = 0; bj < 2; ++bj) { const int col = colb + bj * 128; const f32x4 v0 = acc[ai][bj][m][0] + bv[bj][0], v1 = acc[ai][bj][m][1] + bv[bj][1];
                    const u32x4 yw = *(const u32x4*)(yg + (size_t)row * 512 + col), gw = *(const u32x4*)(proj + (size_t)row * NPROJ + 2048 + col);
                    u32x4 o; o.x = pk2(bflo(yw.x) * sigmoid_f(v0.x) * bflo(gw.x), bfhi(yw.x) * sigmoid_f(v0.y) * bfhi(gw.x)); o.y = pk2(bflo(yw.y) * sigmoid_f(v0.z) * bflo(gw.y), bfhi(yw.y) * sigmoid_f(v0.w) * bfhi(gw.y));
                    o.z = pk2(bflo(yw.z) * sigmoid_f(v1.x) * bflo(gw.z), bfhi(yw.z) * sigmoid_f(v1.y) * bfhi(gw.z)); o.w = pk2(bflo(yw.w) * sigmoid_f(v1.z) * bflo(gw.w), bfhi(yw.w) * sigmoid_f(v1.w) * bfhi(gw.w));
                    *(u32x4*)(mix + (size_t)row * DM + 512 + col) = o; }
                if (m & 1) asm volatile("" ::: "memory"); }
    }
};
template <class ET> __device__ __forceinline__ void gemm_fast_tile(const Ctx& c, const bf16_t* A, const bf16_t* Bt, int M, int N, int K, const ET& e) {
    pg8::Gemm g{A, Bt, M, N, K}; pg8::StaticOrder S; S.init(M, N, (int)gridDim.x, (int)blockIdx.x);
    pg8::gemm_phase<ET, pg8::StaticOrder, true, true>((PG8_LAS unsigned char*)c.lds, g, S, e, c.tid);
    __syncthreads();
}


struct LatentOrder {
    pg8::StaticOrder s;
    __device__ void init(int N, int G_, int c_) { s.init(NB * SEQ, N, G_, c_); }
    __device__ bool next(int i, pg8::Unit& u) const { if (!s.next(i, u)) return false; u.pm = (u.pm >> 4) * 17 + (u.pm & 15) + 1; return true; }
    __device__ __forceinline__ void a_ready(const pg8::Unit&) const {}
    __device__ __forceinline__ void done(const pg8::Unit&) const {}
};
struct EpiOutTile {
    static constexpr bool PERM = true, AFTER_DRAIN = false;
    const float* xold_f; const bf16_t* xold_b; float* xnew_f; bf16_t* xnew_b;
    const float* mods; const float* mods_next; const float* gnext; bf16_t* xm; float* rss;
    __device__ __forceinline__ void operator()(const pg8::f32x4 (&acc)[2][2][4][2], const pg8::Unit& u, int wr, int wc, int fr, int fq) const {
        asm volatile("" : "+v"(fr), "+v"(fq));
        const int b = u.pm / 17, j = u.pm - b * 17;
        const int colb = u.pn * 256 + wc * 32 + 8 * fq;
        const size_t off0 = ((size_t)b * SEQ + (j - 1) * 256 + wr * 64 + fr) * DM + colb;
        const size_t row0 = (size_t)u.pm * 256 + wr * 64 + fr;
        float ss[2][4];
#pragma unroll
        for (int ai = 0; ai < 2; ++ai)
#pragma unroll
            for (int m = 0; m < 4; ++m) ss[ai][m] = 0.f;
#define EPI_OUT_BATCH(BJ, AI0) do { \
            f32x4 xo[4][2]; \
            if (xold_b) { _Pragma("unroll") for (int m = 0; m < 4; ++m) { const u32x4 w_ = *(const u32x4*)(xold_b + off0 + (size_t)((AI0) * 128 + m * 16) * DM + BJ * 128); \
                    xo[m][0] = (f32x4){bflo(w_.x), bfhi(w_.x), bflo(w_.y), bfhi(w_.y)}; xo[m][1] = (f32x4){bflo(w_.z), bfhi(w_.z), bflo(w_.w), bfhi(w_.w)}; } } \
            else { _Pragma("unroll") for (int m = 0; m < 4; ++m) { const float* xp = xold_f + off0 + (size_t)((AI0) * 128 + m * 16) * DM + BJ * 128; xo[m][0] = *(const f32x4*)xp; xo[m][1] = *(const f32x4*)(xp + 4); } } \
            const int col = colb + BJ * 128; \
            const f32x4 gt0 = *(const f32x4*)(mods + (size_t)b * 3072 + 2048 + col), gt1 = *(const f32x4*)(mods + (size_t)b * 3072 + 2048 + col + 4); \
            f32x4 an0 = (f32x4){0.f, 0.f, 0.f, 0.f}, an1 = an0; \
            if (mods_next) { an0 = *(const f32x4*)(gnext + col) * (*(const f32x4*)(mods_next + (size_t)b * 3072 + 1024 + col) + 1.f); an1 = *(const f32x4*)(gnext + col + 4) * (*(const f32x4*)(mods_next + (size_t)b * 3072 + 1024 + col + 4) + 1.f); } \
            _Pragma("unroll") for (int m = 0; m < 4; ++m) { const int ai = AI0; \
                    const f32x4 x0 = xo[m][0] + gt0 * acc[ai][BJ][m][0], x1 = xo[m][1] + gt1 * acc[ai][BJ][m][1]; \
                    const size_t o_ = off0 + (size_t)(ai * 128 + m * 16) * DM + BJ * 128; \
                    if (xnew_b) { u32x4 w; w.x = pk2(x0.x, x0.y); w.y = pk2(x0.z, x0.w); w.z = pk2(x1.x, x1.y); w.w = pk2(x1.z, x1.w); *(u32x4*)(xnew_b + o_) = w; } \
                    else { *(f32x4*)(xnew_f + o_) = x0; *(f32x4*)(xnew_f + o_ + 4) = x1; } \
                    ss[ai][m] += ((x0.x * x0.x + x0.y * x0.y) + (x0.z * x0.z + x0.w * x0.w)) + ((x1.x * x1.x + x1.y * x1.y) + (x1.z * x1.z + x1.w * x1.w)); \
                    if (mods_next) { const f32x4 h0 = x0 * an0, h1 = x1 * an1; u32x4 w; w.x = pk2(h0.x, h0.y); w.y = pk2(h0.z, h0.w); w.z = pk2(h1.x, h1.y); w.w = pk2(h1.z, h1.w); \
                        *(u32x4*)(xm + (row0 + ai * 128 + m * 16) * DM + col) = w; } } \
            asm volatile("" ::: "memory"); } while (0)
        EPI_OUT_BATCH(0, 0); EPI_OUT_BATCH(0, 1); EPI_OUT_BATCH(1, 0); EPI_OUT_BATCH(1, 1);
#undef EPI_OUT_BATCH
        {
#pragma unroll
            for (int ai = 0; ai < 2; ++ai)
#pragma unroll
                for (int m = 0; m < 4; ++m) { float s_ = quad16_sum(ss[ai][m]); if (fq == 0) rss[(row0 + ai * 128 + m * 16) * 16 + u.pn * 4 + wc] = s_; }
        }
    }
};

struct EpiOutDrain {
    static constexpr bool PERM = true, AFTER_DRAIN = true;
    const bf16_t* xb; bf16_t* xbo; const float* mods; const float* mods_next; const float* gnext; bf16_t* xm; float* rss; int wxm;
    __device__ __forceinline__ void operator()(const pg8::f32x4 (&)[2][2][4][2], const pg8::Unit&, int, int, int, int) const {}
    __device__ __forceinline__ void fused(pg8::f32x4 (&acc)[2][2][4][2], const pg8::Unit& u, int wr, int wc, int fr, int fq, PG8_LAS unsigned char* lds, int wid, int lane) const {
        asm volatile("" : "+v"(fr), "+v"(fq), "+v"(lane));
        const int b = u.pm / 17, j = u.pm - b * 17;
        const int colb = u.pn * 256 + wc * 32 + 8 * fq;
        const size_t off0 = ((size_t)b * SEQ + (j - 1) * 256 + wr * 64 + fr) * DM + colb;
        const size_t row0 = (size_t)u.pm * 256 + wr * 64 + fr;
        PG8_LAS unsigned char* wb = lds + wid * 16384;
#pragma unroll
        for (int bj = 0; bj < 2; ++bj)
#pragma unroll
            for (int ai = 0; ai < 2; ++ai)
#pragma unroll
                for (int m = 0; m < 4; ++m)
                    __builtin_amdgcn_global_load_lds((const unsigned*)(xb + off0 + (size_t)(ai * 128 + m * 16) * DM + bj * 128), (PG8_LAS unsigned*)(wb + ((bj * 2 + ai) * 4 + m) * 1024), 16, 0, 0);
        float ss[2][4];
#pragma unroll
        for (int ai = 0; ai < 2; ++ai)
#pragma unroll
            for (int m = 0; m < 4; ++m) ss[ai][m] = 0.f;
        f32x4 gt[2][2], an[2][2];
#pragma unroll
        for (int bj = 0; bj < 2; ++bj)
#pragma unroll
            for (int n = 0; n < 2; ++n) { const int col = colb + bj * 128 + n * 4;
                gt[bj][n] = *(const f32x4*)(mods + (size_t)b * 3072 + 2048 + col);
                an[bj][n] = wxm ? *(const f32x4*)(gnext + col) * (*(const f32x4*)(mods_next + (size_t)b * 3072 + 1024 + col) + 1.f) : (f32x4){0.f, 0.f, 0.f, 0.f}; }
        asm volatile("s_waitcnt vmcnt(0)" ::: "memory");
#pragma unroll
        for (int bj = 0; bj < 2; ++bj)
#pragma unroll
            for (int ai = 0; ai < 2; ++ai)
#pragma unroll
                for (int m = 0; m < 4; ++m) { const u32x4 w_ = *(const PG8_LAS u32x4*)(wb + ((bj * 2 + ai) * 4 + m) * 1024 + lane * 16);
                    const f32x4 x0 = (f32x4){bflo(w_.x), bfhi(w_.x), bflo(w_.y), bfhi(w_.y)} + gt[bj][0] * acc[ai][bj][m][0], x1 = (f32x4){bflo(w_.z), bfhi(w_.z), bflo(w_.w), bfhi(w_.w)} + gt[bj][1] * acc[ai][bj][m][1];
                    const size_t o_ = off0 + (size_t)(ai * 128 + m * 16) * DM + bj * 128;
                    { u32x4 w; w.x = pk2(x0.x, x0.y); w.y = pk2(x0.z, x0.w); w.z = pk2(x1.x, x1.y); w.w = pk2(x1.z, x1.w); *(u32x4*)(xbo + o_) = w; }
                    ss[ai][m] += ((x0.x * x0.x + x0.y * x0.y) + (x0.z * x0.z + x0.w * x0.w)) + ((x1.x * x1.x + x1.y * x1.y) + (x1.z * x1.z + x1.w * x1.w));
                    if (wxm) { const f32x4 h0 = x0 * an[bj][0], h1 = x1 * an[bj][1]; u32x4 w; w.x = pk2(h0.x, h0.y); w.y = pk2(h0.z, h0.w); w.z = pk2(h1.x, h1.y); w.w = pk2(h1.z, h1.w);
                        *(u32x4*)(xm + (row0 + ai * 128 + m * 16) * DM + colb + bj * 128) = w; } }
#pragma unroll
        for (int ai = 0; ai < 2; ++ai)
#pragma unroll
            for (int m = 0; m < 4; ++m) { const float s_ = quad16_sum(ss[ai][m]); if (fq == 0) rss[(row0 + ai * 128 + m * 16) * 16 + u.pn * 4 + wc] = s_; }
    }
};
__device__ __forceinline__ void out_ctx_small(const Ctx& c, int l, const float* cold, float* cnew) {
    const P& p = *c.p;
    const bf16_t* mix = (const bf16_t*)(p.ws + WS_MIX); const bf16_t* wt = (const bf16_t*)(p.ws + WS_WOUT) + (size_t)l * DM * DM;
    const float* mods = (const float*)(p.ws + WS_MODS) + (size_t)l * 5 * 3072 + 4 * 3072; const float* modsn = (const float*)(p.ws + WS_MODS) + (size_t)(l + 1) * 5 * 3072 + 4 * 3072;
    const float* gnext = p.in[4] + (l + 1) * DM; bf16_t* xm = (bf16_t*)(p.ws + WS_XM); float* rss = (float*)(p.ws + WS_RSS);
    const int wid = __builtin_amdgcn_readfirstlane(c.wid), fr = c.lane & 15, fq = c.lane >> 4, rg = wid & 3, kh = wid >> 2;
    float* red = (float*)c.lds;
    for (int t = blockIdx.x; t < 256; t += gridDim.x) {
        const int rm = t >> 4, cn = t & 15;
        const int cr = rm * 64 + rg * 16 + fr, b = cr >> 8, ti = cr & 255;
        const size_t m = (size_t)b * TPB + ti;
        f32x4 acc[4];
#pragma unroll
        for (int q = 0; q < 4; ++q) acc[q] = (f32x4){0.f, 0.f, 0.f, 0.f};
        const bf16_t* a0 = mix + m * DM + kh * 512 + fq * 8; const bf16_t* b0 = wt + (size_t)(cn * 64 + fr) * DM + kh * 512 + fq * 8;
#pragma unroll 4
        for (int k = 0; k < 512; k += 32) { const bf16x8 af = *(const bf16x8*)(a0 + k);
#pragma unroll
            for (int q = 0; q < 4; ++q) { const bf16x8 bf = *(const bf16x8*)(b0 + (size_t)q * 16 * DM + k); acc[q] = __builtin_amdgcn_mfma_f32_16x16x32_bf16(bf, af, acc[q], 0, 0, 0); } }
        __syncthreads();
        if (kh == 1) {
#pragma unroll
            for (int q = 0; q < 4; ++q) *(f32x4*)(red + ((rg * 64 + c.lane) * 4 + q) * 4) = acc[q]; }
        __syncthreads();
        if (kh == 0) {
            float ss = 0.f; const size_t off = ((size_t)b * NCTX + ti) * DM;
#pragma unroll
            for (int q = 0; q < 4; ++q) { const int col = cn * 64 + q * 16 + 4 * fq;
                const f32x4 a2 = acc[q] + *(const f32x4*)(red + ((rg * 64 + c.lane) * 4 + q) * 4);
                const f32x4 gt = *(const f32x4*)(mods + 2048 + col), sc = *(const f32x4*)(modsn + 1024 + col), gv = *(const f32x4*)(gnext + col);
                const f32x4 o = *(const f32x4*)(cold + off + col); const f32x4 xn = o + gt * a2;
                *(f32x4*)(cnew + off + col) = xn; ss += (xn.x * xn.x + xn.y * xn.y) + (xn.z * xn.z + xn.w * xn.w);
                const f32x4 h = xn * gv * (sc + 1.f); u32x2 w; w.x = pk2(h.x, h.y); w.y = pk2(h.z, h.w); *(u32x2*)(xm + m * DM + col) = w; }
            ss = quad16_sum(ss); if (fq == 0) rss[m * 16 + cn] = ss;
        }
    }
    __syncthreads();
}

__device__ __forceinline__ void phase_in(const Ctx& c, int l) {
    const P& p = *c.p;
    EpiIn e{(const float*)(p.ws + WS_RSS), (const float*)(p.ws + WS_BIAS) + (size_t)l * 5 * NPROJ, (bf16_t*)(p.ws + WS_PROJ), l & 1};
    #ifdef USE_PG8
    { const int i_ = l >> 1; EpiInTile et{e.rss, e.bias, e.proj, e.odd, p.in[24] + i_ * 128, p.in[25] + i_ * 128, (const float*)(p.ws + WS_ROPE), (float*)(c.lds + 131072), (float*)(p.ws + WS_VST)}; gemm_fast_tile(c, (const bf16_t*)(p.ws + WS_XM), (const bf16_t*)(p.ws + WS_WIN) + (size_t)l * NPROJ * DM, MTOK, NPROJ, DM, et); }
#else
    gemm_simple(c, (const bf16_t*)(p.ws + WS_XM), DM, (const bf16_t*)(p.ws + WS_WIN) + (size_t)l * NPROJ * DM, DM, MTOK, NPROJ, DM, e);
#endif
}
__device__ __forceinline__ void phase_out(const Ctx& c, int l) {
    const P& p = *c.p;
    float* cres = (float*)(p.ws + WS_CTXRES);
    const bool last = l == DEPTH - 1;
    bf16_t* xb = (bf16_t*)(p.ws + WS_XB);
    EpiOutTile e{nullptr, xb, nullptr, xb, (const float*)(p.ws + WS_MODS) + (size_t)l * 5 * 3072, last ? nullptr : (const float*)(p.ws + WS_MODS) + (size_t)(l + 1) * 5 * 3072,
                 last ? nullptr : p.in[4] + (l + 1) * DM, (bf16_t*)(p.ws + WS_XM), (float*)(p.ws + WS_RSS)};
    pg8::Gemm g{(const bf16_t*)(p.ws + WS_MIX), (const bf16_t*)(p.ws + WS_WOUT) + (size_t)l * DM * DM, MTOK, DM, DM};
    LatentOrder S; S.init(DM, (int)gridDim.x, (int)blockIdx.x);
    if (gridDim.x == 256) {
        EpiOutDrain ed{xb, xb, e.mods, e.mods_next, e.gnext, e.xm, e.rss, last ? 0 : 1};
        pg8::gemm_phase<EpiOutDrain, LatentOrder, false, true>((PG8_LAS unsigned char*)c.lds, g, S, ed, c.tid);
    } else pg8::gemm_phase<EpiOutTile, LatentOrder, true, true>((PG8_LAS unsigned char*)c.lds, g, S, e, c.tid);
    __syncthreads();
    if (!last) out_ctx_small(c, l, l == 0 ? p.in[2] : cres, cres);
#if defined(DUPX) && DUPX == 3
    if (l == 0) out_ctx_small(c, l, p.in[2], cres);
#endif
}
__device__ __forceinline__ void phase_gmlp_fast(const Ctx& c, int l, int blk0, int nblk);
__device__ __forceinline__ void phase_glu(const Ctx& c, int l) {
    const P& p = *c.p; const int i = l >> 1;
    const int G = gridDim.x, ng = G >= 200 ? 136 : G;
    if ((int)blockIdx.x < ng) {
        EpiGluTile et{(const bf16_t*)(p.ws + WS_YG), (const bf16_t*)(p.ws + WS_PROJ), p.in[21] + i * 512, (bf16_t*)(p.ws + WS_MIX)};
        pg8::Gemm g{(const bf16_t*)(p.ws + WS_YG), (const bf16_t*)(p.ws + WS_WGLU) + (size_t)i * 512 * 512, MTOK, 512, 512}; pg8::StaticOrder S; S.init(MTOK, 512, ng, (int)blockIdx.x);
        pg8::gemm_phase<EpiGluTile, pg8::StaticOrder, true, true>((PG8_LAS unsigned char*)c.lds, g, S, et, c.tid);
        __syncthreads();
        if (ng == G) phase_gmlp_fast(c, l, 0, G);
    } else phase_gmlp_fast(c, l, ng, G - ng);
}

__device__ __forceinline__ void phase_gmlp(const Ctx& c, int l) {
    const P& p = *c.p; const int i = l >> 1;
    const bf16_t* proj = (const bf16_t*)(p.ws + WS_PROJ); bf16_t* mix = (bf16_t*)(p.ws + WS_MIX);
    const float* vg = p.in[9] + i * 512; const float* ws_ = p.in[10] + (size_t)i * 4 * 128 * 128; const float* bs = p.in[11] + i * 4 * 128;
    float* vn = (float*)c.lds;
    for (int it = blockIdx.x; it < 136 * 4; it += gridDim.x) {
        const int ch = it >> 2, g = it & 3;
        __syncthreads();
        for (int q = c.wid; q < 128; q += NWAVES) {
            const size_t row = (size_t)ch * 128 + q;
            const u32x4 w = *(const u32x4*)(proj + row * NPROJ + 512 + c.lane * 8);
            float v[8] = {bflo(w.x), bfhi(w.x), bflo(w.y), bfhi(w.y), bflo(w.z), bfhi(w.z), bflo(w.w), bfhi(w.w)};
            float s = 0.f;
#pragma unroll
            for (int e = 0; e < 8; ++e) s += v[e];
            const float mu = wave_sum(s) * (1.f / 512.f); float s2 = 0.f;
#pragma unroll
            for (int e = 0; e < 8; ++e) { v[e] -= mu; s2 += v[e] * v[e]; }
            const float rstd = rsqrtf(wave_sum(s2) * (1.f / 512.f) + EPS);
            if ((c.lane >> 4) == g) {
#pragma unroll
                for (int e = 0; e < 8; ++e) { const int cc = (c.lane & 15) * 8 + e; vn[q * 129 + cc] = v[e] * rstd * vg[g * 128 + cc]; }
            }
        }
        __syncthreads();
        const int cc = c.tid & 127, pq = c.tid >> 7;
        for (int pp = pq * 32; pp < pq * 32 + 32; ++pp) {
            const float* wrow = ws_ + ((size_t)g * 128 + pp) * 128;
            float acc = 0.f;
#pragma unroll 8
            for (int q = 0; q < 128; ++q) acc += wrow[q] * vn[q * 129 + cc];
            const float mixed = acc + bs[g * 128 + pp];
            const size_t row = (size_t)ch * 128 + pp;
            const float u = bf2f(proj[row * NPROJ + g * 128 + cc]), ga = bf2f(proj[row * NPROJ + 1024 + g * 128 + cc]);
            mix[row * DM + g * 128 + cc] = (bf16_t)f2bf(u * mixed * ga);
        }
    }
}

__device__ __forceinline__ void phase_s5_naive(const Ctx& c, int l) {
    const P& p = *c.p; const int i = l >> 1;
    const bf16_t* proj = (const bf16_t*)(p.ws + WS_PROJ);
    float* red = (float*)(c.lds + 80 * 1024) + c.wid * 1024;
    for (int it = c.gw; it < NB * 32 * 2; it += c.ngw) {
        const int dir = it & 1, g = (it >> 1) & 31, b = it >> 6, pl = c.lane;
        float* Y = (float*)(p.ws + (dir ? WS_XM : WS_S5));
        const size_t dg = ((size_t)(i * 2 + dir) * 32 + g);
        const float dt = expf(p.in[14][dg]);
        const float lr = p.in[12][dg * 64 + pl], li = p.in[13][dg * 64 + pl];
        const float mag = expf(lr * dt), lbr = mag * cosf(li * dt), lbi = mag * sinf(li * dt);
        const float den = lr * lr + li * li, nre = lbr - 1.f, nim = lbi;
        const float fre = (nre * lr + nim * li) / den, fim = (nim * lr - nre * li) / den;
        float bbr[16], bbi[16], cr[16], ci[16];
#pragma unroll
        for (int h = 0; h < 16; ++h) { const float br = p.in[15][(dg * 64 + pl) * 16 + h], bi = p.in[16][(dg * 64 + pl) * 16 + h];
            bbr[h] = fre * br - fim * bi; bbi[h] = fre * bi + fim * br;
            cr[h] = p.in[17][(dg * 16 + h) * 64 + pl]; ci[h] = p.in[18][(dg * 16 + h) * 64 + pl]; }
        float hr = 0.f, hi = 0.f;
        for (int s0 = 0; s0 < TPB; s0 += 4) {
            u32x4 uw[4][2];
#pragma unroll
            for (int j = 0; j < 4; ++j) { const int s = s0 + j; const int t = dir == 0 ? s : (s < NCTX ? NCTX - 1 - s : NCTX + SEQ - 1 - (s - NCTX));
                const bf16_t* up = proj + (size_t)(b * TPB + t) * NPROJ + 1536 + g * 16; uw[j][0] = *(const u32x4*)up; uw[j][1] = *(const u32x4*)(up + 8); }
#pragma unroll
            for (int j = 0; j < 4; ++j) { const int s = s0 + j; const int t = dir == 0 ? s : (s < NCTX ? NCTX - 1 - s : NCTX + SEQ - 1 - (s - NCTX));
                float u[16];
#pragma unroll
                for (int q = 0; q < 2; ++q) { u[8 * q + 0] = bflo(uw[j][q].x); u[8 * q + 1] = bfhi(uw[j][q].x); u[8 * q + 2] = bflo(uw[j][q].y); u[8 * q + 3] = bfhi(uw[j][q].y);
                    u[8 * q + 4] = bflo(uw[j][q].z); u[8 * q + 5] = bfhi(uw[j][q].z); u[8 * q + 6] = bflo(uw[j][q].w); u[8 * q + 7] = bfhi(uw[j][q].w); }
                float bur = 0.f, bui = 0.f;
#pragma unroll
                for (int h = 0; h < 16; ++h) { bur += bbr[h] * u[h]; bui += bbi[h] * u[h]; }
                const float nhr = lbr * hr - lbi * hi + bur, nhi = lbr * hi + lbi * hr + bui; hr = nhr; hi = nhi;
#pragma unroll
                for (int h = 0; h < 16; ++h) red[h * 64 + pl] = cr[h] * hr - ci[h] * hi;
                asm volatile("s_waitcnt lgkmcnt(0)" ::: "memory");
                const int hh = pl & 15, part = pl >> 4; float sum = 0.f;
#pragma unroll
                for (int q = 0; q < 16; ++q) sum += red[hh * 64 + part * 16 + q];
                sum += __shfl_xor(sum, 16); sum += __shfl_xor(sum, 32);
                if (pl < 16) Y[(size_t)(b * TPB + t) * 512 + g * 16 + pl] = sum;
                asm volatile("s_waitcnt lgkmcnt(0)" ::: "memory");
            }
        }
    }
}
__device__ __forceinline__ void phase_s5comb(const Ctx& c, int l) {
    const P& p = *c.p; const int i = l >> 1;
    const float* Yf = (const float*)(p.ws + WS_S5); const float* Yb = (const float*)(p.ws + WS_XM); const bf16_t* proj = (const bf16_t*)(p.ws + WS_PROJ);
    bf16_t* yg = (bf16_t*)(p.ws + WS_YG); const float* d = p.in[19] + i * 512;
    const size_t n4 = (size_t)MTOK * 512 / 4;
    for (size_t e = (size_t)blockIdx.x * NTHREADS + c.tid; e < n4; e += (size_t)gridDim.x * NTHREADS) {
        const size_t row = e / 128; const int col = (int)(e % 128) * 4;
        const f32x4 a = *(const f32x4*)(Yf + row * 512 + col), b = *(const f32x4*)(Yb + row * 512 + col), dv = *(const f32x4*)(d + col);
        const u32x2 xw = *(const u32x2*)(proj + row * NPROJ + 1536 + col);
        const float y0 = a.x + b.x + dv.x * bflo(xw.x), y1 = a.y + b.y + dv.y * bfhi(xw.x), y2 = a.z + b.z + dv.z * bflo(xw.y), y3 = a.w + b.w + dv.w * bfhi(xw.y);
        u32x2 o; o.x = pk2(gelu_tanh_f(y0), gelu_tanh_f(y1)); o.y = pk2(gelu_tanh_f(y2), gelu_tanh_f(y3));
        *(u32x2*)(yg + row * 512 + col) = o;
    }
}


constexpr size_t S5T_LAM = 0, S5T_BBT = 64 * 1024, S5T_CMT = 320 * 1024;
constexpr size_t WS_WST = WS_S5 + 2 * MiB;
constexpr size_t WS_SCB = WS_S5 + 5 * MiB;
constexpr size_t WS_SR = WS_S5 + 10 * MiB;
typedef float f32x16 __attribute__((ext_vector_type(16)));

__device__ __forceinline__ void phase_s5prep(const Ctx& c) {
    const P& p = *c.p;
    for (int it = c.gw; it < 2 * 2 * 32; it += c.ngw) {
        const int i = it >> 6, dir = (it >> 5) & 1, g = it & 31, pl = c.lane;
        unsigned char* tb = p.ws + WS_S5 + (size_t)i * MiB;
        const size_t dg = ((size_t)(i * 2 + dir) * 32 + g);
        const float dt = expf(p.in[14][dg]);
        const float lr = p.in[12][dg * 64 + pl], li = p.in[13][dg * 64 + pl];
        const float mag = expf(lr * dt), lbr = mag * cosf(li * dt), lbi = mag * sinf(li * dt);
        const float den = lr * lr + li * li, nre = lbr - 1.f, nim = lbi;
        const float fre = (nre * lr + nim * li) / den, fim = (nim * lr - nre * li) / den;
        float* lam = (float*)(tb + S5T_LAM) + ((size_t)(dir * 32 + g) * 64 + pl) * 2; lam[0] = lbr; lam[1] = lbi;
        bf16_t* bbt = (bf16_t*)(tb + S5T_BBT) + (size_t)(dir * 32 + g) * 2 * 64 * 16; bf16_t* cmt = (bf16_t*)(tb + S5T_CMT) + (size_t)(dir * 32 + g) * 16 * 128;
#pragma unroll
        for (int h = 0; h < 16; ++h) { const float br = p.in[15][(dg * 64 + pl) * 16 + h], bi = p.in[16][(dg * 64 + pl) * 16 + h];
            bbt[(0 * 64 + pl) * 16 + h] = (bf16_t)f2bf(fre * br - fim * bi); bbt[(1 * 64 + pl) * 16 + h] = (bf16_t)f2bf(fre * bi + fim * br);
            cmt[h * 128 + 2 * pl] = (bf16_t)f2bf(p.in[17][(dg * 16 + h) * 64 + pl]); cmt[h * 128 + 2 * pl + 1] = (bf16_t)f2bf(-p.in[18][(dg * 16 + h) * 64 + pl]); }
    }
    bf16_t* wst = (bf16_t*)(p.ws + WS_WST);
    for (size_t e = (size_t)blockIdx.x * NTHREADS + c.tid; e < (size_t)2 * 4 * 128 * 128 / 4; e += (size_t)gridDim.x * NTHREADS) {
        const f32x4 v = *(const f32x4*)(p.in[10] + e * 4); u32x2 o; o.x = pk2(v.x, v.y); o.y = pk2(v.z, v.w); *(u32x2*)(wst + e * 4) = o; }
}

__device__ __forceinline__ void phase_gmlp_fast(const Ctx& c, int l, int blk0, int nblk) {
    const P& p = *c.p; const int i = l >> 1;
    const bf16_t* proj = (const bf16_t*)(p.ws + WS_PROJ); bf16_t* mix = (bf16_t*)(p.ws + WS_MIX);
    const float* vg = p.in[9] + i * 512; const float* bs = p.in[11] + i * 4 * 128;
    const bf16_t* wst = (const bf16_t*)(p.ws + WS_WST) + (size_t)i * 4 * 128 * 128;
    char* lds = (char*)c.lds;
    float* st = (float*)(lds + 32768);
    const int wid = __builtin_amdgcn_readfirstlane(c.wid), lane = c.lane, r32 = lane & 31, hi = lane >> 5;
    char* ost = lds + 36864 + wid * 4608;
    for (int it = (int)blockIdx.x - blk0; it < 136 * 4; it += nblk) {
        const int ch = it >> 2, g = it & 3;
        __syncthreads();
        if (c.tid < 128) {
            const f32x4* vp = (const f32x4*)((const float*)(p.ws + WS_VST) + ((size_t)ch * 128 + c.tid) * 16);
            const f32x4 a0 = vp[0], a1 = vp[1], a2 = vp[2], a3 = vp[3];
            const float s1 = ((a0.x + a0.z) + (a1.x + a1.z)) + ((a2.x + a2.z) + (a3.x + a3.z)), s2 = ((a0.y + a0.w) + (a1.y + a1.w)) + ((a2.y + a2.w) + (a3.y + a3.w));
            const float mu = s1 * (1.f / 512.f); const float var = fmaxf(s2 * (1.f / 512.f) - mu * mu, 0.f);
            st[2 * c.tid] = mu; st[2 * c.tid + 1] = rsqrtf(var + EPS);
        }
        __syncthreads();
        { const int sr = c.tid >> 4, sc = (c.tid & 15) * 8;
            float gv[8];
#pragma unroll
            for (int e = 0; e < 8; ++e) gv[e] = vg[g * 128 + sc + e];
#pragma unroll
            for (int t = 0; t < 2; ++t)
#pragma unroll
                for (int hh = 0; hh < 2; ++hh) { const int q = t * 64 + hh * 32 + sr;
                    const u32x4 w = *(const u32x4*)(proj + ((size_t)ch * 128 + q) * NPROJ + 512 + g * 128 + sc);
                    const float mu = st[2 * q], rs = st[2 * q + 1];
                    u32x4 o; o.x = pk2((bflo(w.x) - mu) * rs * gv[0], (bfhi(w.x) - mu) * rs * gv[1]); o.y = pk2((bflo(w.y) - mu) * rs * gv[2], (bfhi(w.y) - mu) * rs * gv[3]);
                    o.z = pk2((bflo(w.z) - mu) * rs * gv[4], (bfhi(w.z) - mu) * rs * gv[5]); o.w = pk2((bflo(w.w) - mu) * rs * gv[6], (bfhi(w.w) - mu) * rs * gv[7]);
                    *(u32x4*)(lds + t * 16384 + attn::v_st(hh * 32 + sr, sc)) = o; }
        }
        __syncthreads();
        const int pw = wid & 3, cw = wid >> 2;
        f32x16 o0 = {}, o1 = {};
        const int vb = (int)(uintptr_t)lds + attn::v_rd_base(lane);
        const bf16_t* wrow = wst + ((size_t)g * 128 + pw * 32 + r32) * 128 + hi * 8;
#pragma unroll
        for (int t = 0; t < 2; ++t) {
            const bf16x8 pa0 = *(const bf16x8*)(wrow + t * 64), pa1 = *(const bf16x8*)(wrow + t * 64 + 16), pa2 = *(const bf16x8*)(wrow + t * 64 + 32), pa3 = *(const bf16x8*)(wrow + t * 64 + 48);
            if (cw == 0) { attn::pv_one<0>(o0, vb + t * 16384, pa0, pa1, pa2, pa3); attn::pv_one<1>(o1, vb + t * 16384, pa0, pa1, pa2, pa3); }
            else         { attn::pv_one<2>(o0, vb + t * 16384, pa0, pa1, pa2, pa3); attn::pv_one<3>(o1, vb + t * 16384, pa0, pa1, pa2, pa3); }
        }
        {
            int ob = hi * (4 * 144) + r32 * 2; asm volatile("" : "+v"(ob));
#pragma unroll
            for (int r = 0; r < 16; ++r) { const int prow0 = (r & 3) + 8 * (r >> 2); const float b = bs[g * 128 + pw * 32 + prow0 + 4 * hi];
                *(bf16_t*)(ost + ob + prow0 * 144) = (bf16_t)f2bf(o0[r] + b); *(bf16_t*)(ost + ob + prow0 * 144 + 64) = (bf16_t)f2bf(o1[r] + b); }
            asm volatile("s_waitcnt lgkmcnt(0)" ::: "memory");
#pragma unroll
            for (int k = 0; k < 4; ++k) { const int id = k * 64 + lane, row = id >> 3, chk = id & 7;
                const u32x4 mv = *(const u32x4*)(ost + row * 144 + chk * 16);
                const size_t grow = (size_t)ch * 128 + pw * 32 + row; const int col = g * 128 + cw * 64 + chk * 8;
                const u32x4 uv = *(const u32x4*)(proj + grow * NPROJ + col), gvv = *(const u32x4*)(proj + grow * NPROJ + 1024 + col);
                u32x4 w; w.x = pk2(bflo(uv.x) * bflo(mv.x) * bflo(gvv.x), bfhi(uv.x) * bfhi(mv.x) * bfhi(gvv.x)); w.y = pk2(bflo(uv.y) * bflo(mv.y) * bflo(gvv.y), bfhi(uv.y) * bfhi(mv.y) * bfhi(gvv.y));
                w.z = pk2(bflo(uv.z) * bflo(mv.z) * bflo(gvv.z), bfhi(uv.z) * bfhi(mv.z) * bfhi(gvv.z)); w.w = pk2(bflo(uv.w) * bflo(mv.w) * bflo(gvv.w), bfhi(uv.w) * bfhi(mv.w) * bfhi(gvv.w));
                *(u32x4*)(mix + grow * DM + col) = w; }
            asm volatile("s_waitcnt lgkmcnt(0)" ::: "memory");
        }
    }
}

struct cplx { float r, i; };
__device__ __forceinline__ cplx cmul(cplx a, cplx b) { return {a.r * b.r - a.i * b.i, a.r * b.i + a.i * b.r}; }
__device__ __forceinline__ cplx cfma(cplx a, cplx x, cplx b) { return {fmaf(a.r, x.r, fmaf(-a.i, x.i, b.r)), fmaf(a.r, x.i, fmaf(a.i, x.r, b.i))}; }
__device__ __forceinline__ cplx csel(bool s, cplx a, cplx b) { return {s ? a.r : b.r, s ? a.i : b.i}; }
template <bool BWD, bool FINAL>
__device__ __forceinline__ void s5_chunk_scan(f32x16 (&br)[2], f32x16 (&bi)[2], const cplx lam, const cplx Hin, const bool half, cplx& Hout) {
    const cplx lam2 = cmul(lam, lam), lam3 = cmul(lam2, lam), lam4 = cmul(lam2, lam2);
    cplx E[2][4];
#pragma unroll
    for (int tb = 0; tb < 2; ++tb)
#pragma unroll
        for (int q = 0; q < 4; ++q) {
            if (!BWD) { cplx w = {br[tb][4 * q], bi[tb][4 * q]};
#pragma unroll
                for (int j = 1; j < 4; ++j) { w = cfma(lam, w, (cplx){br[tb][4 * q + j], bi[tb][4 * q + j]}); br[tb][4 * q + j] = w.r; bi[tb][4 * q + j] = w.i; }
                E[tb][q] = w; }
            else { cplx w = {br[tb][4 * q + 3], bi[tb][4 * q + 3]};
#pragma unroll
                for (int j = 2; j >= 0; --j) { w = cfma(lam, w, (cplx){br[tb][4 * q + j], bi[tb][4 * q + j]}); br[tb][4 * q + j] = w.r; bi[tb][4 * q + j] = w.i; }
                E[tb][q] = w; }
        }
    cplx Eev[2][4], Eod[2][4];
#pragma unroll
    for (int tb = 0; tb < 2; ++tb)
#pragma unroll
        for (int q = 0; q < 4; ++q) {
            const auto rr = __builtin_amdgcn_permlane32_swap(__float_as_uint(E[tb][q].r), __float_as_uint(E[tb][q].r), false, false);
            const auto ri = __builtin_amdgcn_permlane32_swap(__float_as_uint(E[tb][q].i), __float_as_uint(E[tb][q].i), false, false);
            Eev[tb][q] = {__uint_as_float(rr[0]), __uint_as_float(ri[0])}; Eod[tb][q] = {__uint_as_float(rr[1]), __uint_as_float(ri[1])}; }
    cplx H = Hin; cplx Hg[2][4];
    if (!BWD) {
#pragma unroll
        for (int tb = 0; tb < 2; ++tb)
#pragma unroll
            for (int q = 0; q < 4; ++q) { const cplx He = H; H = cfma(lam4, H, Eev[tb][q]); const cplx Ho = H; H = cfma(lam4, H, Eod[tb][q]); Hg[tb][q] = csel(half, Ho, He); }
    } else {
#pragma unroll
        for (int tb = 1; tb >= 0; --tb)
#pragma unroll
            for (int q = 3; q >= 0; --q) { const cplx Ho = H; H = cfma(lam4, H, Eod[tb][q]); const cplx He = H; H = cfma(lam4, H, Eev[tb][q]); Hg[tb][q] = csel(half, Ho, He); }
    }
    Hout = H;
    if (FINAL) {
#pragma unroll
        for (int tb = 0; tb < 2; ++tb)
#pragma unroll
            for (int q = 0; q < 4; ++q)
#pragma unroll
                for (int j = 0; j < 4; ++j) { const int e = BWD ? 3 - j : j; const cplx pw = e == 0 ? lam : (e == 1 ? lam2 : (e == 2 ? lam3 : lam4));
                    const cplx h = cfma(pw, Hg[tb][q], (cplx){br[tb][4 * q + j], bi[tb][4 * q + j]}); br[tb][4 * q + j] = h.r; bi[tb][4 * q + j] = h.i; }
    }
}
__device__ __forceinline__ cplx cpow2n(cplx a, int n) { for (int k = 0; k < n; ++k) a = cmul(a, a); return a; }
__device__ __forceinline__ cplx ldc(const float* p) { const float2 v = *(const float2*)p; return {v.x, v.y}; }

__device__ __forceinline__ int s5_rs(int rk) { return rk == 0 ? 0 : (rk <= 4 ? 4 + 5 * (rk - 1) : 24 + 4 * (rk - 5)); }
__device__ __forceinline__ int s5_rl(int rk) { return (rk >= 1 && rk <= 4) ? 5 : 4; }
constexpr int S5L_LAM = 0, S5L_BB = 1024, S5L_CM = 1024 + 8192, S5L_HS = 1024 + 16384, S5L_HB = S5L_HS + 8 * 4608, S5L_END = S5L_HB + 8 * 2560;
template <bool OUT>
__device__ __forceinline__ void phase_s5_fast(const Ctx& c, int l) {
    const P& p = *c.p; const int i = l >> 1;
    const bf16_t* proj = (const bf16_t*)(p.ws + WS_PROJ);
    const unsigned char* tb_ = p.ws + WS_S5 + (size_t)i * MiB;
    float* SCB = (float*)(p.ws + WS_SCB); float* SR = (float*)(p.ws + WS_SR); bf16_t* yg = (bf16_t*)(p.ws + WS_YG);
    const int wid = __builtin_amdgcn_readfirstlane(c.wid);
    char* lds = (char*)c.lds;
    const int G = gridDim.x, nsub = G >> 5;
    if ((int)blockIdx.x >= nsub * 32) return;
    const int g = blockIdx.x & 31, sub = blockIdx.x >> 5;
    __syncthreads();
    {
        const float* LAM = (const float*)(tb_ + S5T_LAM); const bf16_t* BBT = (const bf16_t*)(tb_ + S5T_BBT); const bf16_t* CMT = (const bf16_t*)(tb_ + S5T_CMT);
        const int ln = c.lane, r32 = ln & 31, hi = ln >> 5;
        if (c.tid < 128) { const int d = c.tid >> 6, ps = c.tid & 63; *(float2*)(lds + S5L_LAM + (d * 64 + ps) * 8) = *(const float2*)(LAM + ((size_t)(d * 32 + g) * 64 + ps) * 2); }
        { const int d = wid >> 2, ri = (wid >> 1) & 1, pb = wid & 1;
            *(u32x4*)(lds + S5L_BB + (wid * 64 + ln) * 16) = *(const u32x4*)(BBT + (((size_t)(d * 32 + g) * 2 + ri) * 64 + pb * 32 + r32) * 16 + hi * 8); }
        { const int d = wid >> 2, pb = (wid >> 1) & 1, ks = wid & 1;
            *(u32x4*)(lds + S5L_CM + (wid * 64 + ln) * 16) = *(const u32x4*)(CMT + ((size_t)(d * 32 + g) * 16 + (ln & 15)) * 128 + pb * 64 + ks * 32 + (ln >> 4) * 8); }
    }
    __syncthreads();
    char* hs = lds + S5L_HS + wid * 4608;
#pragma unroll 1
    for (int j = sub * 8 + wid; j < 64; j += nsub * 8) {
        int lane = c.lane; asm volatile("" : "+v"(lane));
        const int r32 = lane & 31; const bool half = lane >= 32;
        const int b = j >> 4, rk = j & 15, c0 = s5_rs(rk), nc = s5_rl(rk);
        const size_t m0 = (size_t)b * TPB + 64 * c0;
        cplx Hf[2];
        float* hb = (float*)(lds + S5L_HB + wid * 2560);
        cplx SRf[2], SRb[2], pwb[2];
#pragma unroll
        for (int pb = 0; pb < 2; ++pb) { Hf[pb] = {0.f, 0.f}; SRf[pb] = {0.f, 0.f}; SRb[pb] = {0.f, 0.f}; pwb[pb] = {1.f, 0.f};
}
        if (OUT) {
            constexpr size_t KS = 32 * 2 * 64 * 2, CS = 32 * 64 * 2;
            cplx vf[2][15], vb[2][16], sv[2][5];
#pragma unroll
            for (int pb = 0; pb < 2; ++pb) { const int ps = pb * 32 + r32;
                const float* srb = SR + (((size_t)(b * 16) * 32 + g) * 2 * 64 + ps) * 2;
                const float* scb = SCB + ((((size_t)b * 68 + c0) * 32 + g) * 64 + ps) * 2;
#pragma unroll
                for (int kk = 0; kk < 15; ++kk) vf[pb][kk] = ldc(srb + kk * KS);
#pragma unroll
                for (int kk = 0; kk < 16; ++kk) vb[pb][kk] = ldc(srb + kk * KS + 128);
#pragma unroll
                for (int q = 1; q < 5; ++q) sv[pb][q] = (q < nc) ? ldc(scb + q * CS) : (cplx){0.f, 0.f}; }
#pragma unroll
            for (int pb = 0; pb < 2; ++pb) { const int ps = pb * 32 + r32;
                { const cplx L64 = cpow2n(ldc((const float*)(lds + S5L_LAM + (0 * 64 + ps) * 8)), 6), L256 = cpow2n(L64, 2), L320 = cmul(L256, L64);
                    cplx H = {0.f, 0.f};
#pragma unroll
                    for (int kk = 0; kk < 15; ++kk) if (kk < rk) H = cfma((kk >= 1 && kk <= 4) ? L320 : L256, H, vf[pb][kk]);
                    Hf[pb] = H; }
                { const cplx L64 = cpow2n(ldc((const float*)(lds + S5L_LAM + (1 * 64 + ps) * 8)), 6), L256 = cpow2n(L64, 2), L320 = cmul(L256, L64);
                    cplx H = {0.f, 0.f};
                    if (rk >= 1) { H = vb[pb][0];
#pragma unroll
                        for (int kk = 15; kk >= 2; --kk) if (kk > rk) H = cfma((kk >= 1 && kk <= 4) ? L320 : L256, H, vb[pb][kk]); }
#define HB_ST(q, Hv) do { if (!half) { float2 o_; o_.x = (Hv).r; o_.y = (Hv).i; *(float2*)(hb + ((pb * 5 + (q)) * 32 + r32) * 2) = o_; } } while (0)
                    if (nc == 5) { HB_ST(4, H); H = cfma(L64, H, sv[pb][4]); }
                    HB_ST(3, H); H = cfma(L64, H, sv[pb][3]); HB_ST(2, H); H = cfma(L64, H, sv[pb][2]); HB_ST(1, H); H = cfma(L64, H, sv[pb][1]); HB_ST(0, H); }
#undef HB_ST
            }
        }
        asm volatile("s_waitcnt lgkmcnt(0)" ::: "memory");
        bf16x8 dfr;
        { const int hh = lane & 15, l4 = lane >> 4; const unsigned dv = f2bf(p.in[19][i * 512 + g * 16 + hh]);
#pragma unroll
            for (int e = 0; e < 8; ++e) dfr[e] = (short)((8 * l4 + e == hh) ? dv : 0u); }
        bf16x8 ua[2];
#pragma unroll
        for (int tb = 0; tb < 2; ++tb) ua[tb] = *(const bf16x8*)(proj + (m0 + tb * 32 + r32) * NPROJ + 1536 + g * 16 + (lane >> 5) * 8);
#pragma unroll 1
        for (int cc = 0; cc < nc; ++cc) {
            int ln = lane; asm volatile("" : "+v"(ln));
            const int r32c = ln & 31, hi = ln >> 5, l15 = ln & 15, l4 = ln >> 4;
            const size_t mc = m0 + 64 * cc; const size_t chunk = (size_t)b * 68 + c0 + cc;
            const bf16x8 u0 = ua[0], u1 = ua[1];
            if (cc + 1 < nc) {
#pragma unroll
                for (int tb = 0; tb < 2; ++tb) ua[tb] = *(const bf16x8*)(proj + (mc + 64 + tb * 32 + r32c) * NPROJ + 1536 + g * 16 + hi * 8); }
            f32x4 yacc[4];
            if (OUT) {
                *(bf16x8*)(hs + r32c * 32 + hi * 16) = u0; *(bf16x8*)(hs + (32 + r32c) * 32 + hi * 16) = u1;
                asm volatile("s_waitcnt lgkmcnt(0)" ::: "memory");
#pragma unroll
                for (int t = 0; t < 4; ++t) { bf16x8 xa = (bf16x8){0, 0, 0, 0, 0, 0, 0, 0};
                    if (l4 < 2) xa = *(const bf16x8*)(hs + (t * 16 + l15) * 32 + l4 * 16);
                    yacc[t] = __builtin_amdgcn_mfma_f32_16x16x32_bf16(xa, dfr, (f32x4){0.f, 0.f, 0.f, 0.f}, 0, 0, 0); }
                asm volatile("s_waitcnt lgkmcnt(0)" ::: "memory");
            }
#pragma unroll
            for (int pb = 0; pb < 2; ++pb)
#pragma unroll 1
                for (int d = 0; d < 2; ++d) {
                    const cplx lam_ = ldc((const float*)(lds + S5L_LAM + (d * 64 + pb * 32 + r32c) * 8)); const cplx L64_ = cpow2n(lam_, 6);
                    const bf16x8 bre = *(const bf16x8*)(lds + S5L_BB + (((d * 2 + 0) * 2 + pb) * 64 + ln) * 16), bim = *(const bf16x8*)(lds + S5L_BB + (((d * 2 + 1) * 2 + pb) * 64 + ln) * 16);
                    f32x16 br[2], bi[2];
                    br[0] = __builtin_amdgcn_mfma_f32_32x32x16_bf16(u0, bre, (f32x16){}, 0, 0, 0); bi[0] = __builtin_amdgcn_mfma_f32_32x32x16_bf16(u0, bim, (f32x16){}, 0, 0, 0);
                    br[1] = __builtin_amdgcn_mfma_f32_32x32x16_bf16(u1, bre, (f32x16){}, 0, 0, 0); bi[1] = __builtin_amdgcn_mfma_f32_32x32x16_bf16(u1, bim, (f32x16){}, 0, 0, 0);
                    cplx Hin = {0.f, 0.f}, Hout;
                    if (OUT) { if (d == 0) Hin = Hf[pb]; else Hin = ldc(hb + ((pb * 5 + cc) * 32 + r32c) * 2); }
                    if (d == 0) s5_chunk_scan<false, OUT>(br, bi, lam_, Hin, half, Hout); else s5_chunk_scan<true, OUT>(br, bi, lam_, Hin, half, Hout);
                    if (OUT) {
                        if (d == 0) Hf[pb] = Hout;
#pragma unroll
                        for (int tb = 0; tb < 2; ++tb) {
                            int ob = hi * (4 * 144) + r32c * 4; asm volatile("" : "+v"(ob));
#pragma unroll
                            for (int r = 0; r < 16; ++r) *(unsigned*)(hs + ob + ((r & 3) + 8 * (r >> 2)) * 144) = pk2(br[tb][r], bi[tb][r]);
                            asm volatile("s_waitcnt lgkmcnt(0)" ::: "memory");
#pragma unroll
                            for (int ks = 0; ks < 2; ++ks) { const bf16x8 cf = *(const bf16x8*)(lds + S5L_CM + (((d * 2 + pb) * 2 + ks) * 64 + ln) * 16);
#pragma unroll
                                for (int tq = 0; tq < 2; ++tq) { const bf16x8 af = *(const bf16x8*)(hs + (tq * 16 + l15) * 144 + ks * 64 + l4 * 16);
                                    yacc[tb * 2 + tq] = __builtin_amdgcn_mfma_f32_16x16x32_bf16(af, cf, yacc[tb * 2 + tq], 0, 0, 0); } }
                            asm volatile("s_waitcnt lgkmcnt(0)" ::: "memory");
                        }
                    } else {
                        if (d == 0) SRf[pb] = cfma(L64_, SRf[pb], Hout);
                        else { SRb[pb] = cfma(pwb[pb], Hout, SRb[pb]); pwb[pb] = cmul(pwb[pb], L64_);
                            if (!half) { float2 o; o.x = Hout.r; o.y = Hout.i; *(float2*)(SCB + ((chunk * 32 + g) * 64 + pb * 32 + r32c) * 2) = o; } }
                    }
                }
            if (OUT) {
#pragma unroll
                for (int tq = 0; tq < 4; ++tq)
#pragma unroll
                    for (int e = 0; e < 4; ++e) *(bf16_t*)(hs + (tq * 16 + l4 * 4 + e) * 48 + l15 * 2) = (bf16_t)f2bf(gelu_tanh_f(yacc[tq][e]));
                asm volatile("s_waitcnt lgkmcnt(0)" ::: "memory");
#pragma unroll
                for (int q = 0; q < 2; ++q) { const int id = q * 64 + ln, row = id >> 1, hf = id & 1;
                    *(u32x4*)(yg + (mc + row) * 512 + g * 16 + hf * 8) = *(const u32x4*)(hs + row * 48 + hf * 16); }
                asm volatile("s_waitcnt lgkmcnt(0)" ::: "memory");
            }
        }
        if (!OUT) {
            if (!half) {
#pragma unroll
                for (int pb = 0; pb < 2; ++pb) { float2 o; o.x = SRf[pb].r; o.y = SRf[pb].i; *(float2*)(SR + ((((size_t)(b * 16 + rk) * 32 + g) * 2 + 0) * 64 + pb * 32 + r32) * 2) = o;
                    o.x = SRb[pb].r; o.y = SRb[pb].i; *(float2*)(SR + ((((size_t)(b * 16 + rk) * 32 + g) * 2 + 1) * 64 + pb * 32 + r32) * 2) = o; }
            }
        }
    }
    __syncthreads();
}

__device__ __forceinline__ void phase_headnorm(const Ctx& c, int l) {
    const P& p = *c.p; const int i = l >> 1;
    bf16_t* proj = (bf16_t*)(p.ws + WS_PROJ); const float* rope = (const float*)(p.ws + WS_ROPE);
    for (int it = c.gw; it < MTOK * 10; it += c.ngw) {
        const int m = it / 10, hd = it % 10; const int col0 = hd < 8 ? hd * 128 : 1024 + (hd - 8) * 128;
        const float* g = (hd < 8 ? p.in[24] : p.in[25]) + i * 128;
        const int a = c.lane >> 5, pr = c.lane & 31, i1 = a * 64 + pr, i2 = i1 + 32;
        bf16_t* hp = proj + (size_t)m * NPROJ + col0;
        const float x1 = bf2f(hp[i1]), x2 = bf2f(hp[i2]);
        const float hr = rsqrtf(wave_sum(x1 * x1 + x2 * x2) * (1.f / 128.f) + EPS);
        float y1 = x1 * hr * g[i1], y2 = x2 * hr * g[i2];
        const int t = m % TPB;
        if (t >= NCTX) { const int tl = t - NCTX; const int pos = a == 0 ? tl / 64 : tl % 64; const float cs = rope[2 * (pos * 32 + pr)], sn = rope[2 * (pos * 32 + pr) + 1];
            const float o1 = y1 * cs - y2 * sn, o2 = y1 * sn + y2 * cs; y1 = o1; y2 = o2; }
        hp[i1] = (bf16_t)f2bf(y1); hp[i2] = (bf16_t)f2bf(y2);
    }
}
__device__ __forceinline__ void phase_attn_naive(const Ctx& c, int l) {
    const P& p = *c.p;
    const bf16_t* proj = (const bf16_t*)(p.ws + WS_PROJ); bf16_t* mix = (bf16_t*)(p.ws + WS_MIX);
    float* sc = (float*)c.lds + c.wid * TPB;
    const bool with_ctx = l != DEPTH - 1;
    const int nit = with_ctx ? MTOK : NB * SEQ;
    const float scale = 0.08838834764831845f;
    for (int it = blockIdx.x; it < nit; it += gridDim.x) {
        int m; if (with_ctx) m = it; else { const int b = it / SEQ; m = b * TPB + NCTX + (it - b * SEQ); }
        const int b = m / TPB, t = m - b * TPB; const int nk = t < NCTX ? NCTX : TPB;
        const int hq = c.wid, kv = hq >> 2;
        const bf16_t* qp = proj + (size_t)m * NPROJ + hq * 128;
        float* qs = (float*)(c.lds + 140 * 1024) + c.wid * 128;
        { const unsigned w = *(const unsigned*)(qp + 2 * c.lane); qs[2 * c.lane] = bflo(w); qs[2 * c.lane + 1] = bfhi(w); }
        asm volatile("s_waitcnt lgkmcnt(0)" ::: "memory");
        float mx = -1e30f;
        for (int j0 = 0; j0 < nk; j0 += 64) {
            const bf16_t* kp = proj + (size_t)(b * TPB + j0 + c.lane) * NPROJ + 1024 + kv * 128;
            float s = 0.f;
#pragma unroll 4
            for (int d8 = 0; d8 < 16; ++d8) { const u32x4 w = *(const u32x4*)(kp + d8 * 8); const f32x4 qa = *(const f32x4*)(qs + d8 * 8), qb = *(const f32x4*)(qs + d8 * 8 + 4);
                s += qa.x * bflo(w.x) + qa.y * bfhi(w.x) + qa.z * bflo(w.y) + qa.w * bfhi(w.y) + qb.x * bflo(w.z) + qb.y * bfhi(w.z) + qb.z * bflo(w.w) + qb.w * bfhi(w.w); }
            s *= scale; sc[j0 + c.lane] = s; mx = fmaxf(mx, s);
        }
#pragma unroll
        for (int o = 1; o < 64; o <<= 1) mx = fmaxf(mx, __shfl_xor(mx, o));
        float ls = 0.f;
        for (int j0 = 0; j0 < nk; j0 += 64) { const float e = __expf(sc[j0 + c.lane] - mx); sc[j0 + c.lane] = e; ls += e; }
        ls = wave_sum(ls);
        asm volatile("s_waitcnt lgkmcnt(0)" ::: "memory");
        float o0 = 0.f, o1 = 0.f;
        const bf16_t* vp = proj + (size_t)(b * TPB) * NPROJ + 1280 + kv * 128 + 2 * c.lane;
#pragma unroll 4
        for (int j = 0; j < nk; ++j) { const unsigned w = *(const unsigned*)(vp + (size_t)j * NPROJ); const float pj = sc[j]; o0 += pj * bflo(w); o1 += pj * bfhi(w); }
        const float inv = 1.f / ls;
        const unsigned gw_ = *(const unsigned*)(proj + (size_t)m * NPROJ + 1536 + hq * 128 + 2 * c.lane);
        *(unsigned*)(mix + (size_t)m * DM + hq * 128 + 2 * c.lane) = pk2(o0 * inv * bflo(gw_), o1 * inv * bfhi(gw_));
        asm volatile("s_waitcnt lgkmcnt(0)" ::: "memory");
    }
}


__device__ __forceinline__ void phase_attn(const Ctx& c, int l) {
    const P& p = *c.p;
    const bf16_t* proj = (const bf16_t*)(p.ws + WS_PROJ); bf16_t* mix = (bf16_t*)(p.ws + WS_MIX);
    const int G = gridDim.x, bid = blockIdx.x; const int vcu = (G % 8 == 0) ? (bid % 8) * (G / 8) + bid / 8 : bid;
    const int nu = 512 + (l != DEPTH - 1 ? 32 : 0);
    for (int u = vcu; u < nu; u += G) {
        int b, hq, row0, seq;
        if (u < 512) { const int qb = u & 15, hql = (u >> 4) & 3, kvh = (u >> 6) & 1; b = u >> 7; hq = kvh * 4 + hql; row0 = b * TPB + NCTX + qb * 256; seq = TPB; }
        else { const int v = u - 512; b = v >> 3; hq = v & 7; row0 = b * TPB; seq = NCTX; }
        const int kv = hq >> 2;
        const bf16_t* kvb = proj + (size_t)b * TPB * NPROJ;
        attn::attn_dense_body<bf16_t>(proj + (size_t)row0 * NPROJ + hq * 128, kvb + 1024 + kv * 128, kvb + 1280 + kv * 128,
                                      mix + (size_t)row0 * DM + hq * 128, proj + (size_t)row0 * NPROJ + 1536 + hq * 128, seq, (char*)c.lds, c.tid);
        __syncthreads();
    }
}

__device__ __forceinline__ void phase_final(const Ctx& c) {
    const P& p = *c.p; const float* g = p.in[26]; const bf16_t* xb = (const bf16_t*)(p.ws + WS_XB); const float* rss = (const float*)(p.ws + WS_RSS);
    for (int m0 = 4 * c.gw; m0 < NB * SEQ; m0 += 4 * c.ngw) {
        u32x4 w[4][2]; float rs[4];
#pragma unroll
        for (int rr = 0; rr < 4; ++rr) { const int m = m0 + rr; const int b = m / SEQ, t = m - b * SEQ; const size_t grow = (size_t)b * TPB + NCTX + t;
#pragma unroll
            for (int hh = 0; hh < 2; ++hh) w[rr][hh] = *(const u32x4*)(xb + (size_t)m * DM + hh * 512 + c.lane * 8);
            const f32x4* rp = (const f32x4*)(rss + grow * 16); const f32x4 s0 = rp[0], s1 = rp[1], s2 = rp[2], s3 = rp[3];
            rs[rr] = rsqrtf((((s0.x + s0.y) + (s0.z + s0.w)) + ((s1.x + s1.y) + (s1.z + s1.w)) + ((s2.x + s2.y) + (s2.z + s2.w)) + ((s3.x + s3.y) + (s3.z + s3.w))) * (1.f / DM) + EPS); }
#pragma unroll
        for (int rr = 0; rr < 4; ++rr)
#pragma unroll
            for (int hh = 0; hh < 2; ++hh) { const int col = hh * 512 + c.lane * 8; const f32x4 g0 = *(const f32x4*)(g + col), g1 = *(const f32x4*)(g + col + 4); const u32x4 v = w[rr][hh]; const float r_ = rs[rr];
                float* o = p.out + (size_t)(m0 + rr) * DM + col;
                *(f32x4*)o = (f32x4){bflo(v.x) * r_ * g0.x, bfhi(v.x) * r_ * g0.y, bflo(v.y) * r_ * g0.z, bfhi(v.y) * r_ * g0.w};
                *(f32x4*)(o + 4) = (f32x4){bflo(v.z) * r_ * g1.x, bfhi(v.z) * r_ * g1.y, bflo(v.w) * r_ * g1.z, bfhi(v.w) * r_ * g1.w}; }
    }
}

enum { K_PREP_A, K_PREP_B, K_IN, K_EVENMIX, K_S5COMB, K_GLU, K_OUT, K_XPREP, K_HEADNORM, K_ATTN, K_FINAL };
#ifdef DUP_PH
constexpr int NPH = 20, NPHT = 19;
#else
constexpr int NPH = 19, NPHT = 19;
#endif
__device__ __forceinline__ void phase_decode(int ph, int& kind, int& layer) {
    constexpr int kinds[NPHT] = {K_PREP_A, K_PREP_B,
        K_IN, K_EVENMIX, K_S5COMB, K_GLU, K_OUT,
        K_IN, K_ATTN, K_OUT,
        K_IN, K_EVENMIX, K_S5COMB, K_GLU, K_OUT,
        K_IN, K_ATTN, K_OUT, K_FINAL};
    constexpr int layers[NPHT] = {0, 0, 0, 0, 0, 0, 0, 1, 1, 1, 2, 2, 2, 2, 2, 3, 3, 3, 0};
#ifdef DUP_PH
    if (ph > DUP_PH) --ph;
#endif
    kind = kinds[ph]; layer = layers[ph];
}

template <int ONLY> __device__ __forceinline__ void mega_body(const P& p) {
    extern __shared__ __attribute__((aligned(16))) unsigned char lds[];
    const int wave_u = __builtin_amdgcn_readfirstlane((int)threadIdx.x >> 6);
    if (threadIdx.x == 0) { volatile LAS unsigned long long* tab = (volatile LAS unsigned long long*)((LAS unsigned char*)lds + TAB_OFF);
#pragma unroll
        for (int i = 0; i < 27; ++i) tab[i] = (unsigned long long)p.in[i];
        tab[27] = (unsigned long long)p.out; tab[28] = (unsigned long long)p.ws; }
    if (threadIdx.x < 2) ((volatile LAS unsigned*)((LAS unsigned char*)lds + TAB_OFF + 240))[threadIdx.x] = 0u;
    __syncthreads();
    XcdBarrier bar = xcd_barrier_post((unsigned*)(p.ws + WS_CTL), (volatile LAS unsigned*)((LAS unsigned char*)lds + TAB_OFF + 240));
    for (int ph = p.ph_lo; ph < p.ph_hi; ++ph) {
        int kind, l; phase_decode(ph, kind, l);
        if (ONLY >= 0 && kind != ONLY) continue;
        unsigned z_ = 0u; asm volatile("" : "+v"(z_));
        int tid_ = (wave_u << 6) | (int)__builtin_amdgcn_mbcnt_hi(~0u, __builtin_amdgcn_mbcnt_lo(~0u, z_));
        P q;
        { unsigned tbo = TAB_OFF; asm volatile("" : "+v"(tbo));
          const volatile LAS unsigned* tab = (const volatile LAS unsigned*)((LAS unsigned char*)lds + tbo);
#pragma unroll
          for (int i = 0; i < 27; ++i) { const unsigned lo = __builtin_amdgcn_readfirstlane(tab[2 * i]), hi = __builtin_amdgcn_readfirstlane(tab[2 * i + 1]); q.in[i] = (const float*)(const __attribute__((address_space(1))) float*)(((unsigned long long)hi << 32) | lo); }
          { const unsigned lo = __builtin_amdgcn_readfirstlane(tab[54]), hi = __builtin_amdgcn_readfirstlane(tab[55]); q.out = (float*)(__attribute__((address_space(1))) float*)(((unsigned long long)hi << 32) | lo); }
          { const unsigned lo = __builtin_amdgcn_readfirstlane(tab[56]), hi = __builtin_amdgcn_readfirstlane(tab[57]); q.ws = (unsigned char*)(__attribute__((address_space(1))) unsigned char*)(((unsigned long long)hi << 32) | lo); }
          q.ph_lo = p.ph_lo; q.ph_hi = p.ph_hi; }
        Ctx c; c.p = &q; c.tid = tid_; c.wid = wave_u; c.lane = c.tid & 63; c.gw = blockIdx.x * NWAVES + c.wid; c.ngw = gridDim.x * NWAVES; c.lds = lds;
        switch (kind) {
            case K_PREP_A: phase_prep_a(c); phase_s5prep(c); phase_transposes(c); break;
            case K_PREP_B: phase_bias(c); phase_xprep(c, 0, q.in[0], q.in[2]);
#if defined(DUPX) && DUPX == 4
                phase_bias(c);
#elif defined(DUPX) && DUPX == 5
                phase_xprep(c, 0, q.in[0], q.in[2]);
#elif defined(DUPX) && DUPX == 6
                phase_transposes(c);
#endif
                break;
            case K_IN: phase_in(c, l); break;
#ifdef USE_S5
#ifdef USE_GMLP
            case K_EVENMIX:
                phase_s5_fast<false>(c, l);
#if defined(DUPX) && DUPX == 2
                phase_s5_fast<false>(c, l);
#endif
                break;
#else
            case K_EVENMIX: phase_gmlp(c, l); phase_s5_fast<false>(c, l); break;
#endif
            case K_S5COMB: phase_s5_fast<true>(c, l); break;
#else
#ifdef USE_GMLP
            case K_EVENMIX: phase_gmlp_fast(c, l, 0, (int)gridDim.x); phase_s5_naive(c, l); break;
#else
            case K_EVENMIX: phase_gmlp(c, l); phase_s5_naive(c, l); break;
#endif
            case K_S5COMB: phase_s5comb(c, l); break;
#endif
            case K_GLU: phase_glu(c, l); break;
            case K_OUT: phase_out(c, l); break;
            case K_XPREP: phase_xprep(c, l, q.out, (const float*)(q.ws + WS_CTXRES)); break;
            case K_HEADNORM: phase_headnorm(c, l); break;
#ifdef USE_ATTN
            case K_ATTN: phase_attn(c, l); break;
#else
            case K_ATTN: phase_attn_naive(c, l); break;
#endif
            case K_FINAL: phase_final(c); break;
        }
        if (ph + 1 < p.ph_hi) xcd_barrier(bar);
    }
}

__global__ void __launch_bounds__(NTHREADS) k_mega(P p) { mega_body<-1>(p); }
#ifdef PERKIND
template <int KIND> __global__ void __launch_bounds__(NTHREADS) k_one(P p) { mega_body<KIND>(p); }
template __global__ void k_one<0>(P); template __global__ void k_one<1>(P); template __global__ void k_one<2>(P); template __global__ void k_one<3>(P); template __global__ void k_one<4>(P); template __global__ void k_one<5>(P);
template __global__ void k_one<6>(P); template __global__ void k_one<7>(P); template __global__ void k_one<8>(P); template __global__ void k_one<9>(P); template __global__ void k_one<10>(P);
#endif


extern "C" void kernel_launch(void* const* d_in, const int* in_sizes, int n_in, void* d_out, int out_size, void* d_ws, size_t ws_size, hipStream_t stream) {
    static int grid = 0;
    if (grid == 0) {
        if (n_in != 27 || out_size != NB * SEQ * DM || ws_size < WS_END) { fprintf(stderr, "kernel_launch: unexpected shapes n_in %d out %d ws %zu\n", n_in, out_size, ws_size); grid = -1; return; }
        int dev = 0, cus = 0, per_cu = 0;
        hipGetDevice(&dev); hipDeviceGetAttribute(&cus, hipDeviceAttributeMultiprocessorCount, dev);
        hipFuncSetAttribute((const void*)k_mega, hipFuncAttributeMaxDynamicSharedMemorySize, LDS_BYTES);
        hipOccupancyMaxActiveBlocksPerMultiprocessor(&per_cu, (const void*)k_mega, NTHREADS, LDS_BYTES);
        if (per_cu < 1) { fprintf(stderr, "kernel_launch: occupancy query says %d blocks per CU\n", per_cu); per_cu = 1; }
        grid = cus * 1;
        fprintf(stderr, "kernel_launch: cus %d per_cu %d grid %d\n", cus, per_cu, grid);
    }
    if (grid < 0) return;
    hipMemsetAsync((char*)d_ws + WS_CTL, 0, 16384, stream);
    P p{};
    for (int i = 0; i < 27; ++i) p.in[i] = (const float*)d_in[i];
    p.out = (float*)d_out; p.ws = (unsigned char*)d_ws;
#ifdef ONE_LAUNCH
    p.ph_lo = 0; p.ph_hi = NPH;
    void* args[] = {&p};
    hipError_t e = hipLaunchCooperativeKernel((void*)k_mega, dim3(grid), dim3(NTHREADS), args, LDS_BYTES, stream);
    if (e != hipSuccess) fprintf(stderr, "cooperative launch failed: %s\n", hipGetErrorString(e));
#else
    for (int ph = 0; ph < NPH; ++ph) {
        p.ph_lo = ph; p.ph_hi = ph + 1;
        hipLaunchKernelGGL(k_mega, dim3(grid), dim3(NTHREADS), LDS_BYTES, stream, p);
    }
#endif
}
```
